# Optimizing an MI355X kernel written in HIP

```python
import jax, jax.numpy as jnp
from jax import lax
import numpy as np

D_MODEL = 2048
BATCH = 32
SEQ = 256
DEPTH = 4
DEC_BATCH = 8
DEC_SEQ = 1024
PAST_LEN = 256

GRID_W = 64
N_MIXERS = 2
N_ATTN_LAYERS = (DEPTH + 1) // 2
N_REC_LAYERS = DEPTH // 2
N_HEADS = 16
Q_LORA = 512
KV_LORA = 512
NOPE_DIM = 128
ROPE_DIM = 64
V_DIM = 128
ROPE_BASE = 10000.0
Q_BLOCK = 128
LRU_WIDTH = D_MODEL
N_LRU_BLOCKS = 16
LRU_BLOCK = LRU_WIDTH // N_LRU_BLOCKS
LRU_CONV_W = 4
LRU_CONV_PAD_LEFT = 2
LRU_C = 8.0
D_FF = 5632
FFN_CONV_W = 3
FFN_CONV_PAD_LEFT = 1
NORM_EPS = 1e-6

kernel_name = "hybrid_mla_rglru_convffn_diffusion_step"


def rmsnorm(x, g):
    xf = x.astype(jnp.float32)
    y = xf * lax.rsqrt(jnp.mean(xf * xf, axis=-1, keepdims=True) + NORM_EPS)
    return (y * g.astype(jnp.float32)).astype(x.dtype)


def adaln(cond, w, b):
    m = jax.nn.silu(cond) @ w + b
    return [t[:, None, :] for t in jnp.split(m, 6, axis=-1)]


def depthwise_conv(x, w, b, pad_left):
    k = w.shape[0]
    s = x.shape[1]
    xp = jnp.pad(x, ((0, 0), (pad_left, k - 1 - pad_left), (0, 0)))
    out = b
    for j in range(k):
        out = out + xp[:, j:j + s] * w[j]
    return out


def axial_rope_tables(n_tokens):
    rows = n_tokens // GRID_W
    row = jnp.repeat(jnp.arange(rows), GRID_W).astype(jnp.float32)
    col = jnp.tile(jnp.arange(GRID_W), rows).astype(jnp.float32)
    half = ROPE_DIM // 2
    inv = 1.0 / (ROPE_BASE ** (jnp.arange(0, half, 2, dtype=jnp.float32) / half))
    ang = jnp.concatenate([row[:, None] * inv, col[:, None] * inv], axis=-1)
    return jnp.cos(ang), jnp.sin(ang)


def apply_axial_rope(x, cos, sin):
    q = ROPE_DIM // 4
    xr1, xr2, xc1, xc2 = jnp.split(x.astype(jnp.float32), 4, axis=-1)
    cr, cc = cos[..., :q], cos[..., q:]
    sr, sc = sin[..., :q], sin[..., q:]
    y = jnp.concatenate([xr1 * cr - xr2 * sr, xr2 * cr + xr1 * sr,
                         xc1 * cc - xc2 * sc, xc2 * cc + xc1 * sc], axis=-1)
    return y.astype(x.dtype)


def mla_project(h, w_in, g_q, g_kv, w_uq):
    proj = h @ w_in
    c_q, c_kv, k_rope = jnp.split(proj, [Q_LORA, Q_LORA + KV_LORA], axis=-1)
    q = rmsnorm(c_q, g_q) @ w_uq
    q = q.reshape(q.shape[0], q.shape[1], N_HEADS, NOPE_DIM + ROPE_DIM)
    return q[..., :NOPE_DIM], q[..., NOPE_DIM:], rmsnorm(c_kv, g_kv), k_rope


def mla_expand(ckv, w_uk, w_uv):
    b, s = ckv.shape[:2]
    k_nope = (ckv @ w_uk).reshape(b, s, N_HEADS, NOPE_DIM)
    v = (ckv @ w_uv).reshape(b, s, N_HEADS, V_DIM)
    return k_nope, v


def mla_attention(q_nope, q_rope, k_nope, k_rope, v):
    b, sq = q_nope.shape[:2]
    nblk = sq // Q_BLOCK
    scale = (NOPE_DIM + ROPE_DIM) ** -0.5

    def blk(qs):
        qn, qr = qs
        s = (jnp.einsum('bqhd,bkhd->bhqk', qn, k_nope, preferred_element_type=jnp.float32)
             + jnp.einsum('bqhr,bkr->bhqk', qr, k_rope, preferred_element_type=jnp.float32))
        p = jax.nn.softmax(s * scale, axis=-1).astype(v.dtype)
        return jnp.einsum('bhqk,bkhd->bqhd', p, v)

    to_blocks = lambda t: jnp.moveaxis(t.reshape(b, nblk, Q_BLOCK, *t.shape[2:]), 1, 0)
    out = lax.map(blk, (to_blocks(q_nope), to_blocks(q_rope)))
    return jnp.moveaxis(out, 0, 1).reshape(b, sq, N_HEADS * V_DIM)


def block_diag(x, w, b):
    xb = x.reshape(x.shape[0], x.shape[1], N_LRU_BLOCKS, LRU_BLOCK)
    return jnp.einsum('bsni,nij->bsnj', xb, w).reshape(x.shape) + b


def rg_lru(x, lam, w_gx, b_gx, w_ga, b_ga, h0, reverse):
    gate_x = jax.nn.sigmoid(block_diag(x, w_gx, b_gx).astype(jnp.float32))
    gate_a = jax.nn.sigmoid(block_diag(x, w_ga, b_ga).astype(jnp.float32))
    log_a = -LRU_C * gate_a * jax.nn.softplus(-lam.astype(jnp.float32))
    a = jnp.exp(log_a)
    u = jnp.sqrt(-jnp.expm1(2.0 * log_a)) * (gate_x * x)

    def step(h, au):
        a_t, u_t = au
        h = a_t * h + u_t
        return h, h

    h_last, hs = lax.scan(step, h0.astype(jnp.float32),
                          (jnp.swapaxes(a, 0, 1), jnp.swapaxes(u, 0, 1)), reverse=reverse)
    return jnp.swapaxes(hs, 0, 1), h_last


def recurrent_mixer(h, w_in, w_conv, b_conv, w_gx, b_gx, w_ga, b_ga, lam, w_out, h0_f, h0_b):
    proj = h @ w_in
    y, xb = jnp.split(proj, 2, axis=-1)
    xb = depthwise_conv(xb, w_conv, b_conv, LRU_CONV_PAD_LEFT).astype(jnp.float32)
    hf, sf = rg_lru(xb, lam[0], w_gx[0], b_gx[0], w_ga[0], b_ga[0], h0_f, False)
    hb, sb = rg_lru(xb, lam[1], w_gx[1], b_gx[1], w_ga[1], b_ga[1], h0_b, True)
    mixed = ((hf + hb) * jax.nn.gelu(y.astype(jnp.float32))).astype(h.dtype)
    return mixed @ w_out, sf.astype(h.dtype), sb.astype(h.dtype)


def conv_ffn(h, w_up, w_conv, b_conv, w_down):
    u = depthwise_conv(h @ w_up, w_conv, b_conv, FFN_CONV_PAD_LEFT)
    g, v = jnp.split(u, 2, axis=-1)
    return (jax.nn.silu(g) * v) @ w_down


def setup_inputs(seed: int = 0) -> dict:
    key = jax.random.key(seed)
    ks = iter(jax.random.split(key, 40))
    D = D_MODEL

    def nrm(shape, s=1.0):
        return jax.random.normal(next(ks), shape, jnp.float32) * s

    def gain(shape):
        return 1.0 + nrm(shape, 0.02)

    inp = {}
    inp["x_prompt"] = nrm((BATCH, SEQ, D))
    inp["x_sample"] = nrm((DEC_BATCH, DEC_SEQ, D))
    inp["cache_ckv"] = nrm((DEC_BATCH, N_ATTN_LAYERS, PAST_LEN, KV_LORA))
    inp["cache_krope"] = nrm((DEC_BATCH, N_ATTN_LAYERS, PAST_LEN, ROPE_DIM))
    inp["state_lru"] = nrm((DEC_BATCH, N_REC_LAYERS, 2, LRU_WIDTH), 0.5)
    inp["c"] = nrm((DEC_BATCH, D))
    inp["c_ctx"] = nrm((D,))
    inp["g_mix"] = gain((DEPTH, D))
    inp["g_ffn"] = gain((DEPTH, D))
    inp["g_final"] = gain((D,))
    inp["w_ada"] = nrm((DEPTH, D, 6 * D), 0.5 * D ** -0.5)
    inp["b_ada"] = nrm((DEPTH, 6 * D), 0.02)
    inp["w_mla_in"] = nrm((N_ATTN_LAYERS, D, Q_LORA + KV_LORA + ROPE_DIM), D ** -0.5)
    inp["g_mla_q"] = gain((N_ATTN_LAYERS, Q_LORA))
    inp["g_mla_kv"] = gain((N_ATTN_LAYERS, KV_LORA))
    inp["w_mla_uq"] = nrm((N_ATTN_LAYERS, Q_LORA, N_HEADS * (NOPE_DIM + ROPE_DIM)), Q_LORA ** -0.5)
    inp["w_mla_uk"] = nrm((N_ATTN_LAYERS, KV_LORA, N_HEADS * NOPE_DIM), KV_LORA ** -0.5)
    inp["w_mla_uv"] = nrm((N_ATTN_LAYERS, KV_LORA, N_HEADS * V_DIM), KV_LORA ** -0.5)
    inp["w_mla_o"] = nrm((N_ATTN_LAYERS, N_HEADS * V_DIM, D), (N_HEADS * V_DIM) ** -0.5)
    inp["w_rec_in"] = nrm((N_REC_LAYERS, D, 2 * LRU_WIDTH), D ** -0.5)
    inp["w_rec_conv"] = nrm((N_REC_LAYERS, LRU_CONV_W, LRU_WIDTH), LRU_CONV_W ** -0.5)
    inp["b_rec_conv"] = nrm((N_REC_LAYERS, LRU_WIDTH), 0.01)
    inp["w_rec_gx"] = nrm((N_REC_LAYERS, 2, N_LRU_BLOCKS, LRU_BLOCK, LRU_BLOCK), LRU_BLOCK ** -0.5)
    inp["b_rec_gx"] = nrm((N_REC_LAYERS, 2, LRU_WIDTH), 0.01)
    inp["w_rec_ga"] = nrm((N_REC_LAYERS, 2, N_LRU_BLOCKS, LRU_BLOCK, LRU_BLOCK), LRU_BLOCK ** -0.5)
    inp["b_rec_ga"] = nrm((N_REC_LAYERS, 2, LRU_WIDTH), 0.01)
    a0 = jax.random.uniform(next(ks), (N_REC_LAYERS, 2, LRU_WIDTH), jnp.float32, 0.9, 0.999)
    inp["rec_lambda"] = jnp.log(a0) - jnp.log1p(-a0)
    inp["w_rec_out"] = nrm((N_REC_LAYERS, LRU_WIDTH, D), LRU_WIDTH ** -0.5)
    inp["w_ffn_up"] = nrm((DEPTH, D, 2 * D_FF), D ** -0.5)
    inp["w_ffn_conv"] = nrm((DEPTH, FFN_CONV_W, 2 * D_FF), FFN_CONV_W ** -0.5)
    inp["b_ffn_conv"] = nrm((DEPTH, 2 * D_FF), 0.01)
    inp["w_ffn_down"] = nrm((DEPTH, D_FF, D), D_FF ** -0.5)
    return inp


def reference(x_prompt, x_sample, cache_ckv, cache_krope, state_lru, c, c_ctx,
              g_mix, g_ffn, g_final, w_ada, b_ada,
              w_mla_in, g_mla_q, g_mla_kv, w_mla_uq, w_mla_uk, w_mla_uv, w_mla_o,
              w_rec_in, w_rec_conv, b_rec_conv, w_rec_gx, b_rec_gx, w_rec_ga, b_rec_ga,
              rec_lambda, w_rec_out,
              w_ffn_up, w_ffn_conv, b_ffn_conv, w_ffn_down):
    xp = x_prompt
    ckv_new, kr_new, lru_new = [], [], []
    for layer in range(DEPTH):
        sh1, sc1, g1, sh2, sc2, g2 = adaln(c_ctx[None, :], w_ada[layer], b_ada[layer])
        h = rmsnorm(xp, g_mix[layer]) * (1 + sc1) + sh1
        j = layer // N_MIXERS
        if layer % N_MIXERS == 0:
            qn, qr, ckv, kr = mla_project(h, w_mla_in[j], g_mla_q[j], g_mla_kv[j], w_mla_uq[j])
            kn, v = mla_expand(ckv, w_mla_uk[j], w_mla_uv[j])
            out = mla_attention(qn, qr, kn, kr, v) @ w_mla_o[j]
            ckv_new.append(ckv)
            kr_new.append(kr)
        else:
            h0 = jnp.zeros((xp.shape[0], LRU_WIDTH), jnp.float32)
            out, sf, sb = recurrent_mixer(h, w_rec_in[j], w_rec_conv[j], b_rec_conv[j],
                                          w_rec_gx[j], b_rec_gx[j], w_rec_ga[j], b_rec_ga[j],
                                          rec_lambda[j], w_rec_out[j], h0, h0)
            lru_new.append(jnp.stack([sf, sb], axis=1))
        xp = xp + g1 * out
        h = rmsnorm(xp, g_ffn[layer]) * (1 + sc2) + sh2
        xp = xp + g2 * conv_ffn(h, w_ffn_up[layer], w_ffn_conv[layer], b_ffn_conv[layer], w_ffn_down[layer])
    y_prompt = rmsnorm(xp, g_final)
    new_cache_ckv = jnp.stack(ckv_new, axis=1)
    new_cache_krope = jnp.stack(kr_new, axis=1)
    new_state_lru = jnp.stack(lru_new, axis=1)

    xs = x_sample
    cos, sin = axial_rope_tables(xs.shape[1])
    for layer in range(DEPTH):
        sh1, sc1, g1, sh2, sc2, g2 = adaln(c, w_ada[layer], b_ada[layer])
        h = rmsnorm(xs, g_mix[layer]) * (1 + sc1) + sh1
        j = layer // N_MIXERS
        if layer % N_MIXERS == 0:
            qn, qr, ckv_l, kr_l = mla_project(h, w_mla_in[j], g_mla_q[j], g_mla_kv[j], w_mla_uq[j])
            qr = apply_axial_rope(qr, cos[:, None, :], sin[:, None, :])
            kr_l = apply_axial_rope(kr_l, cos, sin)
            kn_c, v_c = mla_expand(cache_ckv[:, j], w_mla_uk[j], w_mla_uv[j])
            kn_l, v_l = mla_expand(ckv_l, w_mla_uk[j], w_mla_uv[j])
            kn = jnp.concatenate([kn_c, kn_l], axis=1)
            kr = jnp.concatenate([cache_krope[:, j], kr_l], axis=1)
            v = jnp.concatenate([v_c, v_l], axis=1)
            out = mla_attention(qn, qr, kn, kr, v) @ w_mla_o[j]
        else:
            out, _, _ = recurrent_mixer(h, w_rec_in[j], w_rec_conv[j], b_rec_conv[j],
                                        w_rec_gx[j], b_rec_gx[j], w_rec_ga[j], b_rec_ga[j],
                                        rec_lambda[j], w_rec_out[j],
                                        state_lru[:, j, 0], state_lru[:, j, 1])
        xs = xs + g1 * out
        h = rmsnorm(xs, g_ffn[layer]) * (1 + sc2) + sh2
        xs = xs + g2 * conv_ffn(h, w_ffn_up[layer], w_ffn_conv[layer], b_ffn_conv[layer], w_ffn_down[layer])
    y_sample = rmsnorm(xs, g_final)

    return (y_prompt, y_sample, new_cache_ckv, new_cache_krope, new_state_lru)
```

```cpp
#include <hip/hip_runtime.h>
#include <cstdio>
#include <cstdint>

constexpr int D = 2048, NTOK = 16384, MCTX = 8192, DFF = 5632, NUP = 2 * DFF, NLAYER = 4;
constexpr int QL = 512, KVL = 512, NH = 16, NOPE = 128, ROPE = 64, VD = 128, QKD = NOPE + ROPE;
constexpr int NIN = QL + KVL + ROPE  , NINP = 1280  , NQ = NH * QKD  , NKV = 2 * NH * NOPE  ;
constexpr int MKV = MCTX + 8 * 1280;
constexpr int NMOD = 9, ADA_N = 6 * D;
constexpr float NORM_EPS = 1e-6f;

namespace pg8 {
#define PG8_LAS __attribute__((address_space(3)))
typedef unsigned short bf16_t;
typedef short bf16x8 __attribute__((ext_vector_type(8)));
typedef float f32x4 __attribute__((ext_vector_type(4)));
typedef float f32x2 __attribute__((ext_vector_type(2)));
typedef unsigned u32x4 __attribute__((ext_vector_type(4)));
typedef unsigned u32x2 __attribute__((ext_vector_type(2)));
constexpr int BM = 256, BK = 64, HALF = 128, HTB = HALF * BK * 2  , STAGE_BYTES = 8 * HTB, NXCD = 8, WGM = 8;

__host__ __device__ __forceinline__ int lds_byte(int r, int c) { const int st = (r >> 4) * 2 + (c >> 5), rr = r & 15, cc = c & 31, ob = rr * 64 + cc * 2; return st * 1024 + (ob ^ (((ob >> 9) & 1) << 5)); }
__host__ __device__ __forceinline__ void stage_rc(int b, int& R, int& C) { const int st = b / 1024, sb = b % 1024, swz = sb ^ (((sb >> 9) & 1) << 5); R = (st >> 1) * 16 + swz / 64; C = (st & 1) * 32 + (swz % 64) / 2; }
__host__ __device__ __forceinline__ int perm32(int rho) { const int n = rho >> 4, i = rho & 15; return 8 * (i >> 2) + 4 * n + (i & 3); }

struct Unit { int pm, pn; };
struct Gemm { const bf16_t* A; const bf16_t* Bt; int K; int lda; };

struct StaticOrder {
    int nM, nN, nwg, G, c;
    __host__ __device__ void init(int M, int N, int G_, int c_) { nM = M / BM; nN = N / BM; nwg = nM * nN; G = G_; c = c_; }
    __host__ __device__ bool next(int i, Unit& u) const {
        const long L = (long)i * G + c; if (L >= nwg) return false;
        int wgid = (int)L; { const int q = nwg / NXCD, r = nwg % NXCD, xcd = wgid % NXCD, off = wgid / NXCD; wgid = (xcd < r ? xcd * (q + 1) : r * (q + 1) + (xcd - r) * q) + off; }
        const int nig = WGM * nN, gid = wgid / nig, fm = gid * WGM, gsz = (nM - fm) < WGM ? (nM - fm) : WGM;
        u.pm = fm + ((wgid % nig) % gsz); u.pn = (wgid % nig) / gsz; return true;
    }
    __device__ __forceinline__ size_t acol(const Unit&) const { return 0; }
    __device__ __forceinline__ void a_ready(const Unit&) const {}
    __device__ __forceinline__ void done(const Unit&) const {}
};
struct GateOrder : StaticOrder {
    __device__ __forceinline__ size_t acol(const Unit& u) const { return (size_t)(u.pn >> 1) * 256; }
};

__device__ __forceinline__ unsigned cvt_pk_bf16(float lo, float hi) { unsigned r; asm volatile("v_cvt_pk_bf16_f32 %0, %1, %2" : "=v"(r) : "v"(lo), "v"(hi)); return r; }
__device__ __forceinline__ float bf_lo(unsigned w) { return __uint_as_float(w << 16); }
__device__ __forceinline__ float bf_hi(unsigned w) { return __uint_as_float(w & 0xffff0000u); }
__device__ __forceinline__ float fast_sigmoid(float x) { return __builtin_amdgcn_rcpf(1.0f + __builtin_amdgcn_exp2f(-1.4426950408889634f * x)); }
__device__ __forceinline__ float gelu_tanh(float x) { const float z = 0.7978845608028654f * (x + 0.044715f * x * x * x); return x * fast_sigmoid(2.0f * z); }

struct EpiF32 {
    static constexpr bool PERM = false, AFTER_DRAIN = false;
    float* C; int ldc;
    __device__ __forceinline__ void operator()(const f32x4 (&acc)[2][2][4][2], const Unit& u, int wr, int wc, int fr, int fq) const {
        const int row0 = u.pm * BM + wr * 64 + fr, col0 = u.pn * BM + wc * 32 + 4 * fq;
#pragma unroll
        for (int ai = 0; ai < 2; ++ai)
#pragma unroll
            for (int m = 0; m < 4; ++m) { float* rowp = C + (size_t)(row0 + ai * HALF + m * 16) * ldc + col0;
#pragma unroll
                for (int bj = 0; bj < 2; ++bj)
#pragma unroll
                    for (int n = 0; n < 2; ++n) *(f32x4*)(rowp + bj * HALF + n * 16) = acc[ai][bj][m][n]; }
    }
};
template <int ACT> struct EpiBf16 {
    static constexpr bool PERM = true, AFTER_DRAIN = false;
    bf16_t* O; int ldc; int split_cols; size_t split_stride; int act_tiles;
    __device__ __forceinline__ void operator()(const f32x4 (&acc)[2][2][4][2], const Unit& u, int wr, int wc, int fr, int fq) const {
        const int row0 = u.pm * BM + wr * 64 + fr; int colt = u.pn * BM; bf16_t* base = O;
        if (split_cols) { const int t = colt / split_cols; base += (size_t)t * split_stride; colt -= t * split_cols; }
        const int col0 = colt + wc * 32 + 8 * fq;
        const bool act = (ACT == 1) && (u.pn < act_tiles);
#pragma unroll
        for (int ai = 0; ai < 2; ++ai)
#pragma unroll
            for (int m = 0; m < 4; ++m) { bf16_t* rowp = base + (size_t)(row0 + ai * HALF + m * 16) * ldc + col0;
#pragma unroll
                for (int bj = 0; bj < 2; ++bj) { f32x4 v0 = acc[ai][bj][m][0], v1 = acc[ai][bj][m][1];
                    if (ACT == 1) { if (act) {
#pragma unroll
                        for (int j = 0; j < 4; ++j) { v0[j] = gelu_tanh(v0[j]); v1[j] = gelu_tanh(v1[j]); } } }
                    u32x4 w; w.x = cvt_pk_bf16(v0[0], v0[1]); w.y = cvt_pk_bf16(v0[2], v0[3]); w.z = cvt_pk_bf16(v1[0], v1[1]); w.w = cvt_pk_bf16(v1[2], v1[3]);
                    *(u32x4*)(rowp + bj * HALF) = w; } }
    }
};
struct EpiQ {
    static constexpr bool PERM = false, AFTER_DRAIN = false;
    bf16_t* Q; const float* cosT; const float* sinT;
    __device__ __forceinline__ void operator()(const f32x4 (&acc)[2][2][4][2], const Unit& u, int wr, int wc, int fr, int fq) const {
        const int row0 = u.pm * BM + wr * 64 + fr; const bool sample = u.pm >= (MCTX / BM);
#pragma unroll
        for (int bj = 0; bj < 2; ++bj) {
            const int col32 = u.pn * BM + bj * HALF + wc * 32, head = col32 / QKD, d32 = col32 - head * QKD;
            const bool rope = sample && (d32 >= NOPE); const int grp = (d32 - NOPE) >> 5;
#pragma unroll
            for (int ai = 0; ai < 2; ++ai)
#pragma unroll
                for (int m = 0; m < 4; ++m) { const int row = row0 + ai * HALF + m * 16;
                    f32x4 v0 = acc[ai][bj][m][0], v1 = acc[ai][bj][m][1];
                    if (rope) { const int pos = (row - MCTX) & 1023; const f32x4 c = *(const f32x4*)(cosT + pos * 32 + grp * 16 + 4 * fq), s = *(const f32x4*)(sinT + pos * 32 + grp * 16 + 4 * fq);
                        const f32x4 y0 = v0 * c - v1 * s, y1 = v1 * c + v0 * s; v0 = y0; v1 = y1; }
                    bf16_t* p = Q + (size_t)row * NQ + col32 + 4 * fq;
                    u32x2 w0, w1; w0.x = cvt_pk_bf16(v0[0], v0[1]); w0.y = cvt_pk_bf16(v0[2], v0[3]); w1.x = cvt_pk_bf16(v1[0], v1[1]); w1.y = cvt_pk_bf16(v1[2], v1[3]);
                    *(u32x2*)p = w0; *(u32x2*)(p + 16) = w1; }
        }
    }
};
struct EpiRes {
    static constexpr bool PERM = false, AFTER_DRAIN = false;
    float* X; const float* gate;
    __device__ __forceinline__ void operator()(const f32x4 (&acc)[2][2][4][2], const Unit& u, int wr, int wc, int fr, int fq) const {
        const int row0 = u.pm * BM + wr * 64 + fr, col0 = u.pn * BM + wc * 32 + 4 * fq;
        const int mod = u.pm < (MCTX / BM) ? 0 : 1 + ((u.pm - MCTX / BM) >> 2);
        const float* gp = gate + (size_t)mod * ADA_N + col0;
        f32x4 gv[2][2];
#pragma unroll
        for (int bj = 0; bj < 2; ++bj)
#pragma unroll
            for (int n = 0; n < 2; ++n) gv[bj][n] = *(const f32x4*)(gp + bj * HALF + n * 16);
#pragma unroll
        for (int ai = 0; ai < 2; ++ai)
#pragma unroll
            for (int m = 0; m < 4; ++m) { float* rowp = X + (size_t)(row0 + ai * HALF + m * 16) * D + col0;
#pragma unroll
                for (int bj = 0; bj < 2; ++bj)
#pragma unroll
                    for (int n = 0; n < 2; ++n) { float* p = rowp + bj * HALF + n * 16; const f32x4 xo = *(const f32x4*)p; *(f32x4*)p = xo + gv[bj][n] * acc[ai][bj][m][n]; }
                asm volatile("" ::: "memory"); }
    }
};
struct EpiGates {
    static constexpr bool PERM = false, AFTER_DRAIN = false;
    bf16_t* LA; bf16_t* UU; const bf16_t* XC; const float* bgx; const float* bga; const float* sp;
    __device__ __forceinline__ void operator()(const f32x4 (&acc)[2][2][4][2], const Unit& u, int wr, int wc, int fr, int fq) const {
        const int blk = u.pn >> 1, dir = u.pn & 1, row0 = u.pm * BM + wr * 64 + fr, ch0 = blk * 128 + wc * 32 + 4 * fq;
        const char* xcb = (const char*)XC; char* lab = (char*)(LA + (size_t)dir * NTOK * D); char* uub = (char*)(UU + (size_t)dir * NTOK * D);
        const float* pbx = bgx + dir * D + ch0; const float* pba = bga + dir * D + ch0; const float* psv = sp + dir * D + ch0;
#pragma unroll
        for (int ai = 0; ai < 2; ++ai)
#pragma unroll
            for (int m = 0; m < 4; ++m) { const unsigned ro = ((unsigned)(row0 + ai * HALF + m * 16) * D + ch0) * 2u;
#pragma unroll
                for (int n = 0; n < 2; ++n) { const u32x2 xw = *(const u32x2*)(xcb + ro + 32 * n); const f32x4 bxn = *(const f32x4*)(pbx + 16 * n), ban = *(const f32x4*)(pba + 16 * n), svn = *(const f32x4*)(psv + 16 * n);
                    const float xv[4] = {bf_lo(xw.x), bf_hi(xw.x), bf_lo(xw.y), bf_hi(xw.y)}; float l2[4], uv[4];
#pragma unroll
                    for (int j = 0; j < 4; ++j) { const float sx = fast_sigmoid(acc[ai][0][m][n][j] + bxn[j]), sa = fast_sigmoid(acc[ai][1][m][n][j] + ban[j]);
                        l2[j] = -sa * svn[j]; const float a2 = __builtin_amdgcn_exp2f(2.0f * l2[j]); uv[j] = __builtin_amdgcn_sqrtf(fmaxf(1.0f - a2, 0.0f)) * sx * xv[j]; }
                    u32x2 wl, wu; wl.x = cvt_pk_bf16(l2[0], l2[1]); wl.y = cvt_pk_bf16(l2[2], l2[3]); wu.x = cvt_pk_bf16(uv[0], uv[1]); wu.y = cvt_pk_bf16(uv[2], uv[3]);
                    *(u32x2*)(lab + ro + 32 * n) = wl; *(u32x2*)(uub + ro + 32 * n) = wu;
                    asm volatile("" ::: "memory"); __builtin_amdgcn_sched_barrier(0); } }
    }
};

template <class Epi, class Sched, bool ALIGN_EPI = false, bool SP2 = false>
__device__ __forceinline__ void gemm_phase(PG8_LAS unsigned char* lds, const Gemm g, const Sched& S, const Epi& E) {
    int tid_ = threadIdx.x; asm volatile("" : "+v"(tid_));
    const int tid = tid_, wid = __builtin_amdgcn_readfirstlane(tid >> 6), lane = tid & 63, wr = wid >> 2, wc = wid & 3, fr = lane & 15, fq = lane >> 4;
    const int K = g.K, nt = K / BK;
    unsigned voffA[2], voffB[2];
#pragma unroll
    for (int i = 0; i < 2; ++i) { int R, C; stage_rc(tid * 16 + i * 8192, R, C); const int Rb = Epi::PERM ? ((R & ~31) + perm32(R & 31)) : R;
        voffA[i] = (unsigned)(R * g.lda + C) * 2u; voffB[i] = (unsigned)(Rb * K + C) * 2u; }
    const size_t kstep = (size_t)(BK * 2);
    const size_t hstepA = (size_t)HALF * g.lda * 2, hstepB = (size_t)HALF * K * 2;
    const size_t tstepA = 2 * hstepA, tstepB = 2 * hstepB;
    const unsigned ldsw = (unsigned)wid * 1024u;
    const int aoff = lds_byte(wr * 64 + fr, fq * 8), boff = lds_byte(wc * 32 + fr, fq * 8);
#define PG8_SA(b, h) (((b) * 2 + (h)) * HTB)
#define PG8_SB(b, h) ((4 + (b) * 2 + (h)) * HTB)
#define PG8_STAGE(bufoff, gbase, voff) do { _Pragma("unroll") for (int _i = 0; _i < 2; ++_i) \
        __builtin_amdgcn_global_load_lds((const unsigned*)((const char*)(gbase) + (voff)[_i]), (PG8_LAS unsigned*)(lds + (bufoff) + ldsw + _i * 8192), 16, 0, 0); } while (0)
#define PG8_LDA(dst, b, h) do { _Pragma("unroll") for (int m = 0; m < 4; ++m) _Pragma("unroll") for (int k = 0; k < 2; ++k) dst[m][k] = *(const PG8_LAS bf16x8*)(lds + PG8_SA(b, h) + aoff + m * 2048 + k * 1024); } while (0)
#define PG8_LDB(dst, b, h) do { _Pragma("unroll") for (int n = 0; n < 2; ++n) _Pragma("unroll") for (int k = 0; k < 2; ++k) dst[n][k] = *(const PG8_LAS bf16x8*)(lds + PG8_SB(b, h) + boff + n * 2048 + k * 1024); } while (0)
#define PG8_MMA(ai, bj, At, Bt) do { __builtin_amdgcn_s_setprio(1); _Pragma("unroll") for (int m = 0; m < 4; ++m) _Pragma("unroll") for (int n = 0; n < 2; ++n) _Pragma("unroll") for (int k = 0; k < 2; ++k) \
        acc[ai][bj][m][n] = __builtin_amdgcn_mfma_f32_16x16x32_bf16(Bt[n][k], At[m][k], acc[ai][bj][m][n], 0, 0, 0); __builtin_amdgcn_s_setprio(0); } while (0)
#define PG8_WAIT_V(n) asm volatile("s_waitcnt vmcnt(" #n ")" ::: "memory")
#define PG8_WAIT_L(n) asm volatile("s_waitcnt lgkmcnt(" #n ")" ::: "memory")
#define PG8_BAR __builtin_amdgcn_s_barrier()
#define PG8_SCHED __builtin_amdgcn_sched_barrier(0)
    Unit cur, nxt; int ui = 0;
    if (!S.next(0, cur)) return;
    f32x4 acc[2][2][4][2];
#pragma unroll
    for (int a = 0; a < 2; ++a)
#pragma unroll
        for (int b = 0; b < 2; ++b)
#pragma unroll
            for (int m = 0; m < 4; ++m)
#pragma unroll
                for (int n = 0; n < 2; ++n) acc[a][b][m][n] = (f32x4){0.f, 0.f, 0.f, 0.f};
    bf16x8 At[4][2], B0[2][2], B1[2][2];
    const char* cA = (const char*)g.A + (size_t)cur.pm * tstepA + S.acol(cur); const char* cB = (const char*)g.Bt + (size_t)cur.pn * tstepB;
    S.a_ready(cur);
    if constexpr (SP2) {
        PG8_STAGE(PG8_SB(0, 0), cB, voffB); PG8_STAGE(PG8_SB(0, 1), cB + hstepB, voffB); PG8_STAGE(PG8_SA(0, 0), cA, voffA); PG8_STAGE(PG8_SA(0, 1), cA + hstepA, voffA);
        if (wr == 1) PG8_BAR;
        PG8_WAIT_V(2); PG8_BAR;
        PG8_STAGE(PG8_SB(1, 0), cB + kstep, voffB); PG8_STAGE(PG8_SA(1, 0), cA + kstep, voffA); PG8_STAGE(PG8_SB(1, 1), cB + hstepB + kstep, voffB);
        PG8_WAIT_V(6); PG8_BAR;
    } else {
        PG8_STAGE(PG8_SB(0, 0), cB, voffB); PG8_STAGE(PG8_SA(0, 0), cA, voffA); PG8_STAGE(PG8_SB(0, 1), cB + hstepB, voffB); PG8_STAGE(PG8_SA(0, 1), cA + hstepA, voffA);
        if (wr == 1) PG8_BAR;
        PG8_WAIT_V(4); PG8_BAR;
        PG8_STAGE(PG8_SB(1, 0), cB + kstep, voffB); PG8_STAGE(PG8_SA(1, 0), cA + kstep, voffA); PG8_STAGE(PG8_SB(1, 1), cB + hstepB + kstep, voffB);
        PG8_WAIT_V(6); PG8_BAR;
    }
    for (;;) {
        const bool has_next = S.next(ui + 1, nxt);
        const char* nA = has_next ? (const char*)g.A + (size_t)nxt.pm * tstepA + S.acol(nxt) : cA; const char* nB = has_next ? (const char*)g.Bt + (size_t)nxt.pn * tstepB : cB;
        for (int t = 0; t < nt; t += 2) {
            const bool last = (t == nt - 2);
            const char* a1 = cA + (size_t)(t + 1) * kstep;
            const char* a2 = last ? nA : cA + (size_t)(t + 2) * kstep; const char* b2 = last ? nB : cB + (size_t)(t + 2) * kstep;
            const char* a3 = a2 + kstep; const char* b3 = b2 + kstep;
            if (last && has_next) S.a_ready(nxt);
            if constexpr (SP2) {
            PG8_LDB(B0, 0, 0); PG8_LDB(B1, 0, 1); PG8_SCHED; PG8_LDA(At, 0, 0); PG8_STAGE(PG8_SA(1, 1), a1 + hstepA, voffA);
            PG8_WAIT_V(8); PG8_WAIT_L(0); PG8_BAR; PG8_MMA(0, 0, At, B0); PG8_MMA(0, 1, At, B1); PG8_BAR; PG8_SCHED;
            PG8_LDA(At, 0, 1); PG8_STAGE(PG8_SB(0, 0), b2, voffB); PG8_STAGE(PG8_SB(0, 1), b2 + hstepB, voffB); PG8_STAGE(PG8_SA(0, 0), a2, voffA);
            PG8_WAIT_V(8); PG8_WAIT_L(0); PG8_BAR; PG8_MMA(1, 0, At, B0); PG8_MMA(1, 1, At, B1); PG8_BAR; PG8_SCHED;
            PG8_LDB(B0, 1, 0); PG8_LDB(B1, 1, 1); PG8_SCHED; PG8_LDA(At, 1, 0); PG8_STAGE(PG8_SA(0, 1), a2 + hstepA, voffA);
            PG8_WAIT_V(8); PG8_WAIT_L(0); PG8_BAR; PG8_MMA(0, 0, At, B0); PG8_MMA(0, 1, At, B1); PG8_BAR; PG8_SCHED;
            PG8_LDA(At, 1, 1); PG8_STAGE(PG8_SB(1, 0), b3, voffB); PG8_STAGE(PG8_SB(1, 1), b3 + hstepB, voffB); PG8_STAGE(PG8_SA(1, 0), a3, voffA);
            PG8_WAIT_V(8); PG8_WAIT_L(0); PG8_BAR; PG8_MMA(1, 0, At, B0); PG8_MMA(1, 1, At, B1); PG8_BAR; PG8_SCHED;
            } else {
            PG8_LDB(B0, 0, 0); PG8_SCHED; PG8_LDA(At, 0, 0); PG8_STAGE(PG8_SA(1, 1), a1 + hstepA, voffA);
            PG8_WAIT_L(8); PG8_BAR; PG8_WAIT_L(0); PG8_MMA(0, 0, At, B0); PG8_BAR; PG8_SCHED;
            PG8_LDB(B1, 0, 1); PG8_STAGE(PG8_SB(0, 0), b2, voffB);
            PG8_BAR; PG8_WAIT_L(0); PG8_MMA(0, 1, At, B1); PG8_BAR;
            PG8_LDA(At, 0, 1); PG8_STAGE(PG8_SA(0, 0), a2, voffA);
            PG8_BAR; PG8_WAIT_L(0); PG8_MMA(1, 0, At, B0); PG8_BAR; PG8_SCHED;
            PG8_STAGE(PG8_SB(0, 1), b2 + hstepB, voffB);
            PG8_WAIT_V(6); PG8_BAR; PG8_MMA(1, 1, At, B1); PG8_BAR;
            PG8_LDB(B0, 1, 0); PG8_SCHED; PG8_LDA(At, 1, 0); PG8_STAGE(PG8_SA(0, 1), a2 + hstepA, voffA);
            PG8_WAIT_L(8); PG8_BAR; PG8_WAIT_L(0); PG8_MMA(0, 0, At, B0); PG8_BAR; PG8_SCHED;
            PG8_LDB(B1, 1, 1); PG8_STAGE(PG8_SB(1, 0), b3, voffB);
            PG8_BAR; PG8_WAIT_L(0); PG8_MMA(0, 1, At, B1); PG8_BAR;
            PG8_LDA(At, 1, 1); PG8_STAGE(PG8_SA(1, 0), a3, voffA);
            PG8_BAR; PG8_WAIT_L(0); PG8_MMA(1, 0, At, B0); PG8_BAR; PG8_SCHED;
            PG8_STAGE(PG8_SB(1, 1), b3 + hstepB, voffB);
            PG8_WAIT_V(6); PG8_BAR; PG8_MMA(1, 1, At, B1); PG8_BAR;
            }
        }
        if constexpr (ALIGN_EPI) { if (wr == 0) PG8_BAR; }
        if constexpr (!Epi::AFTER_DRAIN) { int t2 = threadIdx.x; asm volatile("" : "+v"(t2));
            E(acc, cur, wr, wc, t2 & 15, (t2 & 63) >> 4); S.done(cur); }
        if (!has_next) break;
#pragma unroll
        for (int a = 0; a < 2; ++a)
#pragma unroll
            for (int b = 0; b < 2; ++b)
#pragma unroll
                for (int m = 0; m < 4; ++m)
#pragma unroll
                    for (int n = 0; n < 2; ++n) acc[a][b][m][n] = (f32x4){0.f, 0.f, 0.f, 0.f};
        cur = nxt; cA = nA; cB = nB; ++ui;
        if constexpr (ALIGN_EPI) { if (wr == 1) PG8_BAR; }
    }
    PG8_WAIT_V(0);
    if constexpr (!ALIGN_EPI) { if (wr == 0) PG8_BAR; }
    PG8_BAR;
    if constexpr (Epi::AFTER_DRAIN) { E.fused(acc, cur, wr, wc, fr, fq, lds, wid, lane); S.done(cur); }
#undef PG8_SA
#undef PG8_SB
#undef PG8_STAGE
#undef PG8_LDA
#undef PG8_LDB
#undef PG8_MMA
#undef PG8_WAIT_V
#undef PG8_WAIT_L
#undef PG8_BAR
#undef PG8_SCHED
}
}

#define GAS __attribute__((address_space(1)))
#define LAS __attribute__((address_space(3)))
typedef unsigned short bf16;
typedef unsigned v4u __attribute__((ext_vector_type(4)));
typedef float f32x4 __attribute__((ext_vector_type(4)));
typedef short bf16x8 __attribute__((ext_vector_type(8)));
typedef GAS unsigned gu32;
typedef GAS unsigned long long gu64;
#define RLX_AGENT __ATOMIC_RELAXED, __HIP_MEMORY_SCOPE_AGENT
#define LDS_WAIT() asm volatile("s_waitcnt lgkmcnt(0)" ::: "memory")
#define VM_WAIT() asm volatile("s_waitcnt vmcnt(0)" ::: "memory")
__device__ __forceinline__ unsigned long long rt() { return __builtin_amdgcn_s_memrealtime(); }
__device__ __forceinline__ unsigned f2bf(float f) { unsigned u = __builtin_bit_cast(unsigned, f); return (u + 0x7fffu + ((u >> 16) & 1u)) >> 16; }
__device__ __forceinline__ unsigned pk2(float lo, float hi) { return f2bf(lo) | (f2bf(hi) << 16); }

#define XB_TMO      128
#define XB_XCNT(j)  (256  + 64 * (j))
#define XB_XSUB(j)  (1280 + 64 * (j))
#define XB_XGEN(j)  (2304 + 64 * (j))
#define XB_TOP      3328
#define XB_TOPGEN   3392
#define XCD_BAR_WORDS 3456
#define XB_SPIN_CAP (1u << 18)

__device__ __forceinline__ unsigned xb_ld(unsigned* p)              { return __hip_atomic_load(p, __ATOMIC_RELAXED, __HIP_MEMORY_SCOPE_AGENT); }
__device__ __forceinline__ unsigned xb_add(unsigned* p, unsigned v) { return __hip_atomic_fetch_add(p, v, __ATOMIC_RELAXED, __HIP_MEMORY_SCOPE_AGENT); }
__device__ __forceinline__ unsigned xb_xcc_id() { return (unsigned)__builtin_amdgcn_s_getreg((3 << 11) | 20) & 0xFu; }
#define XB_SPIN(cond, bar) do { unsigned _sp = 0; while (cond) { __builtin_amdgcn_s_sleep(1); \
    if ((++_sp & 255u) == 0u) { if (xb_ld(&(bar)[XB_TMO])) break; if (_sp > XB_SPIN_CAP) { atomicAdd(&(bar)[XB_TMO], 1u); break; } } } } while (0)

struct XcdBarrier {
    unsigned* bar; unsigned x;
    volatile LAS unsigned* st;
};

__device__ __forceinline__ XcdBarrier xcd_barrier_post(unsigned* bar, volatile LAS unsigned* st) {
    XcdBarrier b; b.bar = bar; b.x = xb_xcc_id(); b.st = st;
    if (threadIdx.x == 0) (void)xb_add(&bar[XB_XCNT(b.x)], 1u);
    return b;
}
__device__ __forceinline__ void xcd_barrier_complete(unsigned* bar, unsigned x, unsigned& nloc, unsigned& nx) {
    const unsigned G = gridDim.x * gridDim.y * gridDim.z;
    unsigned sum, cnt, mine, sp = 0u;
    for (;;) {
        sum = 0u; cnt = 0u; mine = 0u;
#pragma unroll
        for (unsigned j = 0; j < 16; ++j) { const unsigned c = xb_ld(&bar[XB_XCNT(j)]); sum += c; cnt += (c > 0u) ? 1u : 0u; mine = (j == x) ? c : mine; }
        if (sum == G) break;
        __builtin_amdgcn_s_sleep(1);
        if ((++sp & 255u) == 0u) { if (xb_ld(&bar[XB_TMO])) break; if (sp > XB_SPIN_CAP) { atomicAdd(&bar[XB_TMO], 1u); break; } }
    }
    nloc = mine > 0u ? mine : 1u; nx = cnt > 0u ? cnt : 1u;
}

__device__ __forceinline__ void xcd_barrier(const XcdBarrier& b) {
    asm volatile("s_waitcnt vmcnt(0)" ::: "memory");
    __syncthreads();
    if (threadIdx.x == 0) {
        unsigned* bar = b.bar;
        __builtin_amdgcn_s_waitcnt(0);
        unsigned nloc = b.st[0], nx = b.st[1];
        if (nloc == 0u) { xcd_barrier_complete(bar, b.x, nloc, nx); b.st[0] = nloc; b.st[1] = nx; }
        const unsigned old = xb_add(&bar[XB_XSUB(b.x)], 1u);
        const unsigned gen = old / nloc;
        if (old + 1u == (gen + 1u) * nloc) {
            __builtin_amdgcn_fence(__ATOMIC_RELEASE, "agent");
            asm volatile("s_waitcnt vmcnt(0)" ::: "memory");
            const unsigned og = xb_add(&bar[XB_TOP], 1u);
            const unsigned tg = og / nx;
            if (og + 1u == (tg + 1u) * nx) xb_add(&bar[XB_TOPGEN], 1u);
            else XB_SPIN(xb_ld(&bar[XB_TOPGEN]) == tg, bar);
            __builtin_amdgcn_fence(__ATOMIC_ACQUIRE, "agent");
            xb_add(&bar[XB_XGEN(b.x)], 1u);
            asm volatile("s_waitcnt vmcnt(0)" ::: "memory");
        } else {
            XB_SPIN(xb_ld(&bar[XB_XGEN(b.x)]) == gen, bar);
            __builtin_amdgcn_fence(__ATOMIC_ACQUIRE, "agent");
            asm volatile("s_waitcnt vmcnt(0)" ::: "memory");
        }
    }
    __syncthreads();
}

namespace att {
using bf16x8 = __attribute__((ext_vector_type(8))) short;
using s16x4  = __attribute__((ext_vector_type(4))) short;
using f32x16 = __attribute__((ext_vector_type(16))) float;
using u32x4  = __attribute__((ext_vector_type(4))) unsigned;
typedef unsigned short bf16;
constexpr int QBLK = 32, KVBLK = 64, NW = 8;
constexpr float SCALE = 0.07216878364870322f;
constexpr float THR = 8.f;
constexpr int LDQ = NQ, LDKN = D, LDKR = ROPE, LDV = D, LDO = D;
constexpr int SHM_V = KVBLK * 128 * 2, SHM_K = KVBLK * 128 * 2, SHM_R = KVBLK * 64 * 2;
constexpr int OFF_V = 0, OFF_K = 2 * SHM_V, OFF_R = OFF_K + 2 * SHM_K, OFF_WS = OFF_R + 2 * SHM_R, ATTN_LDS_BYTES = OFF_WS + NW * 64 * 4;
#define KSWZ(row, colB) ((row) * 256 + ((colB) ^ (((row) & 7) << 4)))
#define RSWZ(row, colB) ((row) * 128 + ((colB) ^ ((((row) >> 1) & 7) << 4)))
#define SBAR() __builtin_amdgcn_sched_barrier(0)
__device__ __forceinline__ int crow(int r, int hi) { return (r & 3) + 8 * (r >> 2) + 4 * hi; }
__device__ __forceinline__ unsigned cvtpk(float lo, float hi) { unsigned r; asm volatile("v_cvt_pk_bf16_f32 %0, %1, %2" : "=v"(r) : "v"(lo), "v"(hi)); return r; }

__device__ __forceinline__ void partialSM(f32x16& p0, f32x16& p1, float& m_reg, float& mn, float& alpha) {
  constexpr float C = SCALE * 1.4426950408889634f;
  float pmax = p0[0];
#pragma unroll
  for (int r = 1; r < 16; ++r) pmax = fmaxf(pmax, p0[r]);
#pragma unroll
  for (int r = 0; r < 16; ++r) pmax = fmaxf(pmax, p1[r]);
  { auto rr = __builtin_amdgcn_permlane32_swap(__float_as_uint(pmax), __float_as_uint(pmax), false, false);
    pmax = fmaxf(__uint_as_float(rr[0]), __uint_as_float(rr[1])); }
  if (__builtin_expect(__all(pmax - m_reg <= THR / SCALE), 1)) { mn = m_reg; alpha = 1.f; }
  else { mn = fmaxf(m_reg, pmax); alpha = __builtin_amdgcn_exp2f((m_reg - mn) * C); m_reg = mn; }
  float mnC = -mn * C;
#pragma unroll
  for (int r = 0; r < 16; ++r) p0[r] = fmaf(p0[r], C, mnC);
#pragma unroll
  for (int r = 0; r < 16; ++r) p1[r] = fmaf(p1[r], C, mnC);
#pragma unroll
  for (int r = 0; r < 16; ++r) p0[r] = __builtin_amdgcn_exp2f(p0[r]);
}
__device__ __forceinline__ void finishSM(f32x16& p0, f32x16& p1, float alpha, float& l_reg, bf16x8& pa0, bf16x8& pa1, bf16x8& pa2, bf16x8& pa3) {
#pragma unroll
  for (int r = 0; r < 16; ++r) p1[r] = __builtin_amdgcn_exp2f(p1[r]);
  float ps = 0;
#pragma unroll
  for (int r = 0; r < 16; ++r) ps += p0[r];
#pragma unroll
  for (int r = 0; r < 16; ++r) ps += p1[r];
  { auto rr = __builtin_amdgcn_permlane32_swap(__float_as_uint(ps), __float_as_uint(ps), false, false);
    ps = __uint_as_float(rr[0]) + __uint_as_float(rr[1]); }
  l_reg = l_reg * alpha + ps;
#define PK4(P, BASE, OUT) do { unsigned a0 = cvtpk(P[BASE + 0], P[BASE + 1]), a1 = cvtpk(P[BASE + 2], P[BASE + 3]);   \
    unsigned b0 = cvtpk(P[BASE + 4], P[BASE + 5]), b1 = cvtpk(P[BASE + 6], P[BASE + 7]);                              \
    auto r0 = __builtin_amdgcn_permlane32_swap(a0, b0, false, false); auto r1 = __builtin_amdgcn_permlane32_swap(a1, b1, false, false); \
    u32x4 w = {r0[0], r1[0], r0[1], r1[1]}; OUT = *reinterpret_cast<bf16x8*>(&w); } while (0)
  PK4(p0, 0, pa0); PK4(p0, 8, pa1); PK4(p1, 0, pa2); PK4(p1, 8, pa3);
#undef PK4
}
__device__ __forceinline__ void qkt(f32x16& p0, f32x16& p1, const char* Ks, const char* Rs, const bf16x8* qr, int r32, int hi) {
  p0 = f32x16{}; p1 = f32x16{};
#pragma unroll
  for (int d0 = 0; d0 < 8; ++d0) { const int cb = (d0 * 16 + hi * 8) * 2;
    bf16x8 b0 = *reinterpret_cast<const bf16x8*>(Ks + KSWZ(r32, cb));
    bf16x8 b1 = *reinterpret_cast<const bf16x8*>(Ks + KSWZ(32 + r32, cb));
    p0 = __builtin_amdgcn_mfma_f32_32x32x16_bf16(b0, qr[d0], p0, 0, 0, 0);
    p1 = __builtin_amdgcn_mfma_f32_32x32x16_bf16(b1, qr[d0], p1, 0, 0, 0); }
#pragma unroll
  for (int d0 = 0; d0 < 4; ++d0) { const int cb = (d0 * 16 + hi * 8) * 2;
    bf16x8 b0 = *reinterpret_cast<const bf16x8*>(Rs + RSWZ(r32, cb));
    bf16x8 b1 = *reinterpret_cast<const bf16x8*>(Rs + RSWZ(32 + r32, cb));
    p0 = __builtin_amdgcn_mfma_f32_32x32x16_bf16(b0, qr[8 + d0], p0, 0, 0, 0);
    p1 = __builtin_amdgcn_mfma_f32_32x32x16_bf16(b1, qr[8 + d0], p1, 0, 0, 0); }
}
__device__ __forceinline__ int v_st(int k, int c) { const int kk = (k & ~0xC) | ((k & 4) << 1) | ((k & 8) >> 1); return ((kk >> 3) * 4 + (c >> 5)) * 512 + ((kk & 7) * 32 + (c & 31)) * 2; }
__device__ __forceinline__ int v_rd_base(int lane) { return ((lane & 3) << 3) | (((lane >> 2) & 3) << 6) | (((lane >> 4) & 1) << 5) | (((lane >> 5) & 1) << 8); }
constexpr int v_rd_off(int d0, int ks, int half) { return d0 * 512 + ks * 4096 + half * 2048; }
template <int OFF> __device__ __forceinline__ s16x4 tr_read(int vb) {
  s16x4 r; asm volatile("ds_read_b64_tr_b16 %0, %1 offset:%2" : "=&v"(r) : "v"(vb), "i"(OFF) : "memory"); return r;
}
template <int D0> __device__ __forceinline__ void pv_one(f32x16& od, int vb, bf16x8 pa0, bf16x8 pa1, bf16x8 pa2, bf16x8 pa3) {
  const s16x4 l0 = tr_read<v_rd_off(D0, 0, 0)>(vb), h0 = tr_read<v_rd_off(D0, 0, 1)>(vb), l1 = tr_read<v_rd_off(D0, 1, 0)>(vb), h1 = tr_read<v_rd_off(D0, 1, 1)>(vb);
  const s16x4 l2 = tr_read<v_rd_off(D0, 2, 0)>(vb), h2 = tr_read<v_rd_off(D0, 2, 1)>(vb), l3 = tr_read<v_rd_off(D0, 3, 0)>(vb), h3 = tr_read<v_rd_off(D0, 3, 1)>(vb);
  asm volatile("s_waitcnt lgkmcnt(0)" ::: "memory"); SBAR();
#define PK(L, H) (bf16x8){L[0], L[1], L[2], L[3], H[0], H[1], H[2], H[3]}
  od = __builtin_amdgcn_mfma_f32_32x32x16_bf16(pa0, PK(l0, h0), od, 0, 0, 0);
  od = __builtin_amdgcn_mfma_f32_32x32x16_bf16(pa1, PK(l1, h1), od, 0, 0, 0);
  od = __builtin_amdgcn_mfma_f32_32x32x16_bf16(pa2, PK(l2, h2), od, 0, 0, 0);
  od = __builtin_amdgcn_mfma_f32_32x32x16_bf16(pa3, PK(l3, h3), od, 0, 0, 0);
#undef PK
}
__device__ __forceinline__ void pv_d0(f32x16* o, int vb, bf16x8 pa0, bf16x8 pa1, bf16x8 pa2, bf16x8 pa3) {
  pv_one<0>(o[0], vb, pa0, pa1, pa2, pa3); pv_one<1>(o[1], vb, pa0, pa1, pa2, pa3); pv_one<2>(o[2], vb, pa0, pa1, pa2, pa3); pv_one<3>(o[3], vb, pa0, pa1, pa2, pa3);
}

__device__ __forceinline__ void attn_unit(const bf16* __restrict__ Qb, const bf16* __restrict__ Kn, const bf16* __restrict__ Kr, const bf16* __restrict__ Vh,
                                          bf16* __restrict__ Ob, int seq, char* lds) {
  int tid_ = threadIdx.x; asm volatile("" : "+v"(tid_));
  const int tid = tid_, wid = tid >> 6, lane = tid & 63, r32 = lane & 31, hi = lane >> 5;
  char* V_lds = lds + OFF_V; char* K_lds = lds + OFF_K; char* R_lds = lds + OFF_R;
  float* ws = (float*)(lds + OFF_WS) + wid * 64; float* li_l = ws; float* al_l = ws + 32;
  float m_reg = -1e30f, l_reg = 0; f32x16 o[4] = {}; bf16x8 qr[12];
  const bf16* Qw = Qb + (long)(wid * QBLK + r32) * LDQ + hi * 8;
#pragma unroll
  for (int d0 = 0; d0 < 12; ++d0) qr[d0] = *reinterpret_cast<const bf16x8*>(Qw + d0 * 16);
  const int sr = tid >> 4, sc = (tid & 15) * 8, vst0 = v_st(sr, sc), vst1 = v_st(32 + sr, sc);
  const int rr_ = tid >> 3, rc_ = (tid & 7) * 8;
  const int vb0 = (int)(uintptr_t)V_lds + v_rd_base(lane);
  bf16x8 vs0, vs1, ks0, ks1, rs;
#define SLOAD(k0) do { vs0 = *reinterpret_cast<const bf16x8*>(&Vh[(long)((k0) + sr) * LDV + sc]); vs1 = *reinterpret_cast<const bf16x8*>(&Vh[(long)((k0) + 32 + sr) * LDV + sc]); \
    ks0 = *reinterpret_cast<const bf16x8*>(&Kn[(long)((k0) + sr) * LDKN + sc]); ks1 = *reinterpret_cast<const bf16x8*>(&Kn[(long)((k0) + 32 + sr) * LDKN + sc]); \
    rs = *reinterpret_cast<const bf16x8*>(&Kr[(long)((k0) + rr_) * LDKR + rc_]); } while (0)
#define SWRITE(b) do { *(bf16x8*)(V_lds + (b) * SHM_V + vst0) = vs0;          \
    *(bf16x8*)(V_lds + (b) * SHM_V + vst1) = vs1; const int kc = sc * 2;               \
    *(bf16x8*)(K_lds + (b) * SHM_K + KSWZ(sr, kc)) = ks0;                       \
    *(bf16x8*)(K_lds + (b) * SHM_K + KSWZ(32 + sr, kc)) = ks1;                  \
    *(bf16x8*)(R_lds + (b) * SHM_R + RSWZ(rr_, rc_ * 2)) = rs; } while (0)
#define RESC(a) do { if (__any((a) < 1.f)) { if (hi == 0) al_l[r32] = (a); asm volatile("s_waitcnt lgkmcnt(0)" ::: "memory"); \
    _Pragma("unroll") for (int d = 0; d < 4; ++d) _Pragma("unroll") for (int r = 0; r < 16; ++r) o[d][r] *= al_l[crow(r, hi)]; } } while (0)
  f32x16 p0, p1; float mn, al; bf16x8 pa0, pa1, pa2, pa3; const int NT = seq / KVBLK;
  SLOAD(0); asm volatile("s_waitcnt vmcnt(0)" ::: "memory"); SWRITE(0); __syncthreads();
  for (int j = 0; j < NT; j += 2) {
    SLOAD((j + 1) * KVBLK); SBAR();
    qkt(p0, p1, K_lds, R_lds, qr, r32, hi); partialSM(p0, p1, m_reg, mn, al); finishSM(p0, p1, al, l_reg, pa0, pa1, pa2, pa3); RESC(al); SBAR();
    pv_d0(o, vb0, pa0, pa1, pa2, pa3);
    SWRITE(1); __syncthreads();
    if (j + 2 < NT) SLOAD((j + 2) * KVBLK); SBAR();
    qkt(p0, p1, K_lds + SHM_K, R_lds + SHM_R, qr, r32, hi); partialSM(p0, p1, m_reg, mn, al); finishSM(p0, p1, al, l_reg, pa0, pa1, pa2, pa3); RESC(al); SBAR();
    pv_d0(o, vb0 + SHM_V, pa0, pa1, pa2, pa3);
    if (j + 2 < NT) SWRITE(0);
    __syncthreads();
  }
  if (hi == 0) li_l[r32] = l_reg; asm volatile("s_waitcnt lgkmcnt(0)" ::: "memory");
  float rli[16];
#pragma unroll
  for (int r = 0; r < 16; ++r) rli[r] = __builtin_amdgcn_rcpf(li_l[crow(r, hi)]);
  bf16* Ow = Ob + (long)(wid * QBLK) * LDO;
#pragma unroll
  for (int r = 0; r < 16; ++r) { const int orow = crow(r, hi);
#pragma unroll
    for (int d0 = 0; d0 < 4; ++d0) Ow[(long)orow * LDO + d0 * 32 + r32] = (bf16)(cvtpk(o[d0][r] * rli[r], 0.f) & 0xffffu); }
#undef SLOAD
#undef SWRITE
#undef RESC
}
}

constexpr size_t MiB = 1u << 20;
constexpr size_t WS_CTL = 0, CTL_ZERO_BYTES = 64 * 1024;
constexpr size_t WS_MODS = 1 * MiB;
constexpr size_t WS_COS = 3 * MiB, WS_SIN = WS_COS + 128 * 1024, WS_SP = WS_SIN + 128 * 1024;
constexpr size_t WS_WIN = 4 * MiB, WS_WUQ = 14 * MiB, WS_WUKV = 20 * MiB, WS_WO = 28 * MiB, WS_WRIN = 44 * MiB, WS_WG = 76 * MiB, WS_WROUT = 80 * MiB, WS_WUP = 96 * MiB, WS_WDN = 272 * MiB;
constexpr size_t WS_X = 360 * MiB, WS_H = 488 * MiB, WS_S = 552 * MiB, WS_END = 1192 * MiB;
constexpr size_t WS_U = WS_S, WS_ACT = WS_S + 352 * MiB;
constexpr size_t WS_PROJ = WS_S, WS_CQ = WS_S + 80 * MiB, WS_CKV = WS_S + 96 * MiB, WS_KR = WS_S + 114 * MiB, WS_Q = WS_S + 117 * MiB, WS_KN = WS_S + 213 * MiB, WS_V = WS_S + 285 * MiB, WS_O = WS_S + 357 * MiB;
constexpr size_t WS_RIN = WS_S, WS_XC = WS_S + 128 * MiB, WS_LA = WS_S + 192 * MiB, WS_UU = WS_S + 320 * MiB, WS_HB = WS_S + 448 * MiB, WS_MIX = WS_S + 576 * MiB;
static_assert(WS_WIN + 2ull * NINP * D * 2 <= WS_WUQ && WS_WUQ + 2ull * NQ * QL * 2 <= WS_WUKV && WS_WUKV + 2ull * NKV * KVL * 2 <= WS_WO && WS_WO + 2ull * D * D * 2 <= WS_WRIN, "ws map 1");
static_assert(WS_WRIN + 2ull * 2 * D * D * 2 <= WS_WG && WS_WG + 2ull * 8192 * 128 * 2 <= WS_WROUT && WS_WROUT + 2ull * D * D * 2 <= WS_WUP && WS_WUP + 4ull * NUP * D * 2 <= WS_WDN && WS_WDN + 4ull * D * DFF * 2 <= WS_X, "ws map 2");
static_assert(WS_X + (size_t)NTOK * D * 4 <= WS_H && WS_H + (size_t)NTOK * D * 2 <= WS_S, "ws map 3");
static_assert(WS_U + (size_t)NTOK * NUP * 2 <= WS_ACT && WS_ACT + (size_t)NTOK * DFF * 2 <= WS_END, "ws map ffn");
static_assert(WS_PROJ + (size_t)NTOK * NINP * 4 <= WS_CQ && WS_CQ + (size_t)NTOK * QL * 2 <= WS_CKV && WS_CKV + (size_t)MKV * KVL * 2 <= WS_KR && WS_KR + (size_t)MKV * ROPE * 2 <= WS_Q && WS_Q + (size_t)NTOK * NQ * 2 <= WS_KN
              && WS_KN + (size_t)MKV * D * 2 <= WS_V && WS_V + (size_t)MKV * D * 2 <= WS_O && WS_O + (size_t)NTOK * D * 2 <= WS_END, "ws map attn");
static_assert(WS_RIN + (size_t)NTOK * 2 * D * 2 <= WS_XC && WS_XC + (size_t)NTOK * D * 2 <= WS_LA && WS_LA + 2ull * NTOK * D * 2 <= WS_UU && WS_UU + 2ull * NTOK * D * 2 <= WS_HB && WS_HB + (size_t)NTOK * D * 4 <= WS_MIX && WS_MIX + (size_t)NTOK * D * 2 <= WS_END, "ws map rec");
constexpr int CW_BAR = 1024;
constexpr size_t OUT_Y = 0, OUT_CKV = 2ull * MCTX * D, OUT_KR = OUT_CKV + 32ull * 2 * 256 * KVL, OUT_ST = OUT_KR + 32ull * 2 * 256 * ROPE, OUT_TOTAL = OUT_ST + 32ull * 2 * 2 * D;

constexpr int NWAVES = 8;
constexpr int RING_OFF = 0, RING_BYTES = 131072;
constexpr int LDSCTL_OFF = RING_BYTES, MISC_OFF = LDSCTL_OFF + 320;
constexpr int LDS_BYTES = 147456;
static_assert(MISC_OFF + 128 <= LDS_BYTES && att::ATTN_LDS_BYTES <= RING_BYTES, "LDS map");

struct Args { const float* in[32]; float* out; unsigned char* ws; int ph_lo, ph_hi; };
static_assert(sizeof(Args) == 34 * 8 + 8, "Args has no padding");
struct Frame {
    LAS unsigned char* lds;
    volatile LAS unsigned* MISC;
    int tid, lane, wave;
    int vcu, G;
    float* out;
    unsigned char* ws;
};
__device__ __forceinline__ float shfl_xor_l(float v, int mask, int lane) { return __int_as_float(__builtin_amdgcn_ds_bpermute((lane ^ mask) << 2, __float_as_int(v))); }
__device__ __forceinline__ float wave_sum(float v, int lane) {
#pragma unroll
    for (int o = 1; o < 64; o <<= 1) v += shfl_xor_l(v, o, lane);
    return v;
}
__device__ __forceinline__ int mod_of_row(int m) { return m < MCTX ? 0 : 1 + ((m - MCTX) >> 10); }
__device__ __forceinline__ int kv_row(int m) { return m < MCTX ? m : MCTX + ((m - MCTX) >> 10) * 1280 + 256 + ((m - MCTX) & 1023); }

__device__ __forceinline__ void p0_transpose_item(const float* W, int K, int N, bf16* WT, int row_off, LAS float* scr, int item, int lane) {
    const int nblk = N / 32, kb = item / nblk, nb = item % nblk, k0 = 64 * kb, n0 = 32 * nb;
#pragma unroll 8
    for (int i = 0; i < 32; ++i) { const int kk = 2 * i + (lane >> 5); scr[kk * 33 + (lane & 31)] = W[(size_t)(k0 + kk) * N + n0 + (lane & 31)]; }
    LDS_WAIT(); asm volatile("" ::: "memory");
    const int c = lane & 7;
#pragma unroll
    for (int j = 0; j < 4; ++j) { const int n = (lane >> 3) + 8 * j; const LAS float* s = scr + (8 * c) * 33 + n;
        v4u o; o.x = pk2(s[0 * 33], s[1 * 33]); o.y = pk2(s[2 * 33], s[3 * 33]); o.z = pk2(s[4 * 33], s[5 * 33]); o.w = pk2(s[6 * 33], s[7 * 33]);
        *(GAS v4u*)(WT + (size_t)(row_off + n0 + n) * K + k0 + 8 * c) = o; }
    LDS_WAIT(); asm volatile("" ::: "memory");
}

__device__ __forceinline__ void ada_task(Frame& F, const Args& A, int task) {
    const int layer = task / 48, cchunk = task % 48;
    LAS float* S = (LAS float*)(F.lds + RING_OFF);
    const float* c_ctx = A.in[6]; const float* cc = A.in[5];
    for (int idx = F.tid; idx < NMOD * D; idx += NWAVES * 64) { const int q = idx / D, k = idx % D; const float v = q == 0 ? c_ctx[k] : cc[(q - 1) * D + k];
        S[k * 12 + q] = v / (1.0f + __expf(-v)); }
    __syncthreads();
    f32x4 acc[NMOD];
#pragma unroll
    for (int q = 0; q < NMOD; ++q) acc[q] = (f32x4){0.f, 0.f, 0.f, 0.f};
    const int k0 = F.wave * 256;
    const float* wp = A.in[10] + ((size_t)layer * D + k0) * ADA_N + cchunk * 256 + F.lane * 4;
    for (int kk = 0; kk < 256; kk += 8) {
        f32x4 w[8];
#pragma unroll
        for (int i = 0; i < 8; ++i) w[i] = *(const GAS f32x4*)(wp + (size_t)(kk + i) * ADA_N);
#pragma unroll
        for (int i = 0; i < 8; ++i) { const LAS f32x4* sp = (const LAS f32x4*)(S + (k0 + kk + i) * 12); const f32x4 s0 = sp[0], s1 = sp[1], s2 = sp[2];
            acc[0] += s0.x * w[i]; acc[1] += s0.y * w[i]; acc[2] += s0.z * w[i]; acc[3] += s0.w * w[i];
            acc[4] += s1.x * w[i]; acc[5] += s1.y * w[i]; acc[6] += s1.z * w[i]; acc[7] += s1.w * w[i]; acc[8] += s2.x * w[i]; }
    }
    __syncthreads();
    LAS float* R = (LAS float*)(F.lds + RING_OFF);
#pragma unroll
    for (int q = 0; q < NMOD; ++q) *(LAS f32x4*)(R + (F.wave * NMOD + q) * 256 + F.lane * 4) = acc[q];
    __syncthreads();
    float* mods = (float*)(F.ws + WS_MODS); const float* b_ada = A.in[11];
    for (int idx = F.tid; idx < NMOD * 256; idx += NWAVES * 64) { const int q = idx >> 8, cl = idx & 255; float s = b_ada[layer * ADA_N + cchunk * 256 + cl];
#pragma unroll
        for (int w = 0; w < NWAVES; ++w) s += R[(w * NMOD + q) * 256 + cl];
        mods[(size_t)(layer * NMOD + q) * ADA_N + cchunk * 256 + cl] = s; }
    __syncthreads();
}
__device__ __forceinline__ void p0_prologue(Frame& F, const Args& A) {
    if (F.vcu < 192) ada_task(F, A, F.vcu);
    LAS float* scr = (LAS float*)(F.lds + RING_OFF + F.wave * 16384);
    const int gw = F.vcu * NWAVES + F.wave, NGW = F.G * NWAVES;
    bf16* ws16 = (bf16*)F.ws;
    constexpr int I_IN = (D / 64) * (NIN / 32), I_UQ = (QL / 64) * (NQ / 32), I_UK = (KVL / 64) * (D / 32), I_O = (D / 64) * (D / 32), I_RIN = (D / 64) * (2 * D / 32), I_G = 2 * 16 * 8, I_UP = (D / 64) * (NUP / 32), I_DN = (DFF / 64) * (D / 32);
    constexpr int PER_J = I_IN + I_UQ + 2 * I_UK + I_O + I_RIN + I_O + 2 * I_G;
    constexpr int NITEMS = 2 * PER_J + 4 * (I_UP + I_DN);
    for (int it = gw; it < NITEMS; it += NGW) {
        int r = it;
        if (r < 2 * PER_J) {
            const int j = r / PER_J; r -= j * PER_J;
            if (r < I_IN) { p0_transpose_item(A.in[12] + (size_t)j * D * NIN, D, NIN, (bf16*)(F.ws + WS_WIN) + (size_t)j * NINP * D, 0, scr, r, F.lane); continue; } r -= I_IN;
            if (r < I_UQ) { p0_transpose_item(A.in[15] + (size_t)j * QL * NQ, QL, NQ, (bf16*)(F.ws + WS_WUQ) + (size_t)j * NQ * QL, 0, scr, r, F.lane); continue; } r -= I_UQ;
            if (r < I_UK) { p0_transpose_item(A.in[16] + (size_t)j * KVL * D, KVL, D, (bf16*)(F.ws + WS_WUKV) + (size_t)j * NKV * KVL, 0, scr, r, F.lane); continue; } r -= I_UK;
            if (r < I_UK) { p0_transpose_item(A.in[17] + (size_t)j * KVL * D, KVL, D, (bf16*)(F.ws + WS_WUKV) + (size_t)j * NKV * KVL, D, scr, r, F.lane); continue; } r -= I_UK;
            if (r < I_O) { p0_transpose_item(A.in[18] + (size_t)j * D * D, D, D, (bf16*)(F.ws + WS_WO) + (size_t)j * D * D, 0, scr, r, F.lane); continue; } r -= I_O;
            if (r < I_RIN) { p0_transpose_item(A.in[19] + (size_t)j * D * 2 * D, D, 2 * D, (bf16*)(F.ws + WS_WRIN) + (size_t)j * 2 * D * D, 0, scr, r, F.lane); continue; } r -= I_RIN;
            if (r < I_O) { p0_transpose_item(A.in[27] + (size_t)j * D * D, D, D, (bf16*)(F.ws + WS_WROUT) + (size_t)j * D * D, 0, scr, r, F.lane); continue; } r -= I_O;
            { const int gate = r / I_G; r -= gate * I_G; const int mat = r >> 3, sub = r & 7, dir = mat >> 4, blk = mat & 15;
              p0_transpose_item(A.in[gate ? 24 : 22] + ((size_t)j * 32 + mat) * 128 * 128, 128, 128, (bf16*)(F.ws + WS_WG) + (size_t)j * 8192 * 128, blk * 512 + dir * 256 + gate * 128, scr, sub, F.lane); continue; }
        }
        r -= 2 * PER_J;
        { const int l = r / (I_UP + I_DN); r -= l * (I_UP + I_DN);
          if (r < I_UP) { p0_transpose_item(A.in[28] + (size_t)l * D * NUP, D, NUP, (bf16*)(F.ws + WS_WUP) + (size_t)l * NUP * D, 0, scr, r, F.lane); continue; } r -= I_UP;
          p0_transpose_item(A.in[31] + (size_t)l * DFF * D, DFF, D, (bf16*)(F.ws + WS_WDN) + (size_t)l * D * DFF, 0, scr, r, F.lane); }
    }
    (void)ws16;
    const int gt = F.vcu * NWAVES * 64 + F.tid, NGT = F.G * NWAVES * 64;
    for (int i = gt; i < 2 * (NINP - NIN) * D / 8; i += NGT) { const int j = i / ((NINP - NIN) * D / 8), o = i % ((NINP - NIN) * D / 8);
        *(GAS v4u*)((bf16*)(F.ws + WS_WIN) + ((size_t)j * NINP + NIN) * D + (size_t)o * 8) = (v4u){0u, 0u, 0u, 0u}; }
    for (int i = gt; i < 1024 * 32; i += NGT) { const int pos = i >> 5, a = i & 31; const float inv = exp2f(-(float)(2 * (a & 15)) * (13.287712379549449f / 32.0f));
        const float ang = (float)((a < 16) ? (pos >> 6) : (pos & 63)) * inv; float sn, cs; sincosf(ang, &sn, &cs);
        ((float*)(F.ws + WS_COS))[i] = cs; ((float*)(F.ws + WS_SIN))[i] = sn; }
    for (int i = gt; i < 2 * 2 * D; i += NGT) { const float lam = A.in[26][i]; ((float*)(F.ws + WS_SP))[i] = 8.0f * 1.4426950408889634f * log1pf(expf(-lam)); }
}

template <int MODE>
__device__ __forceinline__ void norm_phase(Frame& F, const Args& A, const float* g, const float* modbase  , int shift_idx  ) {
    const int gw = F.vcu * NWAVES + F.wave, NGW = F.G * NWAVES;
    float* X = (float*)(F.ws + WS_X); bf16* H = (bf16*)(F.ws + WS_H);
    for (int m = gw; m < NTOK; m += NGW) {
        const float* src = MODE == 0 ? (m < MCTX ? A.in[0] + (size_t)m * D : A.in[1] + (size_t)(m - MCTX) * D) : X + (size_t)m * D;
        const GAS f32x4* xr = (const GAS f32x4*)src + F.lane;
        f32x4 v[8]; float s = 0.f;
#pragma unroll
        for (int j = 0; j < 8; ++j) { v[j] = xr[64 * j]; s += (v[j].x * v[j].x + v[j].y * v[j].y) + (v[j].z * v[j].z + v[j].w * v[j].w); }
        const float rstd = 1.0f / sqrtf(wave_sum(s, F.lane) * (1.0f / D) + NORM_EPS);
        if (MODE == 0) { GAS f32x4* xo = (GAS f32x4*)(X + (size_t)m * D) + F.lane;
#pragma unroll
            for (int j = 0; j < 8; ++j) xo[64 * j] = v[j]; }
        if (MODE == 2) { GAS f32x4* yo = (GAS f32x4*)(F.out + OUT_Y + (size_t)m * D) + F.lane;
#pragma unroll
            for (int j = 0; j < 8; ++j) { const f32x4 gg = ((const GAS f32x4*)g)[F.lane + 64 * j]; yo[64 * j] = v[j] * rstd * gg; }
        } else {
            const float* mb = modbase + (size_t)mod_of_row(m) * ADA_N + (size_t)shift_idx * D;
            GAS unsigned long long* o8 = (GAS unsigned long long*)(H + (size_t)m * D) + F.lane;
#pragma unroll
            for (int j = 0; j < 8; ++j) { const f32x4 gg = ((const GAS f32x4*)g)[F.lane + 64 * j], sh = ((const GAS f32x4*)mb)[F.lane + 64 * j], sc = ((const GAS f32x4*)(mb + D))[F.lane + 64 * j];
                const f32x4 h = v[j] * rstd * gg * (sc + 1.0f) + sh;
                o8[64 * j] = (unsigned long long)pk2(h.x, h.y) | ((unsigned long long)pk2(h.z, h.w) << 32); }
        }
    }
}

__device__ __forceinline__ void mla_mid_phase(Frame& F, const Args& A, int j) {
    const int gw = F.vcu * NWAVES + F.wave, NGW = F.G * NWAVES, lane = F.lane;
    const float* PROJ = (const float*)(F.ws + WS_PROJ); bf16* CQ = (bf16*)(F.ws + WS_CQ); bf16* CKV = (bf16*)(F.ws + WS_CKV); bf16* KR = (bf16*)(F.ws + WS_KR);
    const float* gq = A.in[13] + j * QL; const float* gkv = A.in[14] + j * KVL;
    const float* cosT = (const float*)(F.ws + WS_COS); const float* sinT = (const float*)(F.ws + WS_SIN);
    const f32x4 gq0 = *(const GAS f32x4*)(gq + 8 * lane), gq1 = *(const GAS f32x4*)(gq + 8 * lane + 4), gk0 = *(const GAS f32x4*)(gkv + 8 * lane), gk1 = *(const GAS f32x4*)(gkv + 8 * lane + 4);
    for (int m = gw; m < NTOK; m += NGW) {
        const float* pr = PROJ + (size_t)m * NINP;
        const f32x4 q0 = *(const GAS f32x4*)(pr + 8 * lane), q1 = *(const GAS f32x4*)(pr + 8 * lane + 4), k0 = *(const GAS f32x4*)(pr + QL + 8 * lane), k1 = *(const GAS f32x4*)(pr + QL + 8 * lane + 4);
        const float kr = pr[QL + KVL + lane];
        const float sq = wave_sum((q0.x * q0.x + q0.y * q0.y) + (q0.z * q0.z + q0.w * q0.w) + (q1.x * q1.x + q1.y * q1.y) + (q1.z * q1.z + q1.w * q1.w), lane);
        const float sk = wave_sum((k0.x * k0.x + k0.y * k0.y) + (k0.z * k0.z + k0.w * k0.w) + (k1.x * k1.x + k1.y * k1.y) + (k1.z * k1.z + k1.w * k1.w), lane);
        const float rq = 1.0f / sqrtf(sq * (1.0f / QL) + NORM_EPS), rk = 1.0f / sqrtf(sk * (1.0f / KVL) + NORM_EPS);
        const f32x4 a0 = q0 * rq * gq0, a1 = q1 * rq * gq1, c0 = k0 * rk * gk0, c1 = k1 * rk * gk1;
        *(GAS v4u*)(CQ + (size_t)m * QL + 8 * lane) = (v4u){pk2(a0.x, a0.y), pk2(a0.z, a0.w), pk2(a1.x, a1.y), pk2(a1.z, a1.w)};
        const int kvr = kv_row(m);
        *(GAS v4u*)(CKV + (size_t)kvr * KVL + 8 * lane) = (v4u){pk2(c0.x, c0.y), pk2(c0.z, c0.w), pk2(c1.x, c1.y), pk2(c1.z, c1.w)};
        float krv = kr;
        if (m < MCTX) {
            const int b = m >> 8, t = m & 255; float* oc = F.out + OUT_CKV + ((size_t)(b * 2 + j) * 256 + t) * KVL + 8 * lane;
            *(GAS f32x4*)oc = c0; *(GAS f32x4*)(oc + 4) = c1;
            F.out[OUT_KR + ((size_t)(b * 2 + j) * 256 + t) * ROPE + lane] = kr;
        } else {
            const int pos = (m - MCTX) & 1023, ai = (lane & 15) + 16 * (lane >> 5); const float cs = cosT[pos * 32 + ai], sn = sinT[pos * 32 + ai];
            const float other = shfl_xor_l(kr, 16, lane);
            krv = (lane & 16) ? (kr * cs + other * sn) : (kr * cs - other * sn);
        }
        KR[(size_t)kvr * ROPE + lane] = (bf16)f2bf(krv);
    }
    for (int i = gw; i < 8 * 256; i += NGW) { const int b = i >> 8, t = i & 255; const size_t dst = (size_t)MCTX + 1280 * b + t;
        const float* sc = A.in[2] + ((size_t)(b * 2 + j) * 256 + t) * KVL + 8 * lane; const f32x4 c0 = *(const GAS f32x4*)sc, c1 = *(const GAS f32x4*)(sc + 4);
        *(GAS v4u*)(CKV + dst * KVL + 8 * lane) = (v4u){pk2(c0.x, c0.y), pk2(c0.z, c0.w), pk2(c1.x, c1.y), pk2(c1.z, c1.w)};
        KR[dst * ROPE + lane] = (bf16)f2bf(A.in[3][((size_t)(b * 2 + j) * 256 + t) * ROPE + lane]); }
}

__device__ __forceinline__ void attn_phase(Frame& F, char* lds) {
    const att::bf16* Q = (const att::bf16*)(F.ws + WS_Q); const att::bf16* KN = (const att::bf16*)(F.ws + WS_KN); const att::bf16* KR = (const att::bf16*)(F.ws + WS_KR);
    const att::bf16* V = (const att::bf16*)(F.ws + WS_V); att::bf16* O = (att::bf16*)(F.ws + WS_O);
    for (int i = 0; i < 4; ++i) {
        int qrow, krow, h, seq;
        if (i < 2) { const int id = F.vcu * 2 + i, b = id >> 6, rem = id & 63, qb = rem & 3; h = rem >> 2; qrow = MCTX + b * 1024 + qb * 256; krow = MCTX + b * 1280; seq = 1280; }
        else { const int id = F.vcu * 2 + (i - 2), s = id >> 4; h = id & 15; qrow = s * 256; krow = s * 256; seq = 256; }
        __syncthreads();
        att::attn_unit(Q + (size_t)qrow * NQ + h * QKD, KN + (size_t)krow * D + h * NOPE, KR + (size_t)krow * ROPE, V + (size_t)krow * D + h * VD, O + (size_t)qrow * D + h * VD, seq, lds);
    }
}

__device__ __forceinline__ void conv4_phase(Frame& F, const Args& A, int j) {
    const int gw = F.vcu * NWAVES + F.wave, NGW = F.G * NWAVES, lane = F.lane;
    const bf16* RIN = (const bf16*)(F.ws + WS_RIN); bf16* XC = (bf16*)(F.ws + WS_XC);
    const float* wc = A.in[20] + (size_t)j * 4 * D; const float* bc = A.in[21] + (size_t)j * D;
    for (int task = gw; task < (NTOK / 16) * 4; task += NGW) {
        const int cg = task & 3, chunk = task >> 2, r0 = chunk * 16, c0 = cg * 512 + lane * 8;
        const int slen = r0 < MCTX ? 256 : 1024, sbeg = r0 < MCTX ? (r0 & ~255) : MCTX + ((r0 - MCTX) & ~1023), send = sbeg + slen;
        float w[4][8], bb[8];
#pragma unroll
        for (int t = 0; t < 4; ++t) { const f32x4 a = *(const GAS f32x4*)(wc + t * D + c0), b = *(const GAS f32x4*)(wc + t * D + c0 + 4); w[t][0] = a.x; w[t][1] = a.y; w[t][2] = a.z; w[t][3] = a.w; w[t][4] = b.x; w[t][5] = b.y; w[t][6] = b.z; w[t][7] = b.w; }
        { const f32x4 a = *(const GAS f32x4*)(bc + c0), b = *(const GAS f32x4*)(bc + c0 + 4); bb[0] = a.x; bb[1] = a.y; bb[2] = a.z; bb[3] = a.w; bb[4] = b.x; bb[5] = b.y; bb[6] = b.z; bb[7] = b.w; }
        v4u raw[19];
#pragma unroll
        for (int i = 0; i < 19; ++i) { const int r = r0 - 2 + i; raw[i] = (r >= sbeg && r < send) ? *(const GAS v4u*)(RIN + (size_t)r * (2 * D) + D + c0) : (v4u){0u, 0u, 0u, 0u}; }
#pragma unroll
        for (int t = 0; t < 16; ++t) {
            float o[8];
#pragma unroll
            for (int c = 0; c < 8; ++c) o[c] = bb[c];
#pragma unroll
            for (int jj = 0; jj < 4; ++jj) { const v4u x = raw[t + jj];
                o[0] += w[jj][0] * pg8::bf_lo(x.x); o[1] += w[jj][1] * pg8::bf_hi(x.x); o[2] += w[jj][2] * pg8::bf_lo(x.y); o[3] += w[jj][3] * pg8::bf_hi(x.y);
                o[4] += w[jj][4] * pg8::bf_lo(x.z); o[5] += w[jj][5] * pg8::bf_hi(x.z); o[6] += w[jj][6] * pg8::bf_lo(x.w); o[7] += w[jj][7] * pg8::bf_hi(x.w); }
            *(GAS v4u*)(XC + (size_t)(r0 + t) * D + c0) = (v4u){pk2(o[0], o[1]), pk2(o[2], o[3]), pk2(o[4], o[5]), pk2(o[6], o[7])};
        }
    }
}

#define SCAN_G 16
__device__ __forceinline__ void scan_phase(Frame& F, const Args& A, int j) {
    int row0, slen, cg; bool ctx; int bidx;
    if (F.wave == 0) { const int id = F.vcu; bidx = id >> 5; cg = id & 31; row0 = MCTX + bidx * 1024; slen = 1024; ctx = false; }
    else if (F.wave <= 4) { const int id = F.vcu * 4 + (F.wave - 1); bidx = id >> 5; cg = id & 31; row0 = bidx * 256; slen = 256; ctx = true; }
    else return;
    const int ch = cg * 64 + F.lane;
    const bf16* LAf = (const bf16*)(F.ws + WS_LA) + ch; const bf16* LAb = LAf + (size_t)NTOK * D;
    const bf16* UUf = (const bf16*)(F.ws + WS_UU) + ch; const bf16* UUb = UUf + (size_t)NTOK * D;
    float* HB = (float*)(F.ws + WS_HB) + ch; const bf16* GY = (const bf16*)(F.ws + WS_RIN) + ch; bf16* MIX = (bf16*)(F.ws + WS_MIX) + ch;
    float hf0 = 0.f, hb0 = 0.f;
    if (!ctx) { hf0 = A.in[4][((size_t)(bidx * 2 + j) * 2 + 0) * D + ch]; hb0 = A.in[4][((size_t)(bidx * 2 + j) * 2 + 1) * D + ch]; }
    const int NG = slen / SCAN_G;
    {
        unsigned short laA[SCAN_G], uA[SCAN_G], laB[SCAN_G], uB[SCAN_G]; float h = hb0;
#define BL(LA_, U_, g) do { _Pragma("unroll") for (int i = 0; i < SCAN_G; ++i) { const size_t r = (size_t)(row0 + slen - 1 - ((g) * SCAN_G + i)) * D; LA_[i] = *(const GAS bf16*)(LAb + r); U_[i] = *(const GAS bf16*)(UUb + r); } } while (0)
#define BC(LA_, U_, g) do { _Pragma("unroll") for (int i = 0; i < SCAN_G; ++i) { const size_t r = (size_t)(row0 + slen - 1 - ((g) * SCAN_G + i)) * D; \
            h = __builtin_amdgcn_exp2f(__uint_as_float((unsigned)LA_[i] << 16)) * h + __uint_as_float((unsigned)U_[i] << 16); *(GAS float*)(HB + r) = h; } } while (0)
        BL(laA, uA, 0);
        for (int g = 0; g < NG; g += 2) { BL(laB, uB, g + 1); BC(laA, uA, g); if (g + 2 < NG) BL(laA, uA, g + 2); BC(laB, uB, g + 1); }
#undef BL
#undef BC
        if (ctx) F.out[OUT_ST + ((size_t)(bidx * 2 + j) * 2 + 1) * D + ch] = h;
    }
    {
        unsigned short laA[SCAN_G], uA[SCAN_G], gA[SCAN_G], laB[SCAN_G], uB[SCAN_G], gB[SCAN_G]; float hbA[SCAN_G], hbB[SCAN_G]; float h = hf0;
#define FL(LA_, U_, G_, HB_, g) do { _Pragma("unroll") for (int i = 0; i < SCAN_G; ++i) { const size_t rr = (size_t)(row0 + (g) * SCAN_G + i); LA_[i] = *(const GAS bf16*)(LAf + rr * D); U_[i] = *(const GAS bf16*)(UUf + rr * D); \
            G_[i] = *(const GAS bf16*)(GY + rr * (2 * D)); HB_[i] = *(const GAS float*)(HB + rr * D); } } while (0)
#define FC(LA_, U_, G_, HB_, g) do { _Pragma("unroll") for (int i = 0; i < SCAN_G; ++i) { const size_t rr = (size_t)(row0 + (g) * SCAN_G + i); \
            h = __builtin_amdgcn_exp2f(__uint_as_float((unsigned)LA_[i] << 16)) * h + __uint_as_float((unsigned)U_[i] << 16); \
            *(GAS bf16*)(MIX + rr * D) = (bf16)f2bf((h + HB_[i]) * __uint_as_float((unsigned)G_[i] << 16)); } } while (0)
        FL(laA, uA, gA, hbA, 0);
        for (int g = 0; g < NG; g += 2) { FL(laB, uB, gB, hbB, g + 1); FC(laA, uA, gA, hbA, g); if (g + 2 < NG) FL(laA, uA, gA, hbA, g + 2); FC(laB, uB, gB, hbB, g + 1); }
#undef FL
#undef FC
        if (ctx) F.out[OUT_ST + ((size_t)(bidx * 2 + j) * 2 + 0) * D + ch] = h;
    }
}

__device__ __forceinline__ void ffn_conv_phase(Frame& F, const Args& A, int layer) {
    const int gw = F.vcu * NWAVES + F.wave, NGW = F.G * NWAVES, lane = F.lane;
    const bf16* U = (const bf16*)(F.ws + WS_U); bf16* ACT = (bf16*)(F.ws + WS_ACT);
    const float* wc = A.in[29] + (size_t)layer * 3 * NUP; const float* bc = A.in[30] + (size_t)layer * NUP;
    for (int task = gw; task < (NTOK / 8) * 11; task += NGW) {
        const int cg = task % 11, chunk = task / 11, r0 = chunk * 8, c0 = cg * 512 + lane * 8;
        const int slen = r0 < MCTX ? 256 : 1024, sbeg = r0 < MCTX ? (r0 & ~255) : MCTX + ((r0 - MCTX) & ~1023), send = sbeg + slen;
        float wg[3][8], wv[3][8], bg[8], bv[8];
#pragma unroll
        for (int t = 0; t < 3; ++t) { const f32x4 a = *(const GAS f32x4*)(wc + t * NUP + c0), b = *(const GAS f32x4*)(wc + t * NUP + c0 + 4), c = *(const GAS f32x4*)(wc + t * NUP + DFF + c0), d = *(const GAS f32x4*)(wc + t * NUP + DFF + c0 + 4);
            wg[t][0] = a.x; wg[t][1] = a.y; wg[t][2] = a.z; wg[t][3] = a.w; wg[t][4] = b.x; wg[t][5] = b.y; wg[t][6] = b.z; wg[t][7] = b.w;
            wv[t][0] = c.x; wv[t][1] = c.y; wv[t][2] = c.z; wv[t][3] = c.w; wv[t][4] = d.x; wv[t][5] = d.y; wv[t][6] = d.z; wv[t][7] = d.w; }
        { const f32x4 a = *(const GAS f32x4*)(bc + c0), b = *(const GAS f32x4*)(bc + c0 + 4), c = *(const GAS f32x4*)(bc + DFF + c0), d = *(const GAS f32x4*)(bc + DFF + c0 + 4);
            bg[0] = a.x; bg[1] = a.y; bg[2] = a.z; bg[3] = a.w; bg[4] = b.x; bg[5] = b.y; bg[6] = b.z; bg[7] = b.w; bv[0] = c.x; bv[1] = c.y; bv[2] = c.z; bv[3] = c.w; bv[4] = d.x; bv[5] = d.y; bv[6] = d.z; bv[7] = d.w; }
        v4u rg[10], rv[10];
#pragma unroll
        for (int i = 0; i < 10; ++i) { const int r = r0 - 1 + i; const bool ok = (r >= sbeg && r < send);
            rg[i] = ok ? *(const GAS v4u*)(U + (size_t)r * NUP + c0) : (v4u){0u, 0u, 0u, 0u}; rv[i] = ok ? *(const GAS v4u*)(U + (size_t)r * NUP + DFF + c0) : (v4u){0u, 0u, 0u, 0u}; }
#pragma unroll
        for (int t = 0; t < 8; ++t) {
            float g[8], v[8];
#pragma unroll
            for (int c = 0; c < 8; ++c) { g[c] = bg[c]; v[c] = bv[c]; }
#pragma unroll
            for (int jj = 0; jj < 3; ++jj) { const v4u x = rg[t + jj], y = rv[t + jj];
                g[0] += wg[jj][0] * pg8::bf_lo(x.x); g[1] += wg[jj][1] * pg8::bf_hi(x.x); g[2] += wg[jj][2] * pg8::bf_lo(x.y); g[3] += wg[jj][3] * pg8::bf_hi(x.y);
                g[4] += wg[jj][4] * pg8::bf_lo(x.z); g[5] += wg[jj][5] * pg8::bf_hi(x.z); g[6] += wg[jj][6] * pg8::bf_lo(x.w); g[7] += wg[jj][7] * pg8::bf_hi(x.w);
                v[0] += wv[jj][0] * pg8::bf_lo(y.x); v[1] += wv[jj][1] * pg8::bf_hi(y.x); v[2] += wv[jj][2] * pg8::bf_lo(y.y); v[3] += wv[jj][3] * pg8::bf_hi(y.y);
                v[4] += wv[jj][4] * pg8::bf_lo(y.z); v[5] += wv[jj][5] * pg8::bf_hi(y.z); v[6] += wv[jj][6] * pg8::bf_lo(y.w); v[7] += wv[jj][7] * pg8::bf_hi(y.w); }
            float a[8];
#pragma unroll
            for (int c = 0; c < 8; ++c) a[c] = g[c] * pg8::fast_sigmoid(g[c]) * v[c];
            *(GAS v4u*)(ACT + (size_t)(r0 + t) * DFF + c0) = (v4u){pk2(a[0], a[1]), pk2(a[2], a[3]), pk2(a[4], a[5]), pk2(a[6], a[7])};
        }
    }
}

#ifndef MK_PER_PHASE
#define MK_PER_PHASE 0
#endif
#ifndef MK_MASK
#define MK_MASK 0xffffffffu
#endif
#define ON(i) ((MK_MASK >> (i)) & 1u)
#ifndef MK_STOP
#define MK_STOP 1000
#endif
constexpr int NPHASE = 2 + 10 * NLAYER;

__global__ void __launch_bounds__(NWAVES * 64, 2) mk_fwd(Args args) {
    extern __shared__ __attribute__((aligned(16))) unsigned char lds[];
    Frame F;
    F.lds = (LAS unsigned char*)lds;
    F.MISC = (volatile LAS unsigned*)(F.lds + MISC_OFF);
    F.tid = threadIdx.x; F.lane = F.tid & 63; F.wave = __builtin_amdgcn_readfirstlane(F.tid >> 6);
    F.G = gridDim.x; { const int bx = blockIdx.x; F.vcu = (F.G % 8 == 0) ? (bx % 8) * (F.G / 8) + bx / 8 : bx; }
    F.out = args.out; F.ws = args.ws;
    for (int u = F.tid; u < (LDS_BYTES - LDSCTL_OFF) / 4; u += NWAVES * 64) ((LAS unsigned*)(F.lds + LDSCTL_OFF))[u] = 0u;
    __syncthreads();
    const int lo = args.ph_lo, hi = args.ph_hi < MK_STOP ? args.ph_hi : MK_STOP;
    unsigned* barw = (unsigned*)(args.ws + WS_CTL) + CW_BAR;
    XcdBarrier bar; bar.bar = barw; bar.x = 0; bar.st = nullptr;
    if (hi - lo > 1) bar = xcd_barrier_post(barw, F.MISC + 8);
#define IN(k) (lo <= (k) && (k) < hi)
#define PHASE_BEGIN() size_t z_ = 0; asm volatile("" : "+s"(z_)); unsigned char* ws = args.ws + z_;     \
    { int t_ = threadIdx.x; asm volatile("" : "+v"(t_)); F.tid = t_; F.lane = t_ & 63; F.wave = __builtin_amdgcn_readfirstlane(t_ >> 6); F.ws = ws; } \
    const float* mods = (const float*)(ws + WS_MODS); bf16* Hb = (bf16*)(ws + WS_H); float* X = (float*)(ws + WS_X); (void)mods; (void)Hb; (void)X;
#define SEAM(k) do { if (IN(k) && IN((k) + 1)) xcd_barrier(bar); } while (0)
    const int cid = (int)blockIdx.x;

    if (IN(0) && ON(0)) { PHASE_BEGIN(); p0_prologue(F, args); }
    SEAM(0);
    if (IN(1) && ON(1)) { PHASE_BEGIN(); norm_phase<0>(F, args, args.in[7], mods, 0); }
    SEAM(1);

#pragma nounroll
    for (int layer = 0; layer < NLAYER; ++layer) {
        const int pb = 2 + 10 * layer, j = layer >> 1;
        if ((layer & 1) == 0) {
            if (IN(pb + 0) && ON(2)) { PHASE_BEGIN(); const float* lmods = mods + (size_t)layer * NMOD * ADA_N; (void)lmods; pg8::Gemm g{Hb, (const bf16*)(ws + WS_WIN) + (size_t)j * NINP * D, D, D}; pg8::StaticOrder S; S.init(NTOK, NINP, F.G, cid);
                pg8::EpiF32 E{(float*)(ws + WS_PROJ), NINP};
                pg8::gemm_phase<pg8::EpiF32, pg8::StaticOrder, true, true>(F.lds + RING_OFF, g, S, E); }
            SEAM(pb + 0);
            if (IN(pb + 1) && ON(3)) { PHASE_BEGIN(); const float* lmods = mods + (size_t)layer * NMOD * ADA_N; (void)lmods; mla_mid_phase(F, args, j); }
            SEAM(pb + 1);
            if (IN(pb + 2) && ON(4)) {
                PHASE_BEGIN();
                { pg8::Gemm g{(const bf16*)(ws + WS_CQ), (const bf16*)(ws + WS_WUQ) + (size_t)j * NQ * QL, QL, QL}; pg8::StaticOrder S; S.init(NTOK, NQ, F.G, cid);
                  pg8::EpiQ E{(bf16*)(ws + WS_Q), (const float*)(ws + WS_COS), (const float*)(ws + WS_SIN)};
                  pg8::gemm_phase<pg8::EpiQ, pg8::StaticOrder, true, true>(F.lds + RING_OFF, g, S, E); }
                { pg8::Gemm g{(const bf16*)(ws + WS_CKV), (const bf16*)(ws + WS_WUKV) + (size_t)j * NKV * KVL, KVL, KVL}; pg8::StaticOrder S; S.init(MKV, NKV, F.G, cid);
                  pg8::EpiBf16<0> E{(bf16*)(ws + WS_KN), D, D, (size_t)(WS_V - WS_KN) / 2, 0};
                  pg8::gemm_phase<pg8::EpiBf16<0>, pg8::StaticOrder, true, true>(F.lds + RING_OFF, g, S, E); }
            }
            SEAM(pb + 2);
            if (IN(pb + 3) && ON(5)) { PHASE_BEGIN(); const float* lmods = mods + (size_t)layer * NMOD * ADA_N; (void)lmods; attn_phase(F, (char*)lds + RING_OFF); }
            SEAM(pb + 3);
            if (IN(pb + 4) && ON(6)) { PHASE_BEGIN(); const float* lmods = mods + (size_t)layer * NMOD * ADA_N; (void)lmods; pg8::Gemm g{(const bf16*)(ws + WS_O), (const bf16*)(ws + WS_WO) + (size_t)j * D * D, D, D}; pg8::StaticOrder S; S.init(NTOK, D, F.G, cid);
                pg8::EpiRes E{X, lmods + 2 * D};
                pg8::gemm_phase<pg8::EpiRes, pg8::StaticOrder, true, true>(F.lds + RING_OFF, g, S, E); }
            SEAM(pb + 4);
        } else {
            if (IN(pb + 0) && ON(7)) { PHASE_BEGIN(); const float* lmods = mods + (size_t)layer * NMOD * ADA_N; (void)lmods; pg8::Gemm g{Hb, (const bf16*)(ws + WS_WRIN) + (size_t)j * 2 * D * D, D, D}; pg8::StaticOrder S; S.init(NTOK, 2 * D, F.G, cid);
                pg8::EpiBf16<1> E{(bf16*)(ws + WS_RIN), 2 * D, 0, 0, D / 256};
                pg8::gemm_phase<pg8::EpiBf16<1>, pg8::StaticOrder, true, true>(F.lds + RING_OFF, g, S, E); }
            SEAM(pb + 0);
            if (IN(pb + 1) && ON(8)) { PHASE_BEGIN(); const float* lmods = mods + (size_t)layer * NMOD * ADA_N; (void)lmods; conv4_phase(F, args, j); }
            SEAM(pb + 1);
            if (IN(pb + 2) && ON(9)) { PHASE_BEGIN(); const float* lmods = mods + (size_t)layer * NMOD * ADA_N; (void)lmods; pg8::Gemm g{(const bf16*)(ws + WS_XC), (const bf16*)(ws + WS_WG) + (size_t)j * 8192 * 128, 128, D}; pg8::GateOrder S; S.init(NTOK, 8192, F.G, cid);
                pg8::EpiGates E{(bf16*)(ws + WS_LA), (bf16*)(ws + WS_UU), (const bf16*)(ws + WS_XC), args.in[23] + (size_t)j * 2 * D, args.in[25] + (size_t)j * 2 * D, (const float*)(ws + WS_SP) + (size_t)j * 2 * D};
                pg8::gemm_phase<pg8::EpiGates, pg8::GateOrder, true, true>(F.lds + RING_OFF, g, S, E); }
            SEAM(pb + 2);
            if (IN(pb + 3) && ON(10)) { PHASE_BEGIN(); const float* lmods = mods + (size_t)layer * NMOD * ADA_N; (void)lmods; scan_phase(F, args, j); }
            SEAM(pb + 3);
            if (IN(pb + 4) && ON(11)) { PHASE_BEGIN(); const float* lmods = mods + (size_t)layer * NMOD * ADA_N; (void)lmods; pg8::Gemm g{(const bf16*)(ws + WS_MIX), (const bf16*)(ws + WS_WROUT) + (size_t)j * D * D, D, D}; pg8::StaticOrder S; S.init(NTOK, D, F.G, cid);
                pg8::EpiRes E{X, lmods + 2 * D};
                pg8::gemm_phase<pg8::EpiRes, pg8::StaticOrder, true, true>(F.lds + RING_OFF, g, S, E); }
            SEAM(pb + 4);
        }
        if (IN(pb + 5) && ON(12)) { PHASE_BEGIN(); const float* lmods = mods + (size_t)layer * NMOD * ADA_N; (void)lmods; norm_phase<1>(F, args, args.in[8] + (size_t)layer * D, lmods, 3); }
        SEAM(pb + 5);
        if (IN(pb + 6) && ON(13)) { PHASE_BEGIN(); const float* lmods = mods + (size_t)layer * NMOD * ADA_N; (void)lmods; pg8::Gemm g{Hb, (const bf16*)(ws + WS_WUP) + (size_t)layer * NUP * D, D, D}; pg8::StaticOrder S; S.init(NTOK, NUP, F.G, cid);
            pg8::EpiBf16<0> E{(bf16*)(ws + WS_U), NUP, 0, 0, 0};
            pg8::gemm_phase<pg8::EpiBf16<0>, pg8::StaticOrder, true, true>(F.lds + RING_OFF, g, S, E); }
        SEAM(pb + 6);
        if (IN(pb + 7) && ON(14)) { PHASE_BEGIN(); const float* lmods = mods + (size_t)layer * NMOD * ADA_N; (void)lmods; ffn_conv_phase(F, args, layer); }
        SEAM(pb + 7);
        if (IN(pb + 8) && ON(15)) { PHASE_BEGIN(); const float* lmods = mods + (size_t)layer * NMOD * ADA_N; (void)lmods; pg8::Gemm g{(const bf16*)(ws + WS_ACT), (const bf16*)(ws + WS_WDN) + (size_t)layer * D * DFF, DFF, DFF}; pg8::StaticOrder S; S.init(NTOK, D, F.G, cid);
            pg8::EpiRes E{X, lmods + 5 * D};
            pg8::gemm_phase<pg8::EpiRes, pg8::StaticOrder, true, true>(F.lds + RING_OFF, g, S, E); }
        SEAM(pb + 8);
        if (IN(pb + 9) && ON(16)) { PHASE_BEGIN(); const float* lmods = mods + (size_t)layer * NMOD * ADA_N; (void)lmods; if (layer + 1 < NLAYER) norm_phase<1>(F, args, args.in[7] + (size_t)(layer + 1) * D, lmods + (size_t)NMOD * ADA_N, 0); else norm_phase<2>(F, args, args.in[9], mods, 0); }
        if (layer + 1 < NLAYER) SEAM(pb + 9);
    }
#undef IN
#undef SEAM
}

extern "C" void kernel_launch(void* const* d_in, const int* in_sizes, int n_in, void* d_out, int out_size, void* d_ws, size_t ws_size, hipStream_t stream) {
    static int grid = 0;
    if (grid == 0) {
        if (n_in != 32 || in_sizes[0] != MCTX * D || in_sizes[1] != MCTX * D || (size_t)out_size != OUT_TOTAL || ws_size < WS_END) {
            fprintf(stderr, "kernel_launch: shape mismatch (n_in %d, out %d, ws %zu); nothing launched\n", n_in, out_size, ws_size); grid = -1; return; }
        int dev = 0, cus = 0, per_cu = 0;
        if (hipGetDevice(&dev) != hipSuccess || hipDeviceGetAttribute(&cus, hipDeviceAttributeMultiprocessorCount, dev) != hipSuccess) { grid = -1; return; }
        if (hipFuncSetAttribute((const void*)mk_fwd, hipFuncAttributeMaxDynamicSharedMemorySize, LDS_BYTES) != hipSuccess) { fprintf(stderr, "kernel_launch: hipFuncSetAttribute failed\n"); grid = -1; return; }
        if (hipOccupancyMaxActiveBlocksPerMultiprocessor(&per_cu, (const void*)mk_fwd, NWAVES * 64, LDS_BYTES) != hipSuccess || per_cu < 1)
            fprintf(stderr, "kernel_launch: note: occupancy query reports %d workgroups per CU\n", per_cu);
        (void)hipGetLastError();
        grid = cus;
        if (grid != 256) fprintf(stderr, "kernel_launch: note: %d CUs (tuned for 256)\n", grid);
    }
    if (grid < 0) return;
    if (hipMemsetAsync((char*)d_ws + WS_CTL, 0, CTL_ZERO_BYTES, stream) != hipSuccess) { fprintf(stderr, "kernel_launch: memset failed\n"); return; }
    Args a{};
    for (int i = 0; i < 32; ++i) a.in[i] = (const float*)d_in[i];
    a.out = (float*)d_out; a.ws = (unsigned char*)d_ws;
#if MK_PER_PHASE
    for (int p = 0; p < NPHASE && p < MK_STOP; ++p) { a.ph_lo = p; a.ph_hi = p + 1; hipLaunchKernelGGL(mk_fwd, dim3(grid), dim3(NWAVES * 64), LDS_BYTES, stream, a); }
#else
    a.ph_lo = 0; a.ph_hi = NPHASE; hipLaunchKernelGGL(mk_fwd, dim3(grid), dim3(NWAVES * 64), LDS_BYTES, stream, a);
#endif
    const hipError_t le = hipPeekAtLastError();
    if (le != hipSuccess) fprintf(stderr, "kernel_launch: launch failed: %s\n", hipGetErrorName(le));
}
```

```cpp
#define MK_REP 0u
#include <hip/hip_runtime.h>
#include <cstdio>
#include <cstdint>

constexpr int D = 2048, NTOK = 16384, MCTX = 8192, DFF = 5632, NUP = 2 * DFF, NLAYER = 4;
constexpr int QL = 512, KVL = 512, NH = 16, NOPE = 128, ROPE = 64, VD = 128, QKD = NOPE + ROPE;
constexpr int NIN = QL + KVL + ROPE  , NINP = 1280  , NQ = NH * QKD  , NKV = 2 * NH * NOPE  ;
constexpr int MKV = MCTX + 8 * 1280;
constexpr int NMOD = 9, ADA_N = 6 * D;
#ifndef MK_APAD
#define MK_APAD 64
#endif
constexpr int ALD = DFF + MK_APAD;
constexpr float NORM_EPS = 1e-6f;

__device__ __forceinline__ int lane_now() { int z = 0; asm volatile("" : "+v"(z)); return (int)__builtin_amdgcn_mbcnt_hi(~0u, __builtin_amdgcn_mbcnt_lo(~0u, (unsigned)z)); }

namespace pg8 {
#define PG8_LAS __attribute__((address_space(3)))
typedef unsigned short bf16_t;
typedef short bf16x8 __attribute__((ext_vector_type(8)));
typedef float f32x4 __attribute__((ext_vector_type(4)));
typedef float f32x2 __attribute__((ext_vector_type(2)));
typedef unsigned u32x4 __attribute__((ext_vector_type(4)));
typedef unsigned u32x2 __attribute__((ext_vector_type(2)));
constexpr int BM = 256, BK = 64, HALF = 128, HTB = HALF * BK * 2  , STAGE_BYTES = 8 * HTB, NXCD = 8, WGM = 8;

__host__ __device__ __forceinline__ int lds_byte(int r, int c) { const int st = (r >> 4) * 2 + (c >> 5), rr = r & 15, cc = c & 31, ob = rr * 64 + cc * 2; return st * 1024 + (ob ^ (((ob >> 9) & 1) << 5)); }
__host__ __device__ __forceinline__ void stage_rc(int b, int& R, int& C) { const int st = b / 1024, sb = b % 1024, swz = sb ^ (((sb >> 9) & 1) << 5); R = (st >> 1) * 16 + swz / 64; C = (st & 1) * 32 + (swz % 64) / 2; }
__host__ __device__ __forceinline__ int perm32(int rho) { const int n = rho >> 4, i = rho & 15; return 8 * (i >> 2) + 4 * n + (i & 3); }

struct Unit { int pm, pn; };
struct Gemm { const bf16_t* A; const bf16_t* Bt; int K; int lda; int ldb; int pad_; size_t b_hstep, b_tstep; };
__device__ __forceinline__ Gemm mk_gemm(const bf16_t* A, const bf16_t* Bt, int K, int lda) { Gemm g; g.A = A; g.Bt = Bt; g.K = K; g.lda = lda; g.ldb = K; g.pad_ = 0; g.b_hstep = (size_t)HALF * K * 2; g.b_tstep = (size_t)BM * K * 2; return g; }

struct StaticOrder {
    int nM, nN, nwg, G, c;
    __host__ __device__ void init(int M, int N, int G_, int c_) { nM = M / BM; nN = N / BM; nwg = nM * nN; G = G_; c = c_; }
    __host__ __device__ __forceinline__ bool next(int i, Unit& u) const {
        const long L = (long)i * G + c; if (L >= nwg) return false;
        int wgid = (int)L; { const int q = nwg / NXCD, r = nwg % NXCD, xcd = wgid % NXCD, off = wgid / NXCD; wgid = (xcd < r ? xcd * (q + 1) : r * (q + 1) + (xcd - r) * q) + off; }
        const int nig = WGM * nN, gid = wgid / nig, fm = gid * WGM, gsz = (nM - fm) < WGM ? (nM - fm) : WGM;
        u.pm = fm + ((wgid % nig) % gsz); u.pn = (wgid % nig) / gsz; return true;
    }
    __device__ __forceinline__ size_t acol(const Unit&) const { return 0; }
    __device__ __forceinline__ size_t bcol(const Unit&) const { return 0; }
    __device__ __forceinline__ void a_ready(const Unit&) const {}
    __device__ __forceinline__ void done(const Unit&) const {}
};
struct GateOrder : StaticOrder {
    __device__ __forceinline__ size_t acol(const Unit& u) const { return (size_t)(u.pn >> 1) * 256; }
};

struct OneUnit {
    int pm, pn;
    __device__ __forceinline__ bool next(int i, Unit& u) const { if (i) return false; u.pm = pm; u.pn = pn; return true; }
    __device__ __forceinline__ size_t acol(const Unit& u) const { return (size_t)(u.pn >> 1) * 256; }
    __device__ __forceinline__ size_t bcol(const Unit&) const { return 0; }
    __device__ __forceinline__ void a_ready(const Unit&) const {}
    __device__ __forceinline__ void done(const Unit&) const {}
};

struct KSplitOrder {
    int nwg, G, c; unsigned qbytes;
    __device__ void init(int M, int Kq, int G_, int c_) { nwg = (M / BM) * 4; G = G_; c = c_; qbytes = (unsigned)Kq * 2u; }
    __device__ __forceinline__ bool next(int i, Unit& u) const { const long L = (long)i * G + c; if (L >= nwg) return false; u.pm = (int)(L >> 2); u.pn = (int)(L & 3); return true; }
    __device__ __forceinline__ size_t acol(const Unit& u) const { return (size_t)u.pn * qbytes; }
    __device__ __forceinline__ size_t bcol(const Unit& u) const { return (size_t)u.pn * qbytes; }
    __device__ __forceinline__ void a_ready(const Unit&) const {}
    __device__ __forceinline__ void done(const Unit&) const {}
};

__device__ __forceinline__ unsigned cvt_pk_bf16(float lo, float hi) { unsigned r; asm volatile("v_cvt_pk_bf16_f32 %0, %1, %2" : "=v"(r) : "v"(lo), "v"(hi)); return r; }
__device__ __forceinline__ float bf_lo(unsigned w) { return __uint_as_float(w << 16); }
__device__ __forceinline__ float bf_hi(unsigned w) { return __uint_as_float(w & 0xffff0000u); }
__device__ __forceinline__ float fast_sigmoid(float x) { return __builtin_amdgcn_rcpf(1.0f + __builtin_amdgcn_exp2f(-1.4426950408889634f * x)); }
__device__ __forceinline__ float gelu_tanh(float x) { const float z = 0.7978845608028654f * (x + 0.044715f * x * x * x); return x * fast_sigmoid(2.0f * z); }

#ifndef MK_WT
#define MK_WT 0
#endif
template <int TG> __device__ __forceinline__ void gst16(void* p, u32x4 v) {
  if constexpr ((MK_WT >> TG) & 1) {
    asm volatile("global_store_dwordx4 %0, %1, off sc1\n\ts_nop 1" :: "v"(p), "v"(v) : "memory");
  } else {
    *(u32x4*)p = v; }
}
template <int TG> __device__ __forceinline__ void gst16f(void* p, f32x4 v) {
  if constexpr ((MK_WT >> TG) & 1) {
    asm volatile("global_store_dwordx4 %0, %1, off sc1\n\ts_nop 1" :: "v"(p), "v"(v) : "memory");
  } else {
    *(f32x4*)p = v; }
}
template <int TG> __device__ __forceinline__ void gst8(void* p, u32x2 v) {
  if constexpr ((MK_WT >> TG) & 1) {
    asm volatile("global_store_dwordx2 %0, %1, off sc1\n\ts_nop 1" :: "v"(p), "v"(v) : "memory");
  } else {
    *(u32x2*)p = v; }
}
struct EpiF32 {
    static constexpr int TAG = 0;
    static constexpr bool PERM = false, AFTER_DRAIN = false; static constexpr int KREP = 1;
    float* C; int ldc;
    __device__ __forceinline__ void operator()(const f32x4 (&acc)[2][2][4][2], const Unit& u, int wr, int wc, int fr, int fq) const {
        const int row0 = u.pm * BM + wr * 64 + fr, col0 = u.pn * BM + wc * 32 + 4 * fq;
#pragma unroll
        for (int ai = 0; ai < 2; ++ai)
#pragma unroll
            for (int m = 0; m < 4; ++m) { float* rowp = C + (size_t)(row0 + ai * HALF + m * 16) * ldc + col0;
#pragma unroll
                for (int bj = 0; bj < 2; ++bj)
#pragma unroll
                    for (int n = 0; n < 2; ++n) gst16f<TAG>(rowp + bj * HALF + n * 16, acc[ai][bj][m][n]); }
    }
};
struct EpiKr {
    static constexpr int TAG = 1;
    static constexpr bool PERM = false, AFTER_DRAIN = false; static constexpr int KREP = 1;
    float* P;
    __device__ __forceinline__ void operator()(const f32x4 (&acc)[2][2][4][2], const Unit& u, int wr, int wc, int fr, int fq) const {
        if (wc >= 2) return;
        float* base = P + ((size_t)u.pn * NTOK + u.pm * BM + wr * 64 + fr) * ROPE + wc * 32 + 4 * fq;
#pragma unroll
        for (int ai = 0; ai < 2; ++ai)
#pragma unroll
            for (int m = 0; m < 4; ++m)
#pragma unroll
                for (int n = 0; n < 2; ++n) gst16f<TAG>(base + (size_t)(ai * HALF + m * 16) * ROPE + n * 16, acc[ai][0][m][n]);
    }
};
template <int ACT> struct EpiBf16 {
    static constexpr int TAG = 2 + 10 * ACT;
    static constexpr bool PERM = true, AFTER_DRAIN = false; static constexpr int KREP = 1;
    bf16_t* O; int ldc; int split_cols; size_t split_stride; int act_tiles;
    __device__ __forceinline__ void operator()(const f32x4 (&acc)[2][2][4][2], const Unit& u, int wr, int wc, int fr, int fq) const {
        const int row0 = u.pm * BM + wr * 64 + fr; int colt = u.pn * BM; bf16_t* base = O;
        if (split_cols) { const int t = colt / split_cols; base += (size_t)t * split_stride; colt -= t * split_cols; }
        const int col0 = colt + wc * 32 + 8 * fq;
        const bool act = (ACT == 1) && (u.pn < act_tiles);
#pragma unroll
        for (int ai = 0; ai < 2; ++ai)
#pragma unroll
            for (int m = 0; m < 4; ++m) { bf16_t* rowp = base + (size_t)(row0 + ai * HALF + m * 16) * ldc + col0;
#pragma unroll
                for (int bj = 0; bj < 2; ++bj) { f32x4 v0 = acc[ai][bj][m][0], v1 = acc[ai][bj][m][1];
                    if (ACT == 1) { if (act) {
                        f32x4 e0 = v0 * (v0 * v0 * -0.10294324f + -2.3022082f), e1 = v1 * (v1 * v1 * -0.10294324f + -2.3022082f);
#pragma unroll
                        for (int j = 0; j < 4; ++j) { e0[j] = __builtin_amdgcn_exp2f(e0[j]); e1[j] = __builtin_amdgcn_exp2f(e1[j]); }
                        e0 = e0 + 1.0f; e1 = e1 + 1.0f;
#pragma unroll
                        for (int j = 0; j < 4; ++j) { e0[j] = __builtin_amdgcn_rcpf(e0[j]); e1[j] = __builtin_amdgcn_rcpf(e1[j]); }
                        v0 = v0 * e0; v1 = v1 * e1; } }
                    u32x4 w; w.x = cvt_pk_bf16(v0[0], v0[1]); w.y = cvt_pk_bf16(v0[2], v0[3]); w.z = cvt_pk_bf16(v1[0], v1[1]); w.w = cvt_pk_bf16(v1[2], v1[3]);
                    gst16<TAG>(rowp + bj * HALF, w); } }
    }
};
struct EpiQ {
    static constexpr int TAG = 3;
    static constexpr bool PERM = false, AFTER_DRAIN = false; static constexpr int KREP = 1;
    bf16_t* Q; const float* cosT; const float* sinT;
    __device__ __forceinline__ void operator()(const f32x4 (&acc)[2][2][4][2], const Unit& u, int wr, int wc, int fr, int fq) const {
        const int row0 = u.pm * BM + wr * 64 + fr; const bool sample = u.pm >= (MCTX / BM);
#pragma unroll
        for (int bj = 0; bj < 2; ++bj) {
            const int col32 = u.pn * BM + bj * HALF + wc * 32, head = col32 / QKD, d32 = col32 - head * QKD;
            const bool rope = sample && (d32 >= NOPE); const int grp = (d32 - NOPE) >> 5;
#pragma unroll
            for (int ai = 0; ai < 2; ++ai) {
                f32x4 cc[4], ss[4];
                if (rope) {
#pragma unroll
                    for (int m = 0; m < 4; ++m) { const int pos = (row0 + ai * HALF + m * 16 - MCTX) & 1023; cc[m] = *(const f32x4*)(cosT + pos * 32 + grp * 16 + 4 * fq); ss[m] = *(const f32x4*)(sinT + pos * 32 + grp * 16 + 4 * fq); } }
#pragma unroll
                for (int m = 0; m < 4; ++m) { const int row = row0 + ai * HALF + m * 16;
                    f32x4 v0 = acc[ai][bj][m][0], v1 = acc[ai][bj][m][1];
                    if (rope) { const f32x4 y0 = v0 * cc[m] - v1 * ss[m], y1 = v1 * cc[m] + v0 * ss[m]; v0 = y0; v1 = y1; }
                    u32x2 w0, w1; w0.x = cvt_pk_bf16(v0[0], v0[1]); w0.y = cvt_pk_bf16(v0[2], v0[3]); w1.x = cvt_pk_bf16(v1[0], v1[1]); w1.y = cvt_pk_bf16(v1[2], v1[3]);
                    const auto rx = __builtin_amdgcn_permlane16_swap(w0.x, w1.x, false, false), ry = __builtin_amdgcn_permlane16_swap(w0.y, w1.y, false, false);
                    u32x4 w4; w4.x = rx[0]; w4.y = ry[0]; w4.z = rx[1]; w4.w = ry[1];
                    gst16<TAG>(Q + (size_t)row * NQ + col32 + (fq >> 1) * 8 + (fq & 1) * 16, w4); } }
        }
    }
};
template <int KR = 1> struct EpiResT {
    static constexpr int TAG = 4;
    static constexpr bool PERM = true, AFTER_DRAIN = false; static constexpr int KREP = KR;
    bf16_t* X; const float* gate;
    __device__ __forceinline__ void operator()(const f32x4 (&acc)[2][2][4][2], const Unit& u, int wr, int wc, int fr, int fq) const {
        const int row0 = u.pm * BM + wr * 64 + fr, col0 = u.pn * BM + wc * 32 + 8 * fq;
        const int mod = u.pm < (MCTX / BM) ? 0 : 1 + ((u.pm - MCTX / BM) >> 2);
        const float* gp = gate + (size_t)mod * ADA_N + col0;
        f32x4 gv[2][2];
#pragma unroll
        for (int bj = 0; bj < 2; ++bj)
#pragma unroll
            for (int n = 0; n < 2; ++n) gv[bj][n] = *(const f32x4*)(gp + bj * HALF + n * 4);
        u32x4 cur[2], nxt[2];
#pragma unroll
        for (int bj = 0; bj < 2; ++bj) cur[bj] = *(const u32x4*)(X + (size_t)row0 * D + col0 + bj * HALF);
#pragma unroll
        for (int k = 0; k < 8; ++k) { const int ai = k >> 2, m = k & 3; bf16_t* rowp = X + (size_t)(row0 + ai * HALF + m * 16) * D + col0;
            if (k < 7) { const bf16_t* nrow = X + (size_t)(row0 + ((k + 1) >> 2) * HALF + ((k + 1) & 3) * 16) * D + col0;
#pragma unroll
                for (int bj = 0; bj < 2; ++bj) nxt[bj] = *(const u32x4*)(nrow + bj * HALF); }
#pragma unroll
            for (int bj = 0; bj < 2; ++bj) { const u32x4 xw = cur[bj];
                const f32x4 x0 = (f32x4){bf_lo(xw.x), bf_hi(xw.x), bf_lo(xw.y), bf_hi(xw.y)} + gv[bj][0] * acc[ai][bj][m][0];
                const f32x4 x1 = (f32x4){bf_lo(xw.z), bf_hi(xw.z), bf_lo(xw.w), bf_hi(xw.w)} + gv[bj][1] * acc[ai][bj][m][1];
                u32x4 w; w.x = cvt_pk_bf16(x0[0], x0[1]); w.y = cvt_pk_bf16(x0[2], x0[3]); w.z = cvt_pk_bf16(x1[0], x1[1]); w.w = cvt_pk_bf16(x1[2], x1[3]);
                gst16<TAG>(rowp + bj * HALF, w); cur[bj] = nxt[bj]; }
            asm volatile("" ::: "memory"); }
    }
};
typedef EpiResT<1> EpiRes;
#ifndef MK_GOLD
#define MK_GOLD 0
#endif
#if MK_GOLD
#define GSC_B 1.0f
#define GSC_S 1.0f
#else
#define GSC_B 1.4426950408889634f
#define GSC_S -1.0f
#endif
struct EpiGates {
    static constexpr int TAG = 5;
    static constexpr bool PERM = true, AFTER_DRAIN = false; static constexpr int KREP = 1;
    bf16_t* LA; bf16_t* UU; const bf16_t* XC; const float* bgx; const float* bga; const float* sp; PG8_LAS float* prm;
    __device__ __forceinline__ void operator()(const f32x4 (&acc)[2][2][4][2], const Unit& u, int wr, int wc, int fr, int fq) const {
        const int blk = u.pn >> 1, dir = u.pn & 1, row0 = u.pm * BM + wr * 64 + fr, chw = wc * 32 + 8 * fq, ch0 = blk * 128 + chw;
        const char* xcb = (const char*)XC; char* lab = (char*)(LA + (size_t)dir * NTOK * D); char* uub = (char*)(UU + (size_t)dir * NTOK * D);
        { const int t = (wr * 4 + wc) * 64 + fq * 16 + fr;
          const int c4 = (t & 31) * 4, go = dir * D + blk * 128 + c4;
          if (t < 32) *(PG8_LAS f32x4*)(prm + c4) = *(const f32x4*)(bgx + go) * GSC_B;
          else if (t < 64) *(PG8_LAS f32x4*)(prm + 128 + c4) = *(const f32x4*)(bga + go) * GSC_B;
          else if (t < 96) *(PG8_LAS f32x4*)(prm + 256 + c4) = *(const f32x4*)(sp + go) * GSC_S; }
        asm volatile("s_waitcnt vmcnt(0) lgkmcnt(0)" ::: "memory"); __builtin_amdgcn_s_barrier(); asm volatile("" ::: "memory");
#pragma unroll
        for (int aq = 0; aq < 4; ++aq) { const int ai = aq >> 1; u32x4 xw[4];
#pragma unroll
            for (int m = (aq & 1) * 2; m < (aq & 1) * 2 + 2; ++m) xw[m] = *(const u32x4*)(xcb + ((unsigned)(row0 + ai * HALF + m * 16) * D + ch0) * 2u);
#pragma unroll
            for (int m = (aq & 1) * 2; m < (aq & 1) * 2 + 2; ++m) { const unsigned ro = ((unsigned)(row0 + ai * HALF + m * 16) * D + ch0) * 2u; u32x4 wl, wu;
#pragma unroll
                for (int n = 0; n < 2; ++n) { const unsigned x01 = n ? xw[m].z : xw[m].x, x23 = n ? xw[m].w : xw[m].y;
                    const f32x4 bx = *(const PG8_LAS f32x4*)(prm + chw + 4 * n), ba = *(const PG8_LAS f32x4*)(prm + 128 + chw + 4 * n), sv = *(const PG8_LAS f32x4*)(prm + 256 + chw + 4 * n);
#if MK_GOLD
                    const float xv[4] = {bf_lo(x01), bf_hi(x01), bf_lo(x23), bf_hi(x23)}; float l2[4], uv[4];
#pragma unroll
                    for (int j = 0; j < 4; ++j) { const float sx = fast_sigmoid(acc[ai][0][m][n][j] + bx[j]), sa = fast_sigmoid(acc[ai][1][m][n][j] + ba[j]);
                        l2[j] = -sa * sv[j]; const float a2 = __builtin_amdgcn_exp2f(2.0f * l2[j]); uv[j] = __builtin_amdgcn_sqrtf(fmaxf(1.0f - a2, 0.0f)) * sx * xv[j]; }
#else
                    const f32x4 xv = {bf_lo(x01), bf_hi(x01), bf_lo(x23), bf_hi(x23)};
                    f32x4 ex = acc[ai][0][m][n] * 1.4426950408889634f + bx, ea = acc[ai][1][m][n] * 1.4426950408889634f + ba;
#pragma unroll
                    for (int j = 0; j < 4; ++j) { ex[j] = __builtin_amdgcn_exp2f(-ex[j]); ea[j] = __builtin_amdgcn_exp2f(-ea[j]); }
                    ex = ex + 1.0f; ea = ea + 1.0f;
#pragma unroll
                    for (int j = 0; j < 4; ++j) { ex[j] = __builtin_amdgcn_rcpf(ex[j]); ea[j] = __builtin_amdgcn_rcpf(ea[j]); }
                    const f32x4 l2 = ea * sv; f32x4 av;
#pragma unroll
                    for (int j = 0; j < 4; ++j) av[j] = __builtin_amdgcn_exp2f(l2[j]);
                    f32x4 om = av * av - 1.0f;
#pragma unroll
                    for (int j = 0; j < 4; ++j) om[j] = __builtin_amdgcn_sqrtf(__builtin_fabsf(om[j]));
                    const f32x4 uv = om * ex * xv;
#endif
                    if (n == 0) { wl.x = cvt_pk_bf16(l2[0], l2[1]); wl.y = cvt_pk_bf16(l2[2], l2[3]); wu.x = cvt_pk_bf16(uv[0], uv[1]); wu.y = cvt_pk_bf16(uv[2], uv[3]); }
                    else { wl.z = cvt_pk_bf16(l2[0], l2[1]); wl.w = cvt_pk_bf16(l2[2], l2[3]); wu.z = cvt_pk_bf16(uv[0], uv[1]); wu.w = cvt_pk_bf16(uv[2], uv[3]); }
                    __builtin_amdgcn_sched_barrier(0); }
                gst16<TAG>(lab + ro, wl); gst16<TAG>(uub + ro, wu); }
            asm volatile("" ::: "memory"); }
    }
};

struct EpiGatesLds {
    static constexpr int TAG = 7;
    static constexpr bool PERM = true, AFTER_DRAIN = true; static constexpr int KREP = 1;
    const bf16_t* XC; const float* bgx; const float* bga; const float* sp; PG8_LAS float* prm;
    __device__ __forceinline__ void operator()(const f32x4 (&)[2][2][4][2], const Unit&, int, int, int, int) const {}
    __device__ __forceinline__ f32x4 pre(const Unit& u, int t) const { f32x4 r = {0.f, 0.f, 0.f, 0.f};
        const int blk = u.pn >> 1, dir = u.pn & 1, go = dir * D + blk * 128 + (t & 31) * 4;
        if (t < 32) r = *(const f32x4*)(bgx + go); else if (t < 64) r = *(const f32x4*)(bga + go); else if (t < 96) r = *(const f32x4*)(sp + go);
        return r; }
    __device__ __forceinline__ void fused(const f32x4 (&acc)[2][2][4][2], const Unit& u, int wr, int wc, int fr, int fq, PG8_LAS unsigned char* img, const f32x4 pf) const {
        const int blk = u.pn >> 1, dir = u.pn & 1, rl0 = wr * 64 + fr, row0 = u.pm * BM + rl0, chw = wc * 32 + 8 * fq, ch0 = blk * 128 + chw;
        const char* xcb = (const char*)XC;
        u32x4 xa[2][4];
#pragma unroll
        for (int m = 0; m < 4; ++m) xa[0][m] = *(const u32x4*)(xcb + ((unsigned)(row0 + m * 16) * D + ch0) * 2u);
        { const int t = (wr * 4 + wc) * 64 + fq * 16 + fr;
          if (t < 96) *(PG8_LAS f32x4*)(prm + (t >> 5) * 128 + (t & 31) * 4) = pf * (t < 64 ? GSC_B : GSC_S); }
        asm volatile("s_waitcnt lgkmcnt(0)" ::: "memory"); __builtin_amdgcn_s_barrier(); asm volatile("" ::: "memory");
#pragma unroll
        for (int aq = 0; aq < 4; ++aq) { const int ai = aq >> 1;
            if (aq == 0) {
#pragma unroll
                for (int m = 0; m < 4; ++m) xa[1][m] = *(const u32x4*)(xcb + ((unsigned)(row0 + HALF + m * 16) * D + ch0) * 2u); }
#pragma unroll
            for (int m = (aq & 1) * 2; m < (aq & 1) * 2 + 2; ++m) { const int rl = rl0 + ai * HALF + m * 16;
#pragma unroll
                for (int n = 0; n < 2; ++n) { const unsigned x01 = n ? xa[ai][m].z : xa[ai][m].x, x23 = n ? xa[ai][m].w : xa[ai][m].y;
                    const f32x4 bx = *(const PG8_LAS f32x4*)(prm + chw + 4 * n), ba = *(const PG8_LAS f32x4*)(prm + 128 + chw + 4 * n), sv = *(const PG8_LAS f32x4*)(prm + 256 + chw + 4 * n);
                    const f32x4 xv = {bf_lo(x01), bf_hi(x01), bf_lo(x23), bf_hi(x23)};
                    f32x4 ex = acc[ai][0][m][n] * 1.4426950408889634f + bx, ea = acc[ai][1][m][n] * 1.4426950408889634f + ba;
#pragma unroll
                    for (int j = 0; j < 4; ++j) { ex[j] = __builtin_amdgcn_exp2f(-ex[j]); ea[j] = __builtin_amdgcn_exp2f(-ea[j]); }
                    ex = ex + 1.0f; ea = ea + 1.0f;
#pragma unroll
                    for (int j = 0; j < 4; ++j) { ex[j] = __builtin_amdgcn_rcpf(ex[j]); ea[j] = __builtin_amdgcn_rcpf(ea[j]); }
                    const f32x4 l2 = ea * sv; f32x4 av;
#pragma unroll
                    for (int j = 0; j < 4; ++j) av[j] = __builtin_amdgcn_exp2f(l2[j]);
                    f32x4 om = av * av - 1.0f;
#pragma unroll
                    for (int j = 0; j < 4; ++j) om[j] = __builtin_amdgcn_sqrtf(__builtin_fabsf(om[j]));
                    const f32x4 uv = om * ex * xv;
                    u32x4 w; w.x = cvt_pk_bf16(l2[0], uv[0]); w.y = cvt_pk_bf16(l2[1], uv[1]); w.z = cvt_pk_bf16(l2[2], uv[2]); w.w = cvt_pk_bf16(l2[3], uv[3]);
                    const int chunk = (wc * 8 + 2 * fq + n) ^ (rl & 31);
                    *(PG8_LAS u32x4*)(img + rl * 512 + chunk * 16) = w;
                    __builtin_amdgcn_sched_barrier(0); } }
            asm volatile("" ::: "memory"); }
    }
};

__device__ __forceinline__ f32x4 dpp_ror1(f32x4 v) { f32x4 r;
#pragma unroll
    for (int j = 0; j < 4; ++j) r[j] = __int_as_float(__builtin_amdgcn_mov_dpp(__float_as_int(v[j]), 0x121, 0xf, 0xf, false)); return r; }
__device__ __forceinline__ f32x4 dpp_rol1(f32x4 v) { f32x4 r;
#pragma unroll
    for (int j = 0; j < 4; ++j) r[j] = __int_as_float(__builtin_amdgcn_mov_dpp(__float_as_int(v[j]), 0x12f, 0xf, 0xf, false)); return r; }
#ifndef MK_KREP_F1
#define MK_KREP_F1 1
#endif
struct EpiFfn {
    static constexpr int TAG = 6;
    static constexpr bool PERM = true, AFTER_DRAIN = false; static constexpr int KREP = MK_KREP_F1;
    bf16_t* ACT; float* HALO; const float* wcv; const float* bcv; PG8_LAS float* edge;
    __device__ __forceinline__ f32x4 pre(const Unit& u, int t) const { f32x4 r = {0.f, 0.f, 0.f, 0.f};
        if (t < 256) { const int p2 = t >> 5, p = p2 >> 1, bjp = p2 & 1, c4 = (t & 31) * 4; const float* src = (p < 3 ? wcv + (size_t)p * NUP : bcv) + bjp * DFF + u.pn * HALF + c4; asm volatile("global_load_dwordx4 %0, %1, off" : "=&v"(r) : "v"(src) : "memory"); }
        return r; }
    __device__ __forceinline__ void operator()(const f32x4 (&acc)[2][2][4][2], const Unit& u, int wr, int wc, int fr, int fq, const f32x4 pf) const {
        const int chw = wc * 32 + 8 * fq;
#pragma unroll
        for (int ai = 0; ai < 2; ++ai) { const int grp = 2 * ai + wr;
            if (fr == 0) {
#pragma unroll
                for (int bj = 0; bj < 2; ++bj)
#pragma unroll
                    for (int n = 0; n < 2; ++n) *(PG8_LAS f32x4*)(edge + (grp * 2 + 0) * 256 + bj * HALF + chw + 4 * n) = acc[ai][bj][0][n]; }
            if (fr == 15) {
#pragma unroll
                for (int bj = 0; bj < 2; ++bj)
#pragma unroll
                    for (int n = 0; n < 2; ++n) *(PG8_LAS f32x4*)(edge + (grp * 2 + 1) * 256 + bj * HALF + chw + 4 * n) = acc[ai][bj][3][n]; } }
        PG8_LAS float* prm = edge + 4 * 2 * 256;
        { const int t = (wr * 4 + wc) * 64 + fq * 16 + fr;
          asm volatile("s_waitcnt vmcnt(8)" ::: "memory");
          if (t < 256) { const int p2 = t >> 5, bjp = p2 & 1, c4 = (t & 31) * 4;
              *(PG8_LAS f32x4*)(prm + p2 * 128 + c4) = pf * (bjp ? -0.6931471805599453f : -1.4426950408889634f); } }
        asm volatile("s_waitcnt lgkmcnt(0)" ::: "memory"); __builtin_amdgcn_s_barrier(); asm volatile("" ::: "memory");
        if (u.pm >= MCTX / BM) { float* hb = HALO + (size_t)u.pm * 4 * NUP + u.pn * HALF + chw;
            if (wr == 0 && fr < 2) {
#pragma unroll
                for (int bj = 0; bj < 2; ++bj)
#pragma unroll
                    for (int n = 0; n < 2; ++n) *(f32x4*)(hb + (size_t)fr * NUP + bj * DFF + 4 * n) = acc[0][bj][0][n]; }
            if (wr == 1 && fr >= 14) {
#pragma unroll
                for (int bj = 0; bj < 2; ++bj)
#pragma unroll
                    for (int n = 0; n < 2; ++n) *(f32x4*)(hb + (size_t)(fr - 12) * NUP + bj * DFF + 4 * n) = acc[1][bj][3][n]; } }
#pragma unroll
        for (int ai = 0; ai < 2; ++ai) { const int grp = 2 * ai + wr; u32x2 o0[4];
#pragma unroll
            for (int n = 0; n < 2; ++n) { f32x4 gval[4];
#pragma unroll
                for (int bj = 0; bj < 2; ++bj) {
                    const f32x4 w0 = *(const PG8_LAS f32x4*)(prm + (0 + bj) * 128 + chw + 4 * n), w1 = *(const PG8_LAS f32x4*)(prm + (2 + bj) * 128 + chw + 4 * n), w2 = *(const PG8_LAS f32x4*)(prm + (4 + bj) * 128 + chw + 4 * n), bb = *(const PG8_LAS f32x4*)(prm + (6 + bj) * 128 + chw + 4 * n);
                    const f32x4 hp = grp > 0 ? *(const PG8_LAS f32x4*)(edge + ((grp - 1) * 2 + 1) * 256 + bj * HALF + chw + 4 * n) : (f32x4){0.f, 0.f, 0.f, 0.f};
                    const f32x4 hn = grp < 3 ? *(const PG8_LAS f32x4*)(edge + ((grp + 1) * 2 + 0) * 256 + bj * HALF + chw + 4 * n) : (f32x4){0.f, 0.f, 0.f, 0.f};
                    f32x4 rr[4], ll[4];
#pragma unroll
                    for (int m = 0; m < 4; ++m) { rr[m] = dpp_ror1(acc[ai][bj][m][n]); ll[m] = dpp_rol1(acc[ai][bj][m][n]); }
#pragma unroll
                    for (int m = 0; m < 4; ++m) { const f32x4 rp = m > 0 ? rr[m - 1] : hp, ln = m < 3 ? ll[m + 1] : hn; f32x4 pv, nx;
#pragma unroll
                        for (int j = 0; j < 4; ++j) { pv[j] = __int_as_float(__builtin_amdgcn_update_dpp(__float_as_int(rp[j]), __float_as_int(acc[ai][bj][m][n][j]), 0x111, 0xf, 0xf, false));
                                                      nx[j] = __int_as_float(__builtin_amdgcn_update_dpp(__float_as_int(ln[j]), __float_as_int(acc[ai][bj][m][n][j]), 0x101, 0xf, 0xf, false)); }
                        const f32x4 val = bb + w0 * pv + w1 * acc[ai][bj][m][n] + w2 * nx;
                        if (bj == 0) gval[m] = val;
                        else { f32x4 e;
#pragma unroll
                            for (int j = 0; j < 4; ++j) e[j] = __builtin_amdgcn_exp2f(gval[m][j]);
                            e = e + 1.0f;
#pragma unroll
                            for (int j = 0; j < 4; ++j) e[j] = __builtin_amdgcn_rcpf(e[j]);
                            const f32x4 o = gval[m] * val * e;
                            u32x2 w; w.x = cvt_pk_bf16(o[0], o[1]); w.y = cvt_pk_bf16(o[2], o[3]);
                            if (n == 0) o0[m] = w;
                            else { u32x4 w4; w4.x = o0[m].x; w4.y = o0[m].y; w4.z = w.x; w4.w = w.y;
                                gst16<TAG>(ACT + (size_t)(u.pm * BM + ai * HALF + wr * 64 + m * 16 + fr) * ALD + u.pn * HALF + chw, w4); } } }
                    __builtin_amdgcn_sched_barrier(0); } } }
    }
};

template <class Epi, class Sched, bool ALIGN_EPI = false, bool SP2 = false>
__device__ __forceinline__ void gemm_phase(PG8_LAS unsigned char* lds, const Gemm g, const Sched& S, const Epi& E, int wave0  ) {
    int tid_ = wave0 * 64 + lane_now(); asm volatile("" : "+v"(tid_));
    const int tid = tid_, wid = __builtin_amdgcn_readfirstlane(tid >> 6), lane = tid & 63, wr = wid >> 2, wc = wid & 3, fr = lane & 15, fq = lane >> 4;
    const int K = g.K, nt = K / BK;
    unsigned voffA[2], voffB[2];
#pragma unroll
    for (int i = 0; i < 2; ++i) { int R, C; stage_rc(tid * 16 + i * 8192, R, C); const int Rb = Epi::PERM ? ((R & ~31) + perm32(R & 31)) : R;
        voffA[i] = (unsigned)(R * g.lda + C) * 2u; voffB[i] = (unsigned)(Rb * g.ldb + C) * 2u; }
    const size_t kstep = (size_t)(BK * 2);
    const size_t hstepA = (size_t)HALF * g.lda * 2, hstepB = g.b_hstep;
    const size_t tstepA = 2 * hstepA, tstepB = g.b_tstep;
    const unsigned ldsw = (unsigned)wid * 1024u;
    const int aoff = lds_byte(wr * 64 + fr, fq * 8), boff = lds_byte(wc * 32 + fr, fq * 8);
#define PG8_SA(b, h) (((b) * 2 + (h)) * HTB)
#define PG8_SB(b, h) ((4 + (b) * 2 + (h)) * HTB)
#define PG8_STAGE(bufoff, gbase, voff) do { _Pragma("unroll") for (int _i = 0; _i < 2; ++_i) { unsigned vo_ = (voff)[_i]; asm volatile("" : "+v"(vo_));     \
        __builtin_amdgcn_global_load_lds((const unsigned*)((const char*)(gbase) + vo_), (PG8_LAS unsigned*)(lds + (bufoff) + ldsw + _i * 8192), 16, 0, 0); } } while (0)
#define PG8_LDA(dst, b, h) do { _Pragma("unroll") for (int m = 0; m < 4; ++m) _Pragma("unroll") for (int k = 0; k < 2; ++k) dst[m][k] = *(const PG8_LAS bf16x8*)(lds + PG8_SA(b, h) + aoff + m * 2048 + k * 1024); } while (0)
#define PG8_LDB(dst, b, h) do { _Pragma("unroll") for (int n = 0; n < 2; ++n) _Pragma("unroll") for (int k = 0; k < 2; ++k) dst[n][k] = *(const PG8_LAS bf16x8*)(lds + PG8_SB(b, h) + boff + n * 2048 + k * 1024); } while (0)
#define PG8_MMA(ai, bj, At, Bt) do { __builtin_amdgcn_s_setprio(1); _Pragma("unroll") for (int m = 0; m < 4; ++m) _Pragma("unroll") for (int n = 0; n < 2; ++n) _Pragma("unroll") for (int k = 0; k < 2; ++k) \
        acc[ai][bj][m][n] = __builtin_amdgcn_mfma_f32_16x16x32_bf16(Bt[n][k], At[m][k], acc[ai][bj][m][n], 0, 0, 0); __builtin_amdgcn_s_setprio(0); } while (0)
#define PG8_WAIT_V(n) asm volatile("s_waitcnt vmcnt(" #n ")" ::: "memory")
#define PG8_WAIT_L(n) asm volatile("s_waitcnt lgkmcnt(" #n ")" ::: "memory")
#define PG8_BAR __builtin_amdgcn_s_barrier()
#define PG8_SCHED __builtin_amdgcn_sched_barrier(0)
    Unit cur, nxt; int ui = 0;
    if (!S.next(0, cur)) return;
    f32x4 acc[2][2][4][2];
#pragma unroll
    for (int a = 0; a < 2; ++a)
#pragma unroll
        for (int b = 0; b < 2; ++b)
#pragma unroll
            for (int m = 0; m < 4; ++m)
#pragma unroll
                for (int n = 0; n < 2; ++n) acc[a][b][m][n] = (f32x4){0.f, 0.f, 0.f, 0.f};
    bf16x8 At[4][2], B0[2][2], B1[2][2];
    const char* cA = (const char*)g.A + (size_t)cur.pm * tstepA + S.acol(cur); const char* cB = (const char*)g.Bt + (size_t)cur.pn * tstepB + S.bcol(cur);
    S.a_ready(cur);
    if constexpr (SP2) {
        PG8_STAGE(PG8_SB(0, 0), cB, voffB); PG8_STAGE(PG8_SB(0, 1), cB + hstepB, voffB); PG8_STAGE(PG8_SA(0, 0), cA, voffA); PG8_STAGE(PG8_SA(0, 1), cA + hstepA, voffA);
        if (wr == 1) PG8_BAR;
        PG8_WAIT_V(2); PG8_BAR;
        PG8_STAGE(PG8_SB(1, 0), cB + kstep, voffB); PG8_STAGE(PG8_SA(1, 0), cA + kstep, voffA); PG8_STAGE(PG8_SB(1, 1), cB + hstepB + kstep, voffB);
        PG8_WAIT_V(6); PG8_BAR;
    } else {
        PG8_STAGE(PG8_SB(0, 0), cB, voffB); PG8_STAGE(PG8_SA(0, 0), cA, voffA); PG8_STAGE(PG8_SB(0, 1), cB + hstepB, voffB); PG8_STAGE(PG8_SA(0, 1), cA + hstepA, voffA);
        if (wr == 1) PG8_BAR;
        PG8_WAIT_V(4); PG8_BAR;
        PG8_STAGE(PG8_SB(1, 0), cB + kstep, voffB); PG8_STAGE(PG8_SA(1, 0), cA + kstep, voffA); PG8_STAGE(PG8_SB(1, 1), cB + hstepB + kstep, voffB);
        PG8_WAIT_V(6); PG8_BAR;
    }
    f32x4 epre = {0.f, 0.f, 0.f, 0.f};
    if constexpr (Epi::TAG == 7) epre = E.pre(cur, tid);
    for (;;) {
        if constexpr (Epi::TAG == 6) epre = E.pre(cur, tid);
        const bool has_next = S.next(ui + 1, nxt);
        const char* nA = has_next ? (const char*)g.A + (size_t)nxt.pm * tstepA + S.acol(nxt) : cA; const char* nB = has_next ? (const char*)g.Bt + (size_t)nxt.pn * tstepB + S.bcol(nxt) : cB;
#ifdef MK_KREP
        const int ntt = nt * Epi::KREP;
        for (int t0_ = 0; t0_ < ntt; t0_ += 2) {
            const bool last = (t0_ == ntt - 2); const int t = t0_ % nt, tw = (t + 2) % nt;
#else
        for (int t = 0; t < nt; t += 2) {
            const bool last = (t == nt - 2); const int tw = t + 2;
#endif
            const char* a1 = cA + (size_t)(t + 1) * kstep;
            const char* a2 = last ? nA : cA + (size_t)tw * kstep; const char* b2 = last ? nB : cB + (size_t)tw * kstep;
            const char* a3 = a2 + kstep; const char* b3 = b2 + kstep;
            if (last && has_next) S.a_ready(nxt);
            if constexpr (SP2) {
            PG8_LDB(B0, 0, 0); PG8_LDB(B1, 0, 1); PG8_SCHED; PG8_LDA(At, 0, 0); PG8_STAGE(PG8_SA(1, 1), a1 + hstepA, voffA);
            PG8_WAIT_V(8); PG8_WAIT_L(0); PG8_BAR; PG8_MMA(0, 0, At, B0); PG8_MMA(0, 1, At, B1); PG8_BAR; PG8_SCHED;
            PG8_LDA(At, 0, 1); PG8_STAGE(PG8_SB(0, 0), b2, voffB); PG8_STAGE(PG8_SB(0, 1), b2 + hstepB, voffB); PG8_STAGE(PG8_SA(0, 0), a2, voffA);
            PG8_WAIT_V(8); PG8_WAIT_L(0); PG8_BAR; PG8_MMA(1, 0, At, B0); PG8_MMA(1, 1, At, B1); PG8_BAR; PG8_SCHED;
            PG8_LDB(B0, 1, 0); PG8_LDB(B1, 1, 1); PG8_SCHED; PG8_LDA(At, 1, 0); PG8_STAGE(PG8_SA(0, 1), a2 + hstepA, voffA);
            PG8_WAIT_V(8); PG8_WAIT_L(0); PG8_BAR; PG8_MMA(0, 0, At, B0); PG8_MMA(0, 1, At, B1); PG8_BAR; PG8_SCHED;
            PG8_LDA(At, 1, 1); PG8_STAGE(PG8_SB(1, 0), b3, voffB); PG8_STAGE(PG8_SB(1, 1), b3 + hstepB, voffB); PG8_STAGE(PG8_SA(1, 0), a3, voffA);
            PG8_WAIT_V(8); PG8_WAIT_L(0); PG8_BAR; PG8_MMA(1, 0, At, B0); PG8_MMA(1, 1, At, B1); PG8_BAR; PG8_SCHED;
            } else {
            PG8_LDB(B0, 0, 0); PG8_SCHED; PG8_LDA(At, 0, 0); PG8_STAGE(PG8_SA(1, 1), a1 + hstepA, voffA);
            PG8_WAIT_L(8); PG8_BAR; PG8_WAIT_L(0); PG8_MMA(0, 0, At, B0); PG8_BAR; PG8_SCHED;
            PG8_LDB(B1, 0, 1); PG8_STAGE(PG8_SB(0, 0), b2, voffB);
            PG8_BAR; PG8_WAIT_L(0); PG8_MMA(0, 1, At, B1); PG8_BAR;
            PG8_LDA(At, 0, 1); PG8_STAGE(PG8_SA(0, 0), a2, voffA);
            PG8_BAR; PG8_WAIT_L(0); PG8_MMA(1, 0, At, B0); PG8_BAR; PG8_SCHED;
            PG8_STAGE(PG8_SB(0, 1), b2 + hstepB, voffB);
            PG8_WAIT_V(6); PG8_BAR; PG8_MMA(1, 1, At, B1); PG8_BAR;
            PG8_LDB(B0, 1, 0); PG8_SCHED; PG8_LDA(At, 1, 0); PG8_STAGE(PG8_SA(0, 1), a2 + hstepA, voffA);
            PG8_WAIT_L(8); PG8_BAR; PG8_WAIT_L(0); PG8_MMA(0, 0, At, B0); PG8_BAR; PG8_SCHED;
            PG8_LDB(B1, 1, 1); PG8_STAGE(PG8_SB(1, 0), b3, voffB);
            PG8_BAR; PG8_WAIT_L(0); PG8_MMA(0, 1, At, B1); PG8_BAR;
            PG8_LDA(At, 1, 1); PG8_STAGE(PG8_SA(1, 0), a3, voffA);
            PG8_BAR; PG8_WAIT_L(0); PG8_MMA(1, 0, At, B0); PG8_BAR; PG8_SCHED;
            PG8_STAGE(PG8_SB(1, 1), b3 + hstepB, voffB);
            PG8_WAIT_V(6); PG8_BAR; PG8_MMA(1, 1, At, B1); PG8_BAR;
            }
        }
        if constexpr (ALIGN_EPI) { if (wr == 0) PG8_BAR; }
        #ifdef MK_KREP
        if constexpr (Epi::KREP > 1) {
#pragma unroll
            for (int a = 0; a < 2; ++a)
#pragma unroll
                for (int b = 0; b < 2; ++b)
#pragma unroll
                    for (int m = 0; m < 4; ++m)
#pragma unroll
                        for (int n = 0; n < 2; ++n) acc[a][b][m][n] *= (1.0f / Epi::KREP); }
#endif
        if constexpr (!Epi::AFTER_DRAIN) { int t2 = lane_now(); asm volatile("" : "+v"(t2));
            if constexpr (Epi::TAG == 6) E(acc, cur, wr, wc, t2 & 15, (t2 & 63) >> 4, epre); else E(acc, cur, wr, wc, t2 & 15, (t2 & 63) >> 4);
#ifdef MK_EPI2
            if constexpr (Epi::TAG == MK_EPI2 && Epi::TAG != 6) { asm volatile("" ::: "memory"); E(acc, cur, wr, wc, t2 & 15, (t2 & 63) >> 4); }
#endif
            S.done(cur); }
        if (!has_next) break;
#pragma unroll
        for (int a = 0; a < 2; ++a)
#pragma unroll
            for (int b = 0; b < 2; ++b)
#pragma unroll
                for (int m = 0; m < 4; ++m)
#pragma unroll
                    for (int n = 0; n < 2; ++n) acc[a][b][m][n] = (f32x4){0.f, 0.f, 0.f, 0.f};
        cur = nxt; cA = nA; cB = nB; ++ui;
        if constexpr (ALIGN_EPI) { if (wr == 1) PG8_BAR; }
    }
    PG8_WAIT_V(0);
    if constexpr (!ALIGN_EPI) { if (wr == 0) PG8_BAR; }
    PG8_BAR;
    if constexpr (Epi::AFTER_DRAIN) { if constexpr (Epi::TAG == 7) E.fused(acc, cur, wr, wc, fr, fq, lds, epre); else E.fused(acc, cur, wr, wc, fr, fq, lds, wid, lane); S.done(cur); }
#undef PG8_SA
#undef PG8_SB
#undef PG8_STAGE
#undef PG8_LDA
#undef PG8_LDB
#undef PG8_MMA
#undef PG8_WAIT_V
#undef PG8_WAIT_L
#undef PG8_BAR
#undef PG8_SCHED
}

__device__ __forceinline__ void gate_stage(PG8_LAS unsigned char* lds, const Gemm g, int pm, int pn, int wave0) {
    int tid_ = wave0 * 64 + lane_now(); asm volatile("" : "+v"(tid_));
    const int tid = tid_, wid = __builtin_amdgcn_readfirstlane(tid >> 6);
    const unsigned ldsw = (unsigned)wid * 1024u;
    const char* cA = (const char*)g.A + (size_t)pm * (2 * (size_t)HALF * g.lda * 2) + (size_t)(pn >> 1) * 256; const char* cB = (const char*)g.Bt + (size_t)pn * g.b_tstep;
    const size_t hstepA = (size_t)HALF * g.lda * 2, hstepB = g.b_hstep;
#pragma unroll
    for (int i = 0; i < 2; ++i) { int R, C; stage_rc(tid * 16 + i * 8192, R, C); const int Rb = (R & ~31) + perm32(R & 31);
        const unsigned voA = (unsigned)(R * g.lda + C) * 2u, voB = (unsigned)(Rb * g.ldb + C) * 2u;
#pragma unroll
        for (int b = 0; b < 2; ++b)
#pragma unroll
            for (int h = 0; h < 2; ++h) {
                __builtin_amdgcn_global_load_lds((const unsigned*)(cA + h * hstepA + b * (BK * 2) + voA), (PG8_LAS unsigned*)(lds + ((b * 2 + h) * HTB) + ldsw + i * 8192), 16, 0, 0);
                __builtin_amdgcn_global_load_lds((const unsigned*)(cB + h * hstepB + b * (BK * 2) + voB), (PG8_LAS unsigned*)(lds + ((4 + b * 2 + h) * HTB) + ldsw + i * 8192), 16, 0, 0); } }
}
__device__ __forceinline__ void gate_compute(const PG8_LAS unsigned char* lds, f32x4 (&acc)[2][2][4][2], int wr, int wc, int fr, int fq) {
    const int aoff = lds_byte(wr * 64 + fr, fq * 8), boff = lds_byte(wc * 32 + fr, fq * 8);
#pragma unroll
    for (int a = 0; a < 2; ++a)
#pragma unroll
        for (int b = 0; b < 2; ++b)
#pragma unroll
            for (int m = 0; m < 4; ++m)
#pragma unroll
                for (int n = 0; n < 2; ++n) acc[a][b][m][n] = (f32x4){0.f, 0.f, 0.f, 0.f};
#pragma unroll
    for (int kb = 0; kb < 2; ++kb) { bf16x8 B0[2][2], B1[2][2];
#pragma unroll
        for (int n = 0; n < 2; ++n)
#pragma unroll
            for (int k = 0; k < 2; ++k) { B0[n][k] = *(const PG8_LAS bf16x8*)(lds + (4 + kb * 2 + 0) * HTB + boff + n * 2048 + k * 1024); B1[n][k] = *(const PG8_LAS bf16x8*)(lds + (4 + kb * 2 + 1) * HTB + boff + n * 2048 + k * 1024); }
#pragma unroll
        for (int ai = 0; ai < 2; ++ai) { bf16x8 At[4][2];
#pragma unroll
            for (int m = 0; m < 4; ++m)
#pragma unroll
                for (int k = 0; k < 2; ++k) At[m][k] = *(const PG8_LAS bf16x8*)(lds + (kb * 2 + ai) * HTB + aoff + m * 2048 + k * 1024);
#pragma unroll
            for (int m = 0; m < 4; ++m)
#pragma unroll
                for (int n = 0; n < 2; ++n)
#pragma unroll
                    for (int k = 0; k < 2; ++k) { acc[ai][0][m][n] = __builtin_amdgcn_mfma_f32_16x16x32_bf16(B0[n][k], At[m][k], acc[ai][0][m][n], 0, 0, 0);
                                                  acc[ai][1][m][n] = __builtin_amdgcn_mfma_f32_16x16x32_bf16(B1[n][k], At[m][k], acc[ai][1][m][n], 0, 0, 0); } } }
}
}

#define GAS __attribute__((address_space(1)))
#define LAS __attribute__((address_space(3)))
typedef unsigned short bf16;
typedef unsigned v4u __attribute__((ext_vector_type(4)));
typedef float f32x4 __attribute__((ext_vector_type(4)));
typedef short bf16x8 __attribute__((ext_vector_type(8)));
typedef GAS unsigned gu32;
typedef GAS unsigned long long gu64;
#define RLX_AGENT __ATOMIC_RELAXED, __HIP_MEMORY_SCOPE_AGENT
#define LDS_WAIT() asm volatile("s_waitcnt lgkmcnt(0)" ::: "memory")
#define VM_WAIT() asm volatile("s_waitcnt vmcnt(0)" ::: "memory")
__device__ __forceinline__ unsigned long long rt() { return __builtin_amdgcn_s_memrealtime(); }
__device__ __forceinline__ unsigned f2bf(float f) { unsigned u = __builtin_bit_cast(unsigned, f); return (u + 0x7fffu + ((u >> 16) & 1u)) >> 16; }
__device__ __forceinline__ unsigned pk2(float lo, float hi) { unsigned r; asm("v_cvt_pk_bf16_f32 %0, %1, %2" : "=v"(r) : "v"(lo), "v"(hi)); return r; }

#define XB_TMO      128
#define XB_XCNT(j)  (256  + 64 * (j))
#define XB_XSUB(j)  (1280 + 64 * (j))
#define XB_XGEN(j)  (2304 + 64 * (j))
#define XB_TOP      3328
#define XB_TOPGEN   3392
#define XCD_BAR_WORDS 3456
#define XB_SPIN_CAP (1u << 18)

__device__ __forceinline__ unsigned xb_ld(unsigned* p)              { return __hip_atomic_load(p, __ATOMIC_RELAXED, __HIP_MEMORY_SCOPE_AGENT); }
__device__ __forceinline__ unsigned xb_add(unsigned* p, unsigned v) { return __hip_atomic_fetch_add(p, v, __ATOMIC_RELAXED, __HIP_MEMORY_SCOPE_AGENT); }
__device__ __forceinline__ unsigned xb_xcc_id() { return (unsigned)__builtin_amdgcn_s_getreg((3 << 11) | 20) & 0xFu; }
#define XB_SPIN(cond, bar) do { unsigned _sp = 0; while (cond) { __builtin_amdgcn_s_sleep(1); \
    if ((++_sp & 255u) == 0u) { if (xb_ld(&(bar)[XB_TMO])) break; if (_sp > XB_SPIN_CAP) { atomicAdd(&(bar)[XB_TMO], 1u); break; } } } } while (0)

struct XcdBarrier {
    unsigned* bar; unsigned x;
    volatile LAS unsigned* st;
};

__device__ __forceinline__ XcdBarrier xcd_barrier_post(unsigned* bar, volatile LAS unsigned* st, bool t0  ) {
    XcdBarrier b; b.bar = bar; b.x = xb_xcc_id(); b.st = st;
    if (t0) (void)xb_add(&bar[XB_XCNT(b.x)], 1u);
    return b;
}
__device__ __forceinline__ void xcd_barrier_complete(unsigned* bar, unsigned x, unsigned& nloc, unsigned& nx) {
    const unsigned G = gridDim.x * gridDim.y * gridDim.z;
    unsigned sum, cnt, mine, sp = 0u;
    for (;;) {
        sum = 0u; cnt = 0u; mine = 0u;
#pragma unroll
        for (unsigned j = 0; j < 16; ++j) { const unsigned c = xb_ld(&bar[XB_XCNT(j)]); sum += c; cnt += (c > 0u) ? 1u : 0u; mine = (j == x) ? c : mine; }
        if (sum == G) break;
        __builtin_amdgcn_s_sleep(1);
        if ((++sp & 255u) == 0u) { if (xb_ld(&bar[XB_TMO])) break; if (sp > XB_SPIN_CAP) { atomicAdd(&bar[XB_TMO], 1u); break; } }
    }
    nloc = mine > 0u ? mine : 1u; nx = cnt > 0u ? cnt : 1u;
}

__device__ __forceinline__ void xcd_barrier(const XcdBarrier& b, bool t0  ) {
    asm volatile("s_waitcnt vmcnt(0)" ::: "memory");
    __syncthreads();
    if (t0) {
        unsigned* bar = b.bar; asm volatile("" : "+s"(bar));
        __builtin_amdgcn_s_waitcnt(0);
        unsigned nloc = b.st[0], nx = b.st[1];
        if (nloc == 0u) { xcd_barrier_complete(bar, b.x, nloc, nx); b.st[0] = nloc; b.st[1] = nx; }
        const unsigned old = xb_add(&bar[XB_XSUB(b.x)], 1u);
        const unsigned gen = old / nloc;
        if (old + 1u == (gen + 1u) * nloc) {
            __builtin_amdgcn_fence(__ATOMIC_RELEASE, "agent");
            asm volatile("s_waitcnt vmcnt(0)" ::: "memory");
            const unsigned og = xb_add(&bar[XB_TOP], 1u);
            const unsigned tg = og / nx;
            if (og + 1u == (tg + 1u) * nx) xb_add(&bar[XB_TOPGEN], 1u);
            else XB_SPIN(xb_ld(&bar[XB_TOPGEN]) == tg, bar);
            __builtin_amdgcn_fence(__ATOMIC_ACQUIRE, "agent");
            xb_add(&bar[XB_XGEN(b.x)], 1u);
            asm volatile("s_waitcnt vmcnt(0)" ::: "memory");
        } else {
            XB_SPIN(xb_ld(&bar[XB_XGEN(b.x)]) == gen, bar);
            __builtin_amdgcn_fence(__ATOMIC_ACQUIRE, "agent");
            asm volatile("s_waitcnt vmcnt(0)" ::: "memory");
        }
    }
    __syncthreads();
}

namespace att {
using bf16x8 = __attribute__((ext_vector_type(8))) short;
using s16x4  = __attribute__((ext_vector_type(4))) short;
using f32x16 = __attribute__((ext_vector_type(16))) float;
using u32x4  = __attribute__((ext_vector_type(4))) unsigned;
using f32x4  = __attribute__((ext_vector_type(4))) float;
typedef unsigned short bf16;
constexpr int QBLK = 32, KVBLK = 64, NW = 8;
constexpr float SCALE = 0.07216878364870322f;
constexpr float THR = 8.f;
constexpr int LDQ = NQ, LDKN = D, LDKR = ROPE, LDV = D, LDO = D;
constexpr int SHM_V = KVBLK * 128 * 2, SHM_K = KVBLK * 128 * 2, SHM_R = KVBLK * 64 * 2;
constexpr int OFF_V = 0  , OFF_K = 3 * SHM_V  , OFF_R = OFF_K + 2 * SHM_K  , OFF_QR = OFF_R + 2 * SHM_R  , ATTN_LDS_BYTES = OFF_QR + NW * 4096;
#define KSWZ(row, colB) ((row) * 256 + ((colB) ^ (((row) & 7) << 4)))
#define RSWZ(row, colB) ((row) * 128 + ((colB) ^ ((((row) >> 1) & 7) << 4)))
#define SBAR() __builtin_amdgcn_sched_barrier(0)
__device__ __forceinline__ int crow(int r, int hi) { return (r & 3) + 8 * (r >> 2) + 4 * hi; }
__device__ __forceinline__ unsigned cvtpk(float lo, float hi) { unsigned r; asm("v_cvt_pk_bf16_f32 %0, %1, %2" : "=v"(r) : "v"(lo), "v"(hi)); return r; }
#define ATT_INTERLEAVE() do { _Pragma("unroll") for (int i_ = 0; i_ < 12; ++i_) { __builtin_amdgcn_sched_group_barrier(0x100, 3, 0); __builtin_amdgcn_sched_group_barrier(0x008, 2, 0); __builtin_amdgcn_sched_group_barrier(0x002, 12, 0); } } while (0)

__device__ __forceinline__ void partialSM(f32x16& p0, f32x16& p1, float& m_reg, float& mn, float& alpha) {
  constexpr float C = SCALE * 1.4426950408889634f;
  float pmax = p0[0];
#pragma unroll
  for (int r = 1; r < 16; ++r) pmax = fmaxf(pmax, p0[r]);
#pragma unroll
  for (int r = 0; r < 16; ++r) pmax = fmaxf(pmax, p1[r]);
  { auto rr = __builtin_amdgcn_permlane32_swap(__float_as_uint(pmax), __float_as_uint(pmax), false, false);
    pmax = fmaxf(__uint_as_float(rr[0]), __uint_as_float(rr[1])); }
  if (__builtin_expect(__all(pmax - m_reg <= THR / SCALE), 1)) { mn = m_reg; alpha = 1.f; }
  else { mn = fmaxf(m_reg, pmax); alpha = __builtin_amdgcn_exp2f((m_reg - mn) * C); m_reg = mn; }
  float mnC = -mn * C;
#pragma unroll
  for (int r = 0; r < 16; ++r) p0[r] = fmaf(p0[r], C, mnC);
#pragma unroll
  for (int r = 0; r < 16; ++r) p1[r] = fmaf(p1[r], C, mnC);
#pragma unroll
  for (int r = 0; r < 16; ++r) p0[r] = __builtin_amdgcn_exp2f(p0[r]);
}
__device__ __forceinline__ void finishSM(f32x16& p0, f32x16& p1, float alpha, float& l_reg, bf16x8& pa0, bf16x8& pa1, bf16x8& pa2, bf16x8& pa3) {
#pragma unroll
  for (int r = 0; r < 16; ++r) p1[r] = __builtin_amdgcn_exp2f(p1[r]);
  float ps = 0;
#pragma unroll
  for (int r = 0; r < 16; ++r) ps += p0[r];
#pragma unroll
  for (int r = 0; r < 16; ++r) ps += p1[r];
  { auto rr = __builtin_amdgcn_permlane32_swap(__float_as_uint(ps), __float_as_uint(ps), false, false);
    ps = __uint_as_float(rr[0]) + __uint_as_float(rr[1]); }
  l_reg = l_reg * alpha + ps;
#define PK4(P, BASE, OUT) do { unsigned a0 = cvtpk(P[BASE + 0], P[BASE + 1]), a1 = cvtpk(P[BASE + 2], P[BASE + 3]);   \
    unsigned b0 = cvtpk(P[BASE + 4], P[BASE + 5]), b1 = cvtpk(P[BASE + 6], P[BASE + 7]);                              \
    auto r0 = __builtin_amdgcn_permlane32_swap(a0, b0, false, false); auto r1 = __builtin_amdgcn_permlane32_swap(a1, b1, false, false); \
    u32x4 w = {r0[0], r1[0], r0[1], r1[1]}; OUT = *reinterpret_cast<bf16x8*>(&w); } while (0)
  PK4(p0, 0, pa0); PK4(p0, 8, pa1); PK4(p1, 0, pa2); PK4(p1, 8, pa3);
#undef PK4
}
__device__ __forceinline__ void qkt(f32x16& p0, f32x16& p1, const char* Ks, const char* Rs, const char* Qs, const char* Q7s  , const bf16x8* qr, int r32, int hi) {
  p0 = f32x16{}; p1 = f32x16{};
  bf16x8 b0 = *reinterpret_cast<const bf16x8*>(Ks + KSWZ(r32, (hi * 8) * 2)), b1 = *reinterpret_cast<const bf16x8*>(Ks + KSWZ(32 + r32, (hi * 8) * 2)), qf = qr[0];
#pragma unroll
  for (int d0 = 0; d0 < 12; ++d0) {
    bf16x8 n0 = b0, n1 = b1, nq = qf;
    if (d0 + 1 < 8) { const int cb = ((d0 + 1) * 16 + hi * 8) * 2; n0 = *reinterpret_cast<const bf16x8*>(Ks + KSWZ(r32, cb)); n1 = *reinterpret_cast<const bf16x8*>(Ks + KSWZ(32 + r32, cb)); if (d0 + 1 < 7) nq = qr[d0 + 1]; else nq = *reinterpret_cast<const bf16x8*>(Q7s); }
    else if (d0 + 1 < 12) { const int cb = ((d0 + 1 - 8) * 16 + hi * 8) * 2; n0 = *reinterpret_cast<const bf16x8*>(Rs + RSWZ(r32, cb)); n1 = *reinterpret_cast<const bf16x8*>(Rs + RSWZ(32 + r32, cb)); nq = *reinterpret_cast<const bf16x8*>(Qs + RSWZ(r32, cb)); }
    p0 = __builtin_amdgcn_mfma_f32_32x32x16_bf16(b0, qf, p0, 0, 0, 0);
    p1 = __builtin_amdgcn_mfma_f32_32x32x16_bf16(b1, qf, p1, 0, 0, 0);
    b0 = n0; b1 = n1; qf = nq; }
}
__device__ __forceinline__ int v_st(int k, int c) { const int kk = (k & ~0xC) | ((k & 4) << 1) | ((k & 8) >> 1); return ((kk >> 3) * 4 + (c >> 5)) * 512 + ((kk & 7) * 32 + (c & 31)) * 2; }
__device__ __forceinline__ int v_rd_base(int lane) { return ((lane & 3) << 3) | (((lane >> 2) & 3) << 6) | (((lane >> 4) & 1) << 5) | (((lane >> 5) & 1) << 8); }
constexpr int v_rd_off(int d0, int ks, int half) { return d0 * 512 + ks * 4096 + half * 2048; }
template <int OFF> __device__ __forceinline__ s16x4 tr_read(int vb) {
  s16x4 r; asm volatile("ds_read_b64_tr_b16 %0, %1 offset:%2" : "=&v"(r) : "v"(vb), "i"(OFF) : "memory"); return r;
}
template <int D0> __device__ __forceinline__ void pv_one(f32x16& od, int vb, bf16x8 pa0, bf16x8 pa1, bf16x8 pa2, bf16x8 pa3) {
  const s16x4 l0 = tr_read<v_rd_off(D0, 0, 0)>(vb), h0 = tr_read<v_rd_off(D0, 0, 1)>(vb), l1 = tr_read<v_rd_off(D0, 1, 0)>(vb), h1 = tr_read<v_rd_off(D0, 1, 1)>(vb);
  const s16x4 l2 = tr_read<v_rd_off(D0, 2, 0)>(vb), h2 = tr_read<v_rd_off(D0, 2, 1)>(vb), l3 = tr_read<v_rd_off(D0, 3, 0)>(vb), h3 = tr_read<v_rd_off(D0, 3, 1)>(vb);
  asm volatile("s_waitcnt lgkmcnt(0)" ::: "memory"); SBAR();
#define PK(L, H) (bf16x8){L[0], L[1], L[2], L[3], H[0], H[1], H[2], H[3]}
  od = __builtin_amdgcn_mfma_f32_32x32x16_bf16(pa0, PK(l0, h0), od, 0, 0, 0);
  od = __builtin_amdgcn_mfma_f32_32x32x16_bf16(pa1, PK(l1, h1), od, 0, 0, 0);
  od = __builtin_amdgcn_mfma_f32_32x32x16_bf16(pa2, PK(l2, h2), od, 0, 0, 0);
  od = __builtin_amdgcn_mfma_f32_32x32x16_bf16(pa3, PK(l3, h3), od, 0, 0, 0);
#undef PK
}
__device__ __forceinline__ void pv_d0(f32x16* o, int vb, bf16x8 pa0, bf16x8 pa1, bf16x8 pa2, bf16x8 pa3) {
  pv_one<0>(o[0], vb, pa0, pa1, pa2, pa3); pv_one<1>(o[1], vb, pa0, pa1, pa2, pa3); pv_one<2>(o[2], vb, pa0, pa1, pa2, pa3); pv_one<3>(o[3], vb, pa0, pa1, pa2, pa3);
}

__device__ __forceinline__ void attn_unit(const bf16* __restrict__ Qb, const bf16* __restrict__ Kn, const bf16* __restrict__ Kr, const bf16* __restrict__ Vh,
                                          bf16* __restrict__ Ob, int seq, char* lds, char* wsl, int wave0) {
  int tid_ = wave0 * 64 + lane_now(); asm volatile("" : "+v"(tid_));
  const int tid = tid_, wid = __builtin_amdgcn_readfirstlane(tid >> 6), lane = tid & 63, r32 = lane & 31, hi = lane >> 5;
  float* ws = (float*)wsl + wid * 64; float* li_l = ws; float* al_l = ws + 32;
  float m_reg = -1e30f, l_reg = 0; f32x16 o[4] = {}; bf16x8 qr[7];
  typedef __attribute__((address_space(3))) unsigned lds_u32;
#define DMA_TILE(t, vs, ks) do { const bf16* gk_ = Kn + (size_t)(t) * KVBLK * LDKN; const bf16* gv_ = Vh + (size_t)(t) * KVBLK * LDV; const bf16* gr_ = Kr + (size_t)(t) * KVBLK * LDKR; \
    int ln_ = lane; asm volatile("" : "+v"(ln_)); \
    _Pragma("unroll") for (int i_ = 0; i_ < 2; ++i_) { const int L16 = wid * 128 + i_ * 64 + ln_; \
      const int rowk_ = L16 >> 4, ck_ = (L16 & 15) ^ (rowk_ & 7); \
      const int sub_ = L16 >> 5, wi_ = L16 & 31, kk_ = ((sub_ >> 2) << 3) | (wi_ >> 2), cv_ = ((sub_ & 3) << 5) + ((wi_ & 3) << 3), kv_ = (kk_ & ~0xC) | ((kk_ & 4) << 1) | ((kk_ & 8) >> 1); \
      __builtin_amdgcn_global_load_lds((const unsigned*)(gv_ + (unsigned)(kv_ * LDV + cv_)), (lds_u32*)(lds + OFF_V + (vs) + (wid * 128 + i_ * 64) * 16), 16, 0, 0); \
      __builtin_amdgcn_global_load_lds((const unsigned*)(gk_ + (unsigned)(rowk_ * LDKN + ck_ * 8)), (lds_u32*)(lds + OFF_K + (ks) * SHM_K + (wid * 128 + i_ * 64) * 16), 16, 0, 0); } \
    { const int L16 = wid * 64 + ln_, rowr_ = L16 >> 3, cr_ = (L16 & 7) ^ ((rowr_ >> 1) & 7); \
      __builtin_amdgcn_global_load_lds((const unsigned*)(gr_ + (unsigned)(rowr_ * LDKR + cr_ * 8)), (lds_u32*)(lds + OFF_R + (ks) * SHM_R + (wid * 64) * 16), 16, 0, 0); } } while (0)
#define TILE_SYNC() do { asm volatile("s_waitcnt vmcnt(0)" ::: "memory"); __syncthreads(); } while (0)
#define RESC(a) do { if (__any((a) < 1.f)) { if (hi == 0) al_l[r32] = (a); asm volatile("s_waitcnt lgkmcnt(0)" ::: "memory"); \
    _Pragma("unroll") for (int d = 0; d < 4; ++d) _Pragma("unroll") for (int r = 0; r < 16; ++r) o[d][r] *= al_l[crow(r, hi)]; } } while (0)
  const int NT = seq / KVBLK;
  int s0 = 0, s1 = SHM_V, s2 = 2 * SHM_V;
  DMA_TILE(0, s0, 0); DMA_TILE(1, s1, 1);
  const bf16* Qw = Qb + (long)(wid * QBLK + r32) * LDQ + hi * 8;
#pragma unroll
  for (int d0 = 0; d0 < 7; ++d0) qr[d0] = *reinterpret_cast<const bf16x8*>(Qw + d0 * 16);
  char* Q7s = wsl + 2048 + wid * 1024 + r32 * 32 + hi * 16;
  *reinterpret_cast<bf16x8*>(Q7s) = *reinterpret_cast<const bf16x8*>(Qw + 7 * 16);
  char* Qs = lds + OFF_QR + wid * 4096;
  { bf16x8 qx[4];
#pragma unroll
    for (int d0 = 0; d0 < 4; ++d0) qx[d0] = *reinterpret_cast<const bf16x8*>(Qw + (8 + d0) * 16);
#pragma unroll
    for (int d0 = 0; d0 < 4; ++d0) *reinterpret_cast<bf16x8*>(Qs + RSWZ(r32, (d0 * 16 + hi * 8) * 2)) = qx[d0]; }
  const int vb0 = (int)(uintptr_t)lds + OFF_V + v_rd_base(lane);
  TILE_SYNC();
  f32x16 pA0, pA1, pB0, pB1; float mnA, mnB, alA, alB; bf16x8 pa0, pa1, pa2, pa3;
  qkt(pA0, pA1, lds + OFF_K, lds + OFF_R, Qs, Q7s, qr, r32, hi); partialSM(pA0, pA1, m_reg, mnA, alA);
  for (int j = 0; j < NT; j += 2) {
    if (j + 2 < NT) DMA_TILE(j + 2, s2, 0);
    SBAR(); qkt(pB0, pB1, lds + OFF_K + SHM_K, lds + OFF_R + SHM_R, Qs, Q7s, qr, r32, hi);
#ifdef MK_AQ2
    asm volatile("" : "+v"(pB0), "+v"(pB1)); qkt(pB0, pB1, lds + OFF_K + SHM_K, lds + OFF_R + SHM_R, Qs, Q7s, qr, r32, hi);
#endif
    finishSM(pA0, pA1, alA, l_reg, pa0, pa1, pa2, pa3); SBAR();
    pv_d0(o, vb0 + s0, pa0, pa1, pa2, pa3);
#ifdef MK_APV2
    { bf16x8 z_ = {0, 0, 0, 0, 0, 0, 0, 0}; asm volatile("" : "+v"(z_)); pv_d0(o, vb0 + s0, z_, z_, z_, z_); }
#endif
    partialSM(pB0, pB1, m_reg, mnB, alB);
    TILE_SYNC(); RESC(alB);
    const bool more = j + 2 < NT;
    if (j + 3 < NT) DMA_TILE(j + 3, s0, 1);
    SBAR(); if (more) qkt(pA0, pA1, lds + OFF_K, lds + OFF_R, Qs, Q7s, qr, r32, hi);
#ifdef MK_AQ2
    asm volatile("" : "+v"(pA0), "+v"(pA1)); if (more) qkt(pA0, pA1, lds + OFF_K, lds + OFF_R, Qs, Q7s, qr, r32, hi);
#endif
    finishSM(pB0, pB1, alB, l_reg, pa0, pa1, pa2, pa3); SBAR();
    pv_d0(o, vb0 + s1, pa0, pa1, pa2, pa3);
#ifdef MK_APV2
    { bf16x8 z_ = {0, 0, 0, 0, 0, 0, 0, 0}; asm volatile("" : "+v"(z_)); pv_d0(o, vb0 + s1, z_, z_, z_, z_); }
#endif
    if (more) partialSM(pA0, pA1, m_reg, mnA, alA);
    TILE_SYNC(); if (more) RESC(alA);
    const int t_ = s0; s0 = s2; s2 = s1; s1 = t_;
  }
  { const int le = lane_now(), r32e = le & 31, hie = le >> 5; float* li_e = (float*)wsl + wid * 64;
    if (hie == 0) li_e[r32e] = l_reg; asm volatile("s_waitcnt lgkmcnt(0)" ::: "memory");
    float rli[16];
#pragma unroll
    for (int r = 0; r < 16; ++r) rli[r] = __builtin_amdgcn_rcpf(li_e[crow(r, hie)]);
    float* os = (float*)(lds + wid * 16384);
#pragma unroll
    for (int r = 0; r < 16; ++r) { const int orow = crow(r, hie);
#pragma unroll
      for (int d0 = 0; d0 < 4; ++d0) os[orow * 128 + d0 * 32 + r32e] = o[d0][r] * rli[r]; }
    asm volatile("s_waitcnt lgkmcnt(0)" ::: "memory");
    bf16* Ow = Ob + (long)(wid * QBLK) * LDO;
#pragma unroll
    for (int i = 0; i < 8; ++i) { const int ch = i * 64 + le, row = ch >> 4, c8 = (ch & 15) * 8;
      const f32x4* sp = (const f32x4*)(os + row * 128 + c8); const f32x4 a = sp[0], b = sp[1];
      u32x4 w = {cvtpk(a[0], a[1]), cvtpk(a[2], a[3]), cvtpk(b[0], b[1]), cvtpk(b[2], b[3])};
      *reinterpret_cast<u32x4*>(Ow + (long)row * LDO + c8) = w; } }
#undef DMA_TILE
#undef TILE_SYNC
#undef RESC
}
}

constexpr size_t MiB = 1u << 20;
constexpr size_t WS_CTL = 0, CTL_ZERO_BYTES = 64 * 1024;
constexpr size_t WS_MODS = 1 * MiB;
constexpr size_t WS_COS = 3 * MiB, WS_SIN = WS_COS + 128 * 1024, WS_SP = WS_SIN + 128 * 1024;
constexpr size_t WS_WIN = 4 * MiB, WS_WUQ = 14 * MiB, WS_WUKV = 20 * MiB, WS_WO = 28 * MiB, WS_WRIN = 44 * MiB, WS_WG = 76 * MiB, WS_WROUT = 80 * MiB, WS_WUP = 96 * MiB, WS_WDN = 272 * MiB;
constexpr size_t WS_X = 362 * MiB, WS_H = 490 * MiB, WS_S = 554 * MiB, WS_END = 1194 * MiB;
constexpr size_t WS_U = WS_S, WS_HALO = WS_S, WS_ACT = WS_S + 352 * MiB;
constexpr size_t WS_PROJ = WS_S, WS_CQ = WS_S + 80 * MiB, WS_CKV = WS_S + 96 * MiB, WS_KR = WS_S + 114 * MiB, WS_Q = WS_S + 117 * MiB, WS_KN = WS_S + 213 * MiB, WS_V = WS_S + 285 * MiB, WS_O = WS_S + 357 * MiB, WS_PKR = WS_S + 421 * MiB;
constexpr size_t WS_RIN = WS_S, WS_XC = WS_S + 128 * MiB, WS_LA = WS_S + 192 * MiB, WS_UU = WS_S + 320 * MiB, WS_HB = WS_S + 448 * MiB, WS_MIX = WS_S + 576 * MiB;
static_assert(WS_WIN + 2ull * NINP * D * 2 <= WS_WUQ && WS_WUQ + 2ull * NQ * QL * 2 <= WS_WUKV && WS_WUKV + 2ull * NKV * KVL * 2 <= WS_WO && WS_WO + 2ull * D * D * 2 <= WS_WRIN, "ws map 1");
static_assert(WS_WRIN + 2ull * 2 * D * D * 2 <= WS_WG && WS_WG + 2ull * 8192 * 128 * 2 <= WS_WROUT && WS_WROUT + 2ull * D * D * 2 <= WS_WUP && WS_WUP + 4ull * NUP * D * 2 <= WS_WDN && WS_WDN + 4ull * D * ALD * 2 <= WS_X, "ws map 2");
static_assert(WS_X + (size_t)NTOK * D * 2 <= WS_H && WS_H + (size_t)NTOK * D * 2 <= WS_S, "ws map 3");
static_assert(WS_U + (size_t)NTOK * NUP * 2 <= WS_ACT && WS_ACT + (size_t)NTOK * ALD * 2 <= WS_END, "ws map ffn");
static_assert(WS_PROJ + (size_t)NTOK * NINP * 4 <= WS_CQ && WS_CQ + (size_t)NTOK * QL * 2 <= WS_CKV && WS_CKV + (size_t)MKV * KVL * 2 <= WS_KR && WS_KR + (size_t)MKV * ROPE * 2 <= WS_Q && WS_Q + (size_t)NTOK * NQ * 2 <= WS_KN
              && WS_KN + (size_t)MKV * D * 2 <= WS_V && WS_V + (size_t)MKV * D * 2 <= WS_O && WS_O + (size_t)NTOK * D * 2 <= WS_END, "ws map attn");
static_assert(WS_RIN + (size_t)NTOK * 2 * D * 2 <= WS_XC && WS_XC + (size_t)NTOK * D * 2 <= WS_LA && WS_LA + 2ull * NTOK * D * 2 <= WS_UU && WS_UU + 2ull * NTOK * D * 2 <= WS_HB && WS_HB + (size_t)NTOK * D * 4 <= WS_MIX && WS_MIX + (size_t)NTOK * D * 2 <= WS_END, "ws map rec");
constexpr int CW_BAR = 1024;
constexpr size_t OUT_Y = 0, OUT_CKV = 2ull * MCTX * D, OUT_KR = OUT_CKV + 32ull * 2 * 256 * KVL, OUT_ST = OUT_KR + 32ull * 2 * 256 * ROPE, OUT_TOTAL = OUT_ST + 32ull * 2 * 2 * D;

constexpr int NWAVES = 8;
constexpr int RING_OFF = 0, RING_BYTES = 131072;
constexpr int LDSCTL_OFF = RING_BYTES, MISC_OFF = LDSCTL_OFF + 320;
constexpr int EDGE_OFF = LDSCTL_OFF + 2048;
constexpr int LDS_BYTES = 147456;
static_assert(MISC_OFF + 128 <= LDS_BYTES && att::ATTN_LDS_BYTES <= RING_BYTES, "LDS map");

struct Args { const float* in[32]; float* out; unsigned char* ws; int ph_lo, ph_hi; };
static_assert(sizeof(Args) == 34 * 8 + 8, "Args has no padding");
struct Frame {
    LAS unsigned char* lds;
    volatile LAS unsigned* MISC;
    int tid, lane, wave;
    int vcu, G;
    float* out;
    unsigned char* ws;
};
__device__ __forceinline__ float shfl_xor_l(float v, int mask, int lane) { return __int_as_float(__builtin_amdgcn_ds_bpermute((lane ^ mask) << 2, __float_as_int(v))); }
__device__ __forceinline__ float wave_sum(float v, int lane) {
#pragma unroll
    for (int o = 1; o < 64; o <<= 1) v += shfl_xor_l(v, o, lane);
    return v;
}
__device__ __forceinline__ int mod_of_row(int m) { return m < MCTX ? 0 : 1 + ((m - MCTX) >> 10); }
__device__ __forceinline__ int kv_row(int m) { return m < MCTX ? m : MCTX + ((m - MCTX) >> 10) * 1280 + 256 + ((m - MCTX) & 1023); }

__device__ __forceinline__ void p0_transpose_item(const float* W, int K, int N, bf16* WT, int row_off, LAS float* scr, int item, int lane, int ldw = 0) {
    if (ldw == 0) ldw = K;
    const int nblk = N / 32; int kb = item / nblk, nb = item % nblk;
#ifndef MK_TRMAP
#define MK_TRMAP 1
#endif
    if (MK_TRMAP == 1 && ((K / 64) & 3) == 0) {
        const int g = item >> 3, w = item & 7, gn = nblk >> 1, kg = g / gn, ng = g - kg * gn; kb = 4 * kg + (w >> 1); nb = 2 * ng + (w & 1); }
    if (MK_TRMAP == 2 && ((K / 64) & 7) == 0) {
        const int g = item >> 3, w = item & 7, kg = g / nblk, ng = g - kg * nblk; kb = 8 * kg + w; nb = ng; }
    const int k0 = 64 * kb, n0 = 32 * nb;
    float wv[32];
#pragma unroll
    for (int i = 0; i < 32; ++i) wv[i] = *(const GAS float*)(W + (size_t)(k0 + 2 * i + (lane >> 5)) * N + n0 + (lane & 31));
#pragma unroll
    for (int i = 0; i < 32; ++i) scr[(2 * i + (lane >> 5)) * 33 + (lane & 31)] = wv[i];
    LDS_WAIT(); asm volatile("" ::: "memory");
    const int c = lane & 7;
#pragma unroll
    for (int j = 0; j < 4; ++j) { const int n = (lane >> 3) + 8 * j; const LAS float* s = scr + (8 * c) * 33 + n;
        v4u o; o.x = pk2(s[0 * 33], s[1 * 33]); o.y = pk2(s[2 * 33], s[3 * 33]); o.z = pk2(s[4 * 33], s[5 * 33]); o.w = pk2(s[6 * 33], s[7 * 33]);
        *(GAS v4u*)(WT + (size_t)(row_off + n0 + n) * ldw + k0 + 8 * c) = o; }
    LDS_WAIT(); asm volatile("" ::: "memory");
}

__device__ __forceinline__ void ada_task(Frame& F, const Args& A, int task) {
    constexpr int CW = 192;
    const int layer = task >> 6, cchunk = task & 63, al = F.lane < 48 ? F.lane : 47;
    LAS float* S = (LAS float*)(F.lds + RING_OFF);
    const float* c_ctx = A.in[6]; const float* cc = A.in[5];
    { f32x4 cv[NMOD];
#pragma unroll
        for (int q = 0; q < NMOD; ++q) cv[q] = *(const GAS f32x4*)((q == 0 ? c_ctx : cc + (q - 1) * D) + 4 * F.tid);
#pragma unroll
        for (int q = 0; q < NMOD; ++q)
#pragma unroll
            for (int i = 0; i < 4; ++i) { const float v = cv[q][i]; S[(4 * F.tid + i) * 12 + q] = v / (1.0f + __expf(-v)); } }
    __syncthreads();
    f32x4 acc[NMOD];
#pragma unroll
    for (int q = 0; q < NMOD; ++q) acc[q] = (f32x4){0.f, 0.f, 0.f, 0.f};
    const int k0 = F.wave * 256;
    const float* wp = A.in[10] + ((size_t)layer * D + k0) * ADA_N + cchunk * CW + al * 4;
    for (int kk = 0; kk < 256; kk += 8) {
        f32x4 w[8];
#pragma unroll
        for (int i = 0; i < 8; ++i) w[i] = *(const GAS f32x4*)(wp + (size_t)(kk + i) * ADA_N);
#pragma unroll
        for (int i = 0; i < 8; ++i) { const LAS f32x4* sp = (const LAS f32x4*)(S + (k0 + kk + i) * 12); const f32x4 s0 = sp[0], s1 = sp[1], s2 = sp[2];
            acc[0] += s0.x * w[i]; acc[1] += s0.y * w[i]; acc[2] += s0.z * w[i]; acc[3] += s0.w * w[i];
            acc[4] += s1.x * w[i]; acc[5] += s1.y * w[i]; acc[6] += s1.z * w[i]; acc[7] += s1.w * w[i]; acc[8] += s2.x * w[i]; }
    }
    __syncthreads();
    LAS float* R = (LAS float*)(F.lds + RING_OFF);
    if (F.lane < 48) {
#pragma unroll
        for (int q = 0; q < NMOD; ++q) *(LAS f32x4*)(R + (F.wave * NMOD + q) * CW + F.lane * 4) = acc[q]; }
    __syncthreads();
    float* mods = (float*)(F.ws + WS_MODS); const float* b_ada = A.in[11];
    for (int idx = F.tid; idx < NMOD * CW; idx += NWAVES * 64) { const int q = idx / CW, cl = idx % CW; float s = b_ada[layer * ADA_N + cchunk * CW + cl];
#pragma unroll
        for (int w = 0; w < NWAVES; ++w) s += R[(w * NMOD + q) * CW + cl];
        mods[(size_t)(layer * NMOD + q) * ADA_N + cchunk * CW + cl] = s; }
    __syncthreads();
}
__device__ __forceinline__ void p0_prologue(Frame& F, const Args& A) {
#ifndef MK_P0A
#define MK_P0A 1
#endif
#ifndef MK_P0T
#define MK_P0T 1
#endif
    for (int ra = 0; ra < MK_P0A; ++ra) if (F.vcu < 256) ada_task(F, A, F.vcu);
    LAS float* scr = (LAS float*)(F.lds + RING_OFF + F.wave * 16384);
    const int gw = F.vcu * NWAVES + F.wave, NGW = F.G * NWAVES;
    bf16* ws16 = (bf16*)F.ws;
    constexpr int I_IN = (D / 64) * (NIN / 32), I_UQ = (QL / 64) * (NQ / 32), I_UK = (KVL / 64) * (D / 32), I_O = (D / 64) * (D / 32), I_RIN = (D / 64) * (2 * D / 32), I_G = 2 * 16 * 8, I_UP = (D / 64) * (NUP / 32), I_DN = (DFF / 64) * (D / 32);
    constexpr int PER_J = I_IN + I_UQ + 2 * I_UK + I_O + I_RIN + I_O + 2 * I_G;
    constexpr int NITEMS = 2 * PER_J + 4 * (I_UP + I_DN);
    for (int rt = 0; rt < MK_P0T; ++rt)
    for (int it = gw; it < NITEMS; it += NGW) {
        int r = it;
        if (r < 2 * PER_J) {
            const int j = r / PER_J; r -= j * PER_J;
            if (r < I_IN) { p0_transpose_item(A.in[12] + (size_t)j * D * NIN, D, NIN, (bf16*)(F.ws + WS_WIN) + (size_t)j * NINP * D, 0, scr, r, F.lane); continue; } r -= I_IN;
            if (r < I_UQ) { p0_transpose_item(A.in[15] + (size_t)j * QL * NQ, QL, NQ, (bf16*)(F.ws + WS_WUQ) + (size_t)j * NQ * QL, 0, scr, r, F.lane); continue; } r -= I_UQ;
            if (r < I_UK) { p0_transpose_item(A.in[16] + (size_t)j * KVL * D, KVL, D, (bf16*)(F.ws + WS_WUKV) + (size_t)j * NKV * KVL, 0, scr, r, F.lane); continue; } r -= I_UK;
            if (r < I_UK) { p0_transpose_item(A.in[17] + (size_t)j * KVL * D, KVL, D, (bf16*)(F.ws + WS_WUKV) + (size_t)j * NKV * KVL, D, scr, r, F.lane); continue; } r -= I_UK;
            if (r < I_O) { p0_transpose_item(A.in[18] + (size_t)j * D * D, D, D, (bf16*)(F.ws + WS_WO) + (size_t)j * D * D, 0, scr, r, F.lane); continue; } r -= I_O;
            if (r < I_RIN) { p0_transpose_item(A.in[19] + (size_t)j * D * 2 * D, D, 2 * D, (bf16*)(F.ws + WS_WRIN) + (size_t)j * 2 * D * D, 0, scr, r, F.lane); continue; } r -= I_RIN;
            if (r < I_O) { p0_transpose_item(A.in[27] + (size_t)j * D * D, D, D, (bf16*)(F.ws + WS_WROUT) + (size_t)j * D * D, 0, scr, r, F.lane); continue; } r -= I_O;
            { const int gate = r / I_G; r -= gate * I_G; const int mat = r >> 3, sub = r & 7, dir = mat >> 4, blk = mat & 15;
              p0_transpose_item(A.in[gate ? 24 : 22] + ((size_t)j * 32 + mat) * 128 * 128, 128, 128, (bf16*)(F.ws + WS_WG) + (size_t)j * 8192 * 128, blk * 512 + dir * 256 + gate * 128, scr, sub, F.lane); continue; }
        }
        r -= 2 * PER_J;
        { const int l = r / (I_UP + I_DN); r -= l * (I_UP + I_DN);
          if (r < I_UP) { p0_transpose_item(A.in[28] + (size_t)l * D * NUP, D, NUP, (bf16*)(F.ws + WS_WUP) + (size_t)l * NUP * D, 0, scr, r, F.lane); continue; } r -= I_UP;
          p0_transpose_item(A.in[31] + (size_t)l * DFF * D, DFF, D, (bf16*)(F.ws + WS_WDN) + (size_t)l * D * ALD, 0, scr, r, F.lane, ALD); }
    }
    (void)ws16;
    const int gt = F.vcu * NWAVES * 64 + F.tid, NGT = F.G * NWAVES * 64;
    for (int i = gt; i < 2 * (NINP - NIN) * D / 8; i += NGT) { const int j = i / ((NINP - NIN) * D / 8), o = i % ((NINP - NIN) * D / 8);
        *(GAS v4u*)((bf16*)(F.ws + WS_WIN) + ((size_t)j * NINP + NIN) * D + (size_t)o * 8) = (v4u){0u, 0u, 0u, 0u}; }
    for (int i = gt; i < 1024 * 32; i += NGT) { const int pos = i >> 5, a = i & 31; const float inv = exp2f(-(float)(2 * (a & 15)) * (13.287712379549449f / 32.0f));
        const float ang = (float)((a < 16) ? (pos >> 6) : (pos & 63)) * inv; float sn, cs; sincosf(ang, &sn, &cs);
        ((float*)(F.ws + WS_COS))[i] = cs; ((float*)(F.ws + WS_SIN))[i] = sn; }
    for (int i = gt; i < 2 * 2 * D; i += NGT) { const float lam = A.in[26][i]; ((float*)(F.ws + WS_SP))[i] = 8.0f * 1.4426950408889634f * log1pf(expf(-lam)); }
}

template <int MODE>
__device__ __forceinline__ void norm_phase(Frame& F, const Args& A, const float* g, const float* modbase  , int shift_idx  ) {
    const int gw = F.vcu * NWAVES + F.wave, NGW = F.G * NWAVES;
    bf16* X = (bf16*)(F.ws + WS_X); bf16* H = (bf16*)(F.ws + WS_H);
    for (int blk = gw; blk < NTOK / 8; blk += NGW) {
        const int m0 = blk * 8;
        f32x4 gs[4][2], sh[4][2];
        if (MODE == 2) {
#pragma unroll
            for (int j = 0; j < 4; ++j)
#pragma unroll
                for (int h = 0; h < 2; ++h) gs[j][h] = *(const GAS f32x4*)(g + 8 * (F.lane + 64 * j) + 4 * h);
        } else { const float* mb = modbase + (size_t)mod_of_row(m0) * ADA_N + (size_t)shift_idx * D;
#pragma unroll
            for (int j = 0; j < 4; ++j)
#pragma unroll
                for (int h = 0; h < 2; ++h) { const int c = 8 * (F.lane + 64 * j) + 4 * h; gs[j][h] = *(const GAS f32x4*)(g + c) * (*(const GAS f32x4*)(mb + D + c) + 1.0f); sh[j][h] = *(const GAS f32x4*)(mb + c); } }
        f32x4 nx[4][2]; v4u nb[4];
#define NORM_LOAD(m) do { if (MODE == 0) { const float* src_ = (m) < MCTX ? A.in[0] + (size_t)(m) * D : A.in[1] + (size_t)((m) - MCTX) * D; \
            _Pragma("unroll") for (int j = 0; j < 4; ++j) { const GAS f32x4* p = (const GAS f32x4*)(src_ + 8 * (F.lane + 64 * j)); nx[j][0] = p[0]; nx[j][1] = p[1]; } } \
        else { _Pragma("unroll") for (int j = 0; j < 4; ++j) nb[j] = *(const GAS v4u*)(X + (size_t)(m) * D + 8 * (F.lane + 64 * j)); } } while (0)
        NORM_LOAD(m0);
#pragma unroll 1
        for (int r = 0; r < 8; ++r) { const int m = m0 + r;
            f32x4 v[4][2];
            if (MODE == 0) {
#pragma unroll
                for (int j = 0; j < 4; ++j) { v[j][0] = nx[j][0]; v[j][1] = nx[j][1]; }
            } else {
#pragma unroll
                for (int j = 0; j < 4; ++j) { const v4u w = nb[j];
                    v[j][0] = (f32x4){pg8::bf_lo(w.x), pg8::bf_hi(w.x), pg8::bf_lo(w.y), pg8::bf_hi(w.y)}; v[j][1] = (f32x4){pg8::bf_lo(w.z), pg8::bf_hi(w.z), pg8::bf_lo(w.w), pg8::bf_hi(w.w)}; } }
            if (r < 7) NORM_LOAD(m + 1);
            if (MODE == 0) {
#pragma unroll
                for (int j = 0; j < 4; ++j) *(GAS v4u*)(X + (size_t)m * D + 8 * (F.lane + 64 * j)) = (v4u){pk2(v[j][0].x, v[j][0].y), pk2(v[j][0].z, v[j][0].w), pk2(v[j][1].x, v[j][1].y), pk2(v[j][1].z, v[j][1].w)}; }
            float s = 0.f;
#pragma unroll
            for (int j = 0; j < 4; ++j)
#pragma unroll
                for (int h = 0; h < 2; ++h) s += (v[j][h].x * v[j][h].x + v[j][h].y * v[j][h].y) + (v[j][h].z * v[j][h].z + v[j][h].w * v[j][h].w);
            const float rstd = 1.0f / sqrtf(wave_sum(s, F.lane) * (1.0f / D) + NORM_EPS);
            if (MODE == 2) { float* yo = F.out + OUT_Y + (size_t)m * D;
#pragma unroll
                for (int j = 0; j < 4; ++j)
#pragma unroll
                    for (int h = 0; h < 2; ++h) *(GAS f32x4*)(yo + 8 * (F.lane + 64 * j) + 4 * h) = v[j][h] * rstd * gs[j][h];
            } else {
#pragma unroll
                for (int j = 0; j < 4; ++j) { const f32x4 h0 = v[j][0] * rstd * gs[j][0] + sh[j][0], h1 = v[j][1] * rstd * gs[j][1] + sh[j][1];
                    *(GAS v4u*)(H + (size_t)m * D + 8 * (F.lane + 64 * j)) = (v4u){pk2(h0.x, h0.y), pk2(h0.z, h0.w), pk2(h1.x, h1.y), pk2(h1.z, h1.w)}; }
            }
        }
#undef NORM_LOAD
    }
}

__device__ __forceinline__ void mla_mid_phase(Frame& F, const Args& A, int j) {
    const int gw = F.vcu * NWAVES + F.wave, NGW = F.G * NWAVES, lane = F.lane;
    const float* PROJ = (const float*)(F.ws + WS_PROJ); bf16* CQ = (bf16*)(F.ws + WS_CQ); bf16* CKV = (bf16*)(F.ws + WS_CKV); bf16* KR = (bf16*)(F.ws + WS_KR);
    const float* gq = A.in[13] + j * QL; const float* gkv = A.in[14] + j * KVL;
    const float* cosT = (const float*)(F.ws + WS_COS); const float* sinT = (const float*)(F.ws + WS_SIN);
    const f32x4 gq0 = *(const GAS f32x4*)(gq + 8 * lane), gq1 = *(const GAS f32x4*)(gq + 8 * lane + 4), gk0 = *(const GAS f32x4*)(gkv + 8 * lane), gk1 = *(const GAS f32x4*)(gkv + 8 * lane + 4);
    for (int m = gw; m < NTOK; m += NGW) {
        const float* pr = PROJ + (size_t)m * NINP;
        const f32x4 q0 = *(const GAS f32x4*)(pr + 8 * lane), q1 = *(const GAS f32x4*)(pr + 8 * lane + 4), k0 = *(const GAS f32x4*)(pr + QL + 8 * lane), k1 = *(const GAS f32x4*)(pr + QL + 8 * lane + 4);
        const float* pk = (const float*)(F.ws + WS_PKR) + (size_t)m * ROPE + lane;
        const float kr = (pk[0] + pk[(size_t)NTOK * ROPE]) + (pk[2ull * NTOK * ROPE] + pk[3ull * NTOK * ROPE]);
        const float sq = wave_sum((q0.x * q0.x + q0.y * q0.y) + (q0.z * q0.z + q0.w * q0.w) + (q1.x * q1.x + q1.y * q1.y) + (q1.z * q1.z + q1.w * q1.w), lane);
        const float sk = wave_sum((k0.x * k0.x + k0.y * k0.y) + (k0.z * k0.z + k0.w * k0.w) + (k1.x * k1.x + k1.y * k1.y) + (k1.z * k1.z + k1.w * k1.w), lane);
        const float rq = 1.0f / sqrtf(sq * (1.0f / QL) + NORM_EPS), rk = 1.0f / sqrtf(sk * (1.0f / KVL) + NORM_EPS);
        const f32x4 a0 = q0 * rq * gq0, a1 = q1 * rq * gq1, c0 = k0 * rk * gk0, c1 = k1 * rk * gk1;
        *(GAS v4u*)(CQ + (size_t)m * QL + 8 * lane) = (v4u){pk2(a0.x, a0.y), pk2(a0.z, a0.w), pk2(a1.x, a1.y), pk2(a1.z, a1.w)};
        const int kvr = kv_row(m);
        *(GAS v4u*)(CKV + (size_t)kvr * KVL + 8 * lane) = (v4u){pk2(c0.x, c0.y), pk2(c0.z, c0.w), pk2(c1.x, c1.y), pk2(c1.z, c1.w)};
        float krv = kr;
        if (m < MCTX) {
            const int b = m >> 8, t = m & 255; float* oc = F.out + OUT_CKV + ((size_t)(b * 2 + j) * 256 + t) * KVL + 8 * lane;
            *(GAS f32x4*)oc = c0; *(GAS f32x4*)(oc + 4) = c1;
            F.out[OUT_KR + ((size_t)(b * 2 + j) * 256 + t) * ROPE + lane] = kr;
        } else {
            const int pos = (m - MCTX) & 1023, ai = (lane & 15) + 16 * (lane >> 5); const float cs = cosT[pos * 32 + ai], sn = sinT[pos * 32 + ai];
            const float other = shfl_xor_l(kr, 16, lane);
            krv = (lane & 16) ? (kr * cs + other * sn) : (kr * cs - other * sn);
        }
        KR[(size_t)kvr * ROPE + lane] = (bf16)f2bf(krv);
    }
    for (int i = gw; i < 8 * 256; i += NGW) { const int b = i >> 8, t = i & 255; const size_t dst = (size_t)MCTX + 1280 * b + t;
        const float* sc = A.in[2] + ((size_t)(b * 2 + j) * 256 + t) * KVL + 8 * lane; const f32x4 c0 = *(const GAS f32x4*)sc, c1 = *(const GAS f32x4*)(sc + 4);
        *(GAS v4u*)(CKV + dst * KVL + 8 * lane) = (v4u){pk2(c0.x, c0.y), pk2(c0.z, c0.w), pk2(c1.x, c1.y), pk2(c1.z, c1.w)};
        KR[dst * ROPE + lane] = (bf16)f2bf(A.in[3][((size_t)(b * 2 + j) * 256 + t) * ROPE + lane]); }
}

__device__ __forceinline__ void attn_phase(Frame& F, char* lds) {
    const att::bf16* Q = (const att::bf16*)(F.ws + WS_Q); const att::bf16* KN = (const att::bf16*)(F.ws + WS_KN); const att::bf16* KR = (const att::bf16*)(F.ws + WS_KR);
    const att::bf16* V = (const att::bf16*)(F.ws + WS_V); att::bf16* O = (att::bf16*)(F.ws + WS_O);
    for (int i = 0; i < 4; ++i) {
        int qrow, krow, h, seq;
        if (i < 2) { const int id = F.vcu * 2 + i, b = id >> 6, rem = id & 63, qb = rem & 3; h = rem >> 2; qrow = MCTX + b * 1024 + qb * 256; krow = MCTX + b * 1280; seq = 1280; }
        else { const int id = F.vcu * 2 + (i - 2), s = id >> 4; h = id & 15; qrow = s * 256; krow = s * 256; seq = 256; }
        __syncthreads();
        att::attn_unit(Q + (size_t)qrow * NQ + h * QKD, KN + (size_t)krow * D + h * NOPE, KR + (size_t)krow * ROPE, V + (size_t)krow * D + h * VD, O + (size_t)qrow * D + h * VD, seq, lds, lds + RING_BYTES + 2048, F.wave);
    }
}

__device__ __forceinline__ void conv4_phase(Frame& F, const Args& A, int j) {
    const int gw = F.vcu * NWAVES + F.wave, NGW = F.G * NWAVES, lane = F.lane;
    const bf16* RIN = (const bf16*)(F.ws + WS_RIN); bf16* XC = (bf16*)(F.ws + WS_XC);
    const float* wc = A.in[20] + (size_t)j * 4 * D; const float* bc = A.in[21] + (size_t)j * D;
    for (int task = gw; task < (NTOK / 32) * 4; task += NGW) {
        const int cg = task & 3, chunk = task >> 2, c0 = cg * 512 + lane * 8;
        float w[4][8], bb[8];
#pragma unroll
        for (int t = 0; t < 4; ++t) { const f32x4 a = *(const GAS f32x4*)(wc + t * D + c0), b = *(const GAS f32x4*)(wc + t * D + c0 + 4); w[t][0] = a.x; w[t][1] = a.y; w[t][2] = a.z; w[t][3] = a.w; w[t][4] = b.x; w[t][5] = b.y; w[t][6] = b.z; w[t][7] = b.w; }
        { const f32x4 a = *(const GAS f32x4*)(bc + c0), b = *(const GAS f32x4*)(bc + c0 + 4); bb[0] = a.x; bb[1] = a.y; bb[2] = a.z; bb[3] = a.w; bb[4] = b.x; bb[5] = b.y; bb[6] = b.z; bb[7] = b.w; }
#pragma unroll 1
        for (int half = 0; half < 2; ++half) {
        const int r0 = chunk * 32 + half * 16;
        const int slen = r0 < MCTX ? 256 : 1024, sbeg = r0 < MCTX ? (r0 & ~255) : MCTX + ((r0 - MCTX) & ~1023), send = sbeg + slen;
        v4u raw[19];
#pragma unroll
        for (int i = 0; i < 19; ++i) { const int r = r0 - 2 + i; raw[i] = (r >= sbeg && r < send) ? *(const GAS v4u*)(RIN + (size_t)r * (2 * D) + D + c0) : (v4u){0u, 0u, 0u, 0u}; }
#pragma unroll
        for (int t = 0; t < 16; ++t) {
            float o[8];
#pragma unroll
            for (int c = 0; c < 8; ++c) o[c] = bb[c];
#pragma unroll
            for (int jj = 0; jj < 4; ++jj) { const v4u x = raw[t + jj];
                o[0] += w[jj][0] * pg8::bf_lo(x.x); o[1] += w[jj][1] * pg8::bf_hi(x.x); o[2] += w[jj][2] * pg8::bf_lo(x.y); o[3] += w[jj][3] * pg8::bf_hi(x.y);
                o[4] += w[jj][4] * pg8::bf_lo(x.z); o[5] += w[jj][5] * pg8::bf_hi(x.z); o[6] += w[jj][6] * pg8::bf_lo(x.w); o[7] += w[jj][7] * pg8::bf_hi(x.w); }
            *(GAS v4u*)(XC + (size_t)(r0 + t) * D + c0) = (v4u){pk2(o[0], o[1]), pk2(o[2], o[3]), pk2(o[4], o[5]), pk2(o[6], o[7])};
        }
        }
    }
}

typedef float sf2 __attribute__((ext_vector_type(2)));
__device__ __forceinline__ sf2 bf2_to_f2(unsigned w) { return (sf2){__uint_as_float(w << 16), __uint_as_float(w & 0xffff0000u)}; }
__device__ __forceinline__ void scan_phase(Frame& F, const Args& A, int j) {
    const int lane = F.lane, wave = F.wave;
    LAS float* aggb = (LAS float*)(F.lds + RING_OFF);
    LAS float* carb = aggb + 2 * 8 * 128 * 2;
    const int nunits = F.vcu < 128 ? 1 : 4; int pass = 0;
    for (int ui = 0; ui < nunits; ++ui) {
        int row0, nsub, cg, bidx; bool ctx;
        if (F.vcu < 128) { const int id = F.vcu; bidx = id >> 4; cg = id & 15; row0 = MCTX + bidx * 1024; nsub = 4; ctx = false; }
        else { const int id = (F.vcu - 128) * 4 + ui; bidx = id >> 4; cg = id & 15; row0 = bidx * 256; nsub = 1; ctx = true; }
        const int ch = cg * 128 + lane * 2;
        const bf16* LAf = (const bf16*)(F.ws + WS_LA) + ch; const bf16* LAb = LAf + (size_t)NTOK * D;
        const bf16* UUf = (const bf16*)(F.ws + WS_UU) + ch; const bf16* UUb = UUf + (size_t)NTOK * D;
        bf16* HB = (bf16*)(F.ws + WS_HB) + ch; const bf16* GY = (const bf16*)(F.ws + WS_RIN) + ch; bf16* MIX = (bf16*)(F.ws + WS_MIX) + ch;
        sf2 hf0 = (sf2){0.f, 0.f}, hb0 = (sf2){0.f, 0.f};
        if (!ctx) { const float* st = A.in[4] + ((size_t)(bidx * 2 + j) * 2) * D + ch; hf0 = *(const GAS sf2*)st; hb0 = *(const GAS sf2*)(st + D); }
        for (int sb = nsub - 1; sb >= 0; --sb, ++pass) {
            const size_t r0 = (size_t)(row0 + sb * 256 + wave * 32);
            unsigned L[32], U[32];
#pragma unroll
            for (int i = 0; i < 32; ++i) { L[i] = *(const GAS unsigned*)(LAb + (r0 + 31 - i) * D); U[i] = *(const GAS unsigned*)(UUb + (r0 + 31 - i) * D); }
            sf2 sl = (sf2){0.f, 0.f}, hl = (sf2){0.f, 0.f};
#pragma unroll
            for (int i = 0; i < 32; ++i) { const sf2 l = bf2_to_f2(L[i]), u = bf2_to_f2(U[i]); sl += l; hl.x = __builtin_amdgcn_exp2f(l.x) * hl.x + u.x; hl.y = __builtin_amdgcn_exp2f(l.y) * hl.y + u.y; }
            LAS float* ag = aggb + (((pass & 1) * 8 + wave) * 128 + lane * 2) * 2;
            *(LAS f32x4*)ag = (f32x4){__builtin_amdgcn_exp2f(sl.x), hl.x, __builtin_amdgcn_exp2f(sl.y), hl.y};
            __syncthreads();
            sf2 h = hb0; if (sb != nsub - 1) h = *(const LAS sf2*)(carb + (pass & 1) * 128 + lane * 2);
            for (int c = 7; c > wave; --c) { const f32x4 q = *(const LAS f32x4*)(aggb + (((pass & 1) * 8 + c) * 128 + lane * 2) * 2); h.x = q.x * h.x + q.y; h.y = q.z * h.y + q.w; }
#pragma unroll
            for (int i = 0; i < 32; ++i) { const sf2 l = bf2_to_f2(L[i]), u = bf2_to_f2(U[i]); h.x = __builtin_amdgcn_exp2f(l.x) * h.x + u.x; h.y = __builtin_amdgcn_exp2f(l.y) * h.y + u.y;
                *(GAS unsigned*)(HB + (r0 + 31 - i) * D) = pk2(h.x, h.y); }
            if (wave == 0) { *(LAS sf2*)(carb + ((pass + 1) & 1) * 128 + lane * 2) = h;
                if (ctx) *(GAS sf2*)(F.out + OUT_ST + ((size_t)(bidx * 2 + j) * 2 + 1) * D + ch) = h; }
        }
        for (int sb = 0; sb < nsub; ++sb, ++pass) {
            const size_t r0 = (size_t)(row0 + sb * 256 + wave * 32);
            unsigned L[32], U[32], G[32], Hh[32];
#pragma unroll
            for (int i = 0; i < 32; ++i) { L[i] = *(const GAS unsigned*)(LAf + (r0 + i) * D); U[i] = *(const GAS unsigned*)(UUf + (r0 + i) * D); }
#pragma unroll
            for (int i = 0; i < 32; ++i) { G[i] = *(const GAS unsigned*)(GY + (r0 + i) * (2 * D)); Hh[i] = *(const GAS unsigned*)(HB + (r0 + i) * D); }
            sf2 sl = (sf2){0.f, 0.f}, hl = (sf2){0.f, 0.f};
#pragma unroll
            for (int i = 0; i < 32; ++i) { const sf2 l = bf2_to_f2(L[i]), u = bf2_to_f2(U[i]); sl += l; hl.x = __builtin_amdgcn_exp2f(l.x) * hl.x + u.x; hl.y = __builtin_amdgcn_exp2f(l.y) * hl.y + u.y; }
            LAS float* ag = aggb + (((pass & 1) * 8 + wave) * 128 + lane * 2) * 2;
            *(LAS f32x4*)ag = (f32x4){__builtin_amdgcn_exp2f(sl.x), hl.x, __builtin_amdgcn_exp2f(sl.y), hl.y};
            __syncthreads();
            sf2 h = hf0; if (sb != 0) h = *(const LAS sf2*)(carb + (pass & 1) * 128 + lane * 2);
            for (int c = 0; c < wave; ++c) { const f32x4 q = *(const LAS f32x4*)(aggb + (((pass & 1) * 8 + c) * 128 + lane * 2) * 2); h.x = q.x * h.x + q.y; h.y = q.z * h.y + q.w; }
#pragma unroll
            for (int i = 0; i < 32; ++i) { const sf2 l = bf2_to_f2(L[i]), u = bf2_to_f2(U[i]), gy = bf2_to_f2(G[i]), hbv = bf2_to_f2(Hh[i]);
                h.x = __builtin_amdgcn_exp2f(l.x) * h.x + u.x; h.y = __builtin_amdgcn_exp2f(l.y) * h.y + u.y;
                *(GAS unsigned*)(MIX + (r0 + i) * D) = pk2((h.x + hbv.x) * gy.x, (h.y + hbv.y) * gy.y); }
            if (wave == 7) { *(LAS sf2*)(carb + ((pass + 1) & 1) * 128 + lane * 2) = h;
                if (ctx) *(GAS sf2*)(F.out + OUT_ST + ((size_t)(bidx * 2 + j) * 2 + 0) * D + ch) = h; }
        }
    }
    __syncthreads();
}


typedef unsigned v2u __attribute__((ext_vector_type(2)));
__device__ __forceinline__ void rs_phase(Frame& F, const Args& A, int j, int wave0) {
    const int nunits = F.vcu < 128 ? 1 : 4; int pass = 0;
    const pg8::Gemm g = pg8::mk_gemm((const pg8::bf16_t*)(F.ws + WS_XC), (const pg8::bf16_t*)(F.ws + WS_WG) + (size_t)j * 8192 * 128, 128, D);
    const pg8::EpiGatesLds E{(const pg8::bf16_t*)(F.ws + WS_XC), A.in[23] + (size_t)j * 2 * D, A.in[25] + (size_t)j * 2 * D, (const float*)(F.ws + WS_SP) + (size_t)j * 2 * D, (LAS float*)(F.lds + EDGE_OFF)};
    const bool lat = F.vcu < 128; const int nsub = lat ? 4 : 1, npass = 8;
    auto pass_unit = [&](int p, pg8::Unit& u) { const int ui = lat ? 0 : (p >> 1), q = lat ? p : (p & 1), sweep = q / nsub, si = q - sweep * nsub, sb = sweep ? si : nsub - 1 - si;
        const int id = lat ? F.vcu : (F.vcu - 128) * 4 + ui, bidx = id >> 4, cg = id & 15, row0 = lat ? MCTX + bidx * 1024 : bidx * 256;
        u.pm = (row0 >> 8) + sb; u.pn = 2 * cg + (sweep ? 0 : 1); };
    pg8::Unit ucur; pass_unit(0, ucur);
    f32x4 pf; { int tq = wave0 * 64 + lane_now(); asm volatile("" : "+v"(tq)); pf = E.pre(ucur, tq); }
    pg8::gate_stage(F.lds + RING_OFF, g, ucur.pm, ucur.pn, wave0);
    (void)nunits;
#pragma unroll 1
    for (int p = 0; p < npass; ++p, ++pass) {
        const int ui = lat ? 0 : (p >> 1), q = lat ? p : (p & 1), sweep = q / nsub, si = q - sweep * nsub, sb = sweep ? si : nsub - 1 - si;
        const int id = lat ? F.vcu : (F.vcu - 128) * 4 + ui, bidx = id >> 4, cg = id & 15, row0 = lat ? MCTX + bidx * 1024 : bidx * 256; const bool ctx = !lat;
        if (p == 0) asm volatile("s_waitcnt vmcnt(0)" ::: "memory"); else asm volatile("s_waitcnt vmcnt(32)" ::: "memory");
        __syncthreads();
        { int t_ = wave0 * 64 + lane_now(); asm volatile("" : "+v"(t_)); F.tid = t_; F.lane = t_ & 63; F.wave = __builtin_amdgcn_readfirstlane(t_ >> 6); }
        { f32x4 acc[2][2][4][2]; const int wr = F.wave >> 2, wc = F.wave & 3, fr = F.lane & 15, fq = F.lane >> 4;
          pg8::gate_compute(F.lds + RING_OFF, acc, wr, wc, fr, fq);
          __syncthreads();
          E.fused(acc, ucur, wr, wc, fr, fq, F.lds + RING_OFF, pf); }
        __syncthreads();
        const int lane = F.lane, wave = F.wave;
        LAS float* aggb = (LAS float*)(F.lds + EDGE_OFF + 2048);
        LAS float* carb = aggb + 8 * 128 * 2;
        const LAS unsigned char* img = F.lds + RING_OFF;
        const int ch = cg * 128 + lane * 2;
        bf16* HB = (bf16*)(F.ws + WS_HB) + ch; const bf16* GY = (const bf16*)(F.ws + WS_RIN) + ch; bf16* MIX = (bf16*)(F.ws + WS_MIX) + ch;
        const size_t r0 = (size_t)(row0 + sb * 256 + wave * 32);
        unsigned W0[32], W1[32];
#pragma unroll
        for (int i = 0; i < 32; ++i) { const int rl = wave * 32 + (sweep ? i : 31 - i);
            const v2u w = *(const LAS v2u*)(img + rl * 512 + (((lane >> 1) ^ (rl & 31)) << 4) + ((lane & 1) << 3)); W0[i] = w.x; W1[i] = w.y; }
        asm volatile("s_waitcnt lgkmcnt(0)" ::: "memory");
        __syncthreads();
        if (p + 1 < npass) { pass_unit(p + 1, ucur); { int tq = wave0 * 64 + lane_now(); asm volatile("" : "+v"(tq)); pf = E.pre(ucur, tq); }
            pg8::gate_stage(F.lds + RING_OFF, g, ucur.pm, ucur.pn, wave0); }
        unsigned G[32], Hh[32];
#pragma unroll
        for (int i = 0; i < 32; ++i) { G[i] = 0u; Hh[i] = 0u; }
        if (sweep) {
#pragma unroll
            for (int i = 0; i < 32; ++i) { G[i] = *(const GAS unsigned*)(GY + (r0 + i) * (2 * D)); Hh[i] = *(const GAS unsigned*)(HB + (r0 + i) * D); } }
        sf2 sl = (sf2){0.f, 0.f}, hl = (sf2){0.f, 0.f};
#pragma unroll
        for (int i = 0; i < 32; ++i) { const sf2 l = (sf2){pg8::bf_lo(W0[i]), pg8::bf_lo(W1[i])}, u = (sf2){pg8::bf_hi(W0[i]), pg8::bf_hi(W1[i])};
            sl += l; hl.x = __builtin_amdgcn_exp2f(l.x) * hl.x + u.x; hl.y = __builtin_amdgcn_exp2f(l.y) * hl.y + u.y; }
        LAS float* ag = aggb + (wave * 128 + lane * 2) * 2;
        *(LAS f32x4*)ag = (f32x4){__builtin_amdgcn_exp2f(sl.x), hl.x, __builtin_amdgcn_exp2f(sl.y), hl.y};
        __syncthreads();
        sf2 h;
        if (si == 0) { h = (sf2){0.f, 0.f};
            if (!ctx) { const float* st = A.in[4] + ((size_t)(bidx * 2 + j) * 2) * D + ch; h = *(const GAS sf2*)(st + (sweep ? 0 : D)); } }
        else h = *(const LAS sf2*)(carb + (pass & 1) * 128 + lane * 2);
        if (sweep == 0) {
            for (int c = 7; c > wave; --c) { const f32x4 qv = *(const LAS f32x4*)(aggb + (c * 128 + lane * 2) * 2); h.x = qv.x * h.x + qv.y; h.y = qv.z * h.y + qv.w; }
#pragma unroll
            for (int i = 0; i < 32; ++i) { const sf2 l = (sf2){pg8::bf_lo(W0[i]), pg8::bf_lo(W1[i])}, u = (sf2){pg8::bf_hi(W0[i]), pg8::bf_hi(W1[i])};
                h.x = __builtin_amdgcn_exp2f(l.x) * h.x + u.x; h.y = __builtin_amdgcn_exp2f(l.y) * h.y + u.y;
                *(GAS unsigned*)(HB + (r0 + 31 - i) * D) = pk2(h.x, h.y); }
            if (wave == 0) { *(LAS sf2*)(carb + ((pass + 1) & 1) * 128 + lane * 2) = h;
                if (ctx) *(GAS sf2*)(F.out + OUT_ST + ((size_t)(bidx * 2 + j) * 2 + 1) * D + ch) = h; }
        } else {
            for (int c = 0; c < wave; ++c) { const f32x4 qv = *(const LAS f32x4*)(aggb + (c * 128 + lane * 2) * 2); h.x = qv.x * h.x + qv.y; h.y = qv.z * h.y + qv.w; }
#pragma unroll
            for (int i = 0; i < 32; ++i) { const sf2 l = (sf2){pg8::bf_lo(W0[i]), pg8::bf_lo(W1[i])}, u = (sf2){pg8::bf_hi(W0[i]), pg8::bf_hi(W1[i])}, gy = bf2_to_f2(G[i]), hbv = bf2_to_f2(Hh[i]);
                h.x = __builtin_amdgcn_exp2f(l.x) * h.x + u.x; h.y = __builtin_amdgcn_exp2f(l.y) * h.y + u.y;
                *(GAS unsigned*)(MIX + (r0 + i) * D) = pk2((h.x + hbv.x) * gy.x, (h.y + hbv.y) * gy.y); }
            if (wave == 7) { *(LAS sf2*)(carb + ((pass + 1) & 1) * 128 + lane * 2) = h;
                if (ctx) *(GAS sf2*)(F.out + OUT_ST + ((size_t)(bidx * 2 + j) * 2 + 0) * D + ch) = h; }
        }
    }
    asm volatile("s_waitcnt vmcnt(0)" ::: "memory"); __syncthreads();
}

__device__ __forceinline__ void ffn_fix_panel(Frame& F, const Args& A, int layer, int pm) {
    if (pm < MCTX / 256) return;
    const float* HALO = (const float*)(F.ws + WS_HALO); bf16* ACT = (bf16*)(F.ws + WS_ACT);
    const float* wc = A.in[29] + (size_t)layer * 3 * NUP; const float* bc = A.in[30] + (size_t)layer * NUP;
    const float* hc = HALO + (size_t)pm * 4 * NUP; const int k = (pm - MCTX / 256) & 3;
    const bool top = k != 0, bot = k != 3;
    for (int c4 = F.tid; c4 < DFF / 4; c4 += NWAVES * 64) { const int c0 = c4 * 4; f32x4 vt[2], vb[2];
#pragma unroll
        for (int bj = 0; bj < 2; ++bj) { const int cc = c0 + bj * DFF;
            const f32x4 b = *(const GAS f32x4*)(bc + cc), w0 = *(const GAS f32x4*)(wc + cc), w1 = *(const GAS f32x4*)(wc + NUP + cc), w2 = *(const GAS f32x4*)(wc + 2 * NUP + cc);
            const f32x4 z = (f32x4){0.f, 0.f, 0.f, 0.f};
            const f32x4 t0 = top ? *(const GAS f32x4*)(hc - NUP + cc) : z, t1 = top ? *(const GAS f32x4*)(hc + cc) : z, t2 = top ? *(const GAS f32x4*)(hc + NUP + cc) : z;
            const f32x4 b0 = bot ? *(const GAS f32x4*)(hc + 2 * NUP + cc) : z, b1 = bot ? *(const GAS f32x4*)(hc + 3 * NUP + cc) : z, b2 = bot ? *(const GAS f32x4*)(hc + 4 * NUP + cc) : z;
            vt[bj] = b + w0 * t0 + w1 * t1 + w2 * t2; vb[bj] = b + w0 * b0 + w1 * b1 + w2 * b2; }
        if (top) { float o[4];
#pragma unroll
            for (int j = 0; j < 4; ++j) o[j] = vt[0][j] * pg8::fast_sigmoid(vt[0][j]) * vt[1][j];
            *(GAS unsigned long long*)(ACT + (size_t)pm * 256 * ALD + c0) = (unsigned long long)pk2(o[0], o[1]) | ((unsigned long long)pk2(o[2], o[3]) << 32); }
        if (bot) { float o[4];
#pragma unroll
            for (int j = 0; j < 4; ++j) o[j] = vb[0][j] * pg8::fast_sigmoid(vb[0][j]) * vb[1][j];
            *(GAS unsigned long long*)(ACT + ((size_t)pm * 256 + 255) * ALD + c0) = (unsigned long long)pk2(o[0], o[1]) | ((unsigned long long)pk2(o[2], o[3]) << 32); } }
}

#ifndef MK_PER_PHASE
#define MK_PER_PHASE 0
#endif
#ifndef MK_MASK
#define MK_MASK 0xffffffffu
#endif
#define ON(i) ((MK_MASK >> (i)) & 1u)
#ifndef MK_REP
#define MK_REP 0u
#endif
#define NREP(i) (((MK_REP >> (i)) & 1u) ? 2 : 1)
#ifndef MK_RS
#define MK_RS 1
#endif
#ifndef MK_ALIGN
#define MK_ALIGN true
#endif
#ifndef MK_ALIGN_RES
#define MK_ALIGN_RES MK_ALIGN
#endif
#ifndef MK_ALIGN_G
#define MK_ALIGN_G MK_ALIGN
#endif
#ifndef MK_SP2
#define MK_SP2 true
#endif
#ifndef MK_STOP
#define MK_STOP 1000
#endif
constexpr int NPHASE = 2 + 10 * NLAYER;
#ifndef MK_PROBE
#define MK_PROBE 0
#endif
#ifndef MK_SEL1
#define MK_SEL1 0
#endif
#ifndef MK_SEL2
#define MK_SEL2 1
#endif
#ifndef MK_SCALE2
#define MK_SCALE2 1.0f
#endif
constexpr int STAMP_OFF = LDSCTL_OFF + 1024;

__global__ void __launch_bounds__(NWAVES * 64, 2) mk_fwd(Args args) {
    extern __shared__ __attribute__((aligned(16))) unsigned char lds[];
    Frame F;
    F.lds = (LAS unsigned char*)lds;
    F.MISC = (volatile LAS unsigned*)(F.lds + MISC_OFF);
    F.tid = threadIdx.x; F.lane = F.tid & 63; F.wave = __builtin_amdgcn_readfirstlane(F.tid >> 6);
    const int wave0 = F.wave;
    F.G = gridDim.x; { const int bx = blockIdx.x; F.vcu = (F.G % 8 == 0) ? (bx % 8) * (F.G / 8) + bx / 8 : bx; }
    F.out = args.out; F.ws = args.ws;
    for (int u = F.tid; u < (LDS_BYTES - LDSCTL_OFF) / 4; u += NWAVES * 64) ((LAS unsigned*)(F.lds + LDSCTL_OFF))[u] = 0u;
    __syncthreads();
    const int lo = args.ph_lo, hi = args.ph_hi < MK_STOP ? args.ph_hi : MK_STOP;
    unsigned* barw = (unsigned*)(args.ws + WS_CTL) + CW_BAR;
    XcdBarrier bar; bar.bar = barw; bar.x = 0; bar.st = nullptr;
    if (hi - lo > 1) bar = xcd_barrier_post(barw, F.MISC + 8, F.tid == 0);
#define IN(k) (lo <= (k) && (k) < hi)
#define PHASE_BEGIN() size_t z_ = 0; asm volatile("" : "+s"(z_)); unsigned char* ws = args.ws + z_;     \
    { int t_ = wave0 * 64 + lane_now(); asm volatile("" : "+v"(t_)); F.tid = t_; F.lane = t_ & 63; F.wave = __builtin_amdgcn_readfirstlane(t_ >> 6); F.ws = ws; } \
    const float* mods = (const float*)(ws + WS_MODS); bf16* Hb = (bf16*)(ws + WS_H); bf16* X = (bf16*)(ws + WS_X); (void)mods; (void)Hb; (void)X;
#if MK_PROBE
#define STAMP(i) do { if (blockIdx.x == 0 && threadIdx.x == 0) ((LAS unsigned long long*)(F.lds + STAMP_OFF))[i] = __builtin_amdgcn_s_memrealtime(); } while (0)
#define SEAM2(k, kn) do { if (IN(k) && IN(kn)) xcd_barrier(bar, wave0 * 64 + lane_now() == 0); STAMP((k) + 1); } while (0)
#define SEAM(k) SEAM2(k, (k) + 1)
#else
#define STAMP(i) do { } while (0)
#ifdef MK_BAR2
#define SEAM2(k, kn) do { if (IN(k) && IN(kn)) { xcd_barrier(bar, wave0 * 64 + lane_now() == 0); xcd_barrier(bar, wave0 * 64 + lane_now() == 0); } } while (0)
#define SEAM(k) SEAM2(k, (k) + 1)
#else
#define SEAM2(k, kn) do { if (IN(k) && IN(kn)) xcd_barrier(bar, wave0 * 64 + lane_now() == 0); } while (0)
#define SEAM(k) SEAM2(k, (k) + 1)
#endif
#endif
    const int cid = (int)blockIdx.x;

    STAMP(0);
    if (IN(0) && ON(0)) { PHASE_BEGIN(); for (int rep = 0; rep < NREP(0); ++rep) { if (rep) xcd_barrier(bar, wave0 * 64 + lane_now() == 0); p0_prologue(F, args); } }
    SEAM(0);
    if (IN(1) && ON(1)) { PHASE_BEGIN(); for (int rep = 0; rep < NREP(1); ++rep) { if (rep) xcd_barrier(bar, wave0 * 64 + lane_now() == 0); norm_phase<0>(F, args, args.in[7], mods, 0); } }
    SEAM(1);

#pragma nounroll
    for (int layer = 0; layer < NLAYER; ++layer) {
        const int pb = 2 + 10 * layer, j = layer >> 1;
        if ((layer & 1) == 0) {
            if (IN(pb + 0) && ON(2)) { PHASE_BEGIN(); for (int rep = 0; rep < NREP(2); ++rep) { if (rep) xcd_barrier(bar, wave0 * 64 + lane_now() == 0); const float* lmods = mods + (size_t)layer * NMOD * ADA_N; (void)lmods; pg8::Gemm g = pg8::mk_gemm(Hb, (const bf16*)(ws + WS_WIN) + (size_t)j * NINP * D, D, D); pg8::StaticOrder S; S.init(NTOK, QL + KVL, F.G, cid);
                pg8::EpiF32 E{(float*)(ws + WS_PROJ), NINP};
                pg8::gemm_phase<pg8::EpiF32, pg8::StaticOrder, MK_ALIGN, MK_SP2>(F.lds + RING_OFF, g, S, E, wave0);
                pg8::Gemm g2 = pg8::mk_gemm(Hb, (const bf16*)(ws + WS_WIN) + ((size_t)j * NINP + QL + KVL) * D, D / 4, D); g2.ldb = D; g2.b_hstep = (size_t)pg8::HALF * D * 2; g2.b_tstep = 0;
                pg8::KSplitOrder S2; S2.init(NTOK, D / 4, F.G, cid);
                pg8::EpiKr E2{(float*)(ws + WS_PKR)};
                pg8::gemm_phase<pg8::EpiKr, pg8::KSplitOrder, MK_ALIGN, MK_SP2>(F.lds + RING_OFF, g2, S2, E2, wave0); } }
            SEAM(pb + 0);
            if (IN(pb + 1) && ON(3)) { PHASE_BEGIN(); for (int rep = 0; rep < NREP(3); ++rep) { if (rep) xcd_barrier(bar, wave0 * 64 + lane_now() == 0); const float* lmods = mods + (size_t)layer * NMOD * ADA_N; (void)lmods; mla_mid_phase(F, args, j); } }
            SEAM(pb + 1);
            if (IN(pb + 2) && ON(4)) {
                PHASE_BEGIN(); for (int rep = 0; rep < NREP(4); ++rep) { if (rep) xcd_barrier(bar, wave0 * 64 + lane_now() == 0);
#ifdef MK_SKEW
                if ((cid >> 3) & 1) { for (int i = 0; i < MK_SKEW; ++i) __builtin_amdgcn_s_sleep(127); }
#endif
                { pg8::Gemm g = pg8::mk_gemm((const bf16*)(ws + WS_CQ), (const bf16*)(ws + WS_WUQ) + (size_t)j * NQ * QL, QL, QL); pg8::StaticOrder S; S.init(NTOK, NQ, F.G, cid);
                  pg8::EpiQ E{(bf16*)(ws + WS_Q), (const float*)(ws + WS_COS), (const float*)(ws + WS_SIN)};
                  pg8::gemm_phase<pg8::EpiQ, pg8::StaticOrder, MK_ALIGN, MK_SP2>(F.lds + RING_OFF, g, S, E, wave0); }
                { pg8::Gemm g = pg8::mk_gemm((const bf16*)(ws + WS_CKV), (const bf16*)(ws + WS_WUKV) + (size_t)j * NKV * KVL, KVL, KVL); pg8::StaticOrder S; S.init(MKV, NKV, F.G, cid);
                  pg8::EpiBf16<0> E{(bf16*)(ws + WS_KN), D, D, (size_t)(WS_V - WS_KN) / 2, 0};
                  pg8::gemm_phase<pg8::EpiBf16<0>, pg8::StaticOrder, MK_ALIGN, MK_SP2>(F.lds + RING_OFF, g, S, E, wave0); }
            } }
            SEAM(pb + 2);
            if (IN(pb + 3) && ON(5)) { PHASE_BEGIN(); for (int rep = 0; rep < NREP(5); ++rep) { if (rep) xcd_barrier(bar, wave0 * 64 + lane_now() == 0); const float* lmods = mods + (size_t)layer * NMOD * ADA_N; (void)lmods; attn_phase(F, (char*)lds + RING_OFF); } }
            SEAM(pb + 3);
            if (IN(pb + 4) && ON(6)) { PHASE_BEGIN(); for (int rep = 0; rep < NREP(6); ++rep) { if (rep) xcd_barrier(bar, wave0 * 64 + lane_now() == 0); const float* lmods = mods + (size_t)layer * NMOD * ADA_N; (void)lmods; pg8::Gemm g = pg8::mk_gemm((const bf16*)(ws + WS_O), (const bf16*)(ws + WS_WO) + (size_t)j * D * D, D, D); pg8::StaticOrder S; S.init(NTOK, D, F.G, cid);
                pg8::EpiRes E{(NREP(6) == 2 && rep == 0) ? (bf16*)(ws + WS_PROJ) : X, lmods + 2 * D};
                pg8::gemm_phase<pg8::EpiRes, pg8::StaticOrder, MK_ALIGN_RES, MK_SP2>(F.lds + RING_OFF, g, S, E, wave0); } }
            SEAM(pb + 4);
        } else {
            if (IN(pb + 0) && ON(7)) { PHASE_BEGIN(); for (int rep = 0; rep < NREP(7); ++rep) { if (rep) xcd_barrier(bar, wave0 * 64 + lane_now() == 0); const float* lmods = mods + (size_t)layer * NMOD * ADA_N; (void)lmods; pg8::Gemm g = pg8::mk_gemm(Hb, (const bf16*)(ws + WS_WRIN) + (size_t)j * 2 * D * D, D, D); pg8::StaticOrder S; S.init(NTOK, 2 * D, F.G, cid);
                pg8::EpiBf16<1> E{(bf16*)(ws + WS_RIN), 2 * D, 0, 0, D / 256};
                pg8::gemm_phase<pg8::EpiBf16<1>, pg8::StaticOrder, MK_ALIGN, MK_SP2>(F.lds + RING_OFF, g, S, E, wave0); } }
            SEAM(pb + 0);
            if (IN(pb + 1) && ON(8)) { PHASE_BEGIN(); for (int rep = 0; rep < NREP(8); ++rep) { if (rep) xcd_barrier(bar, wave0 * 64 + lane_now() == 0); const float* lmods = mods + (size_t)layer * NMOD * ADA_N; (void)lmods; conv4_phase(F, args, j); } }
            SEAM(pb + 1);
            if (!MK_RS && IN(pb + 2) && ON(9)) { PHASE_BEGIN(); for (int rep = 0; rep < NREP(9); ++rep) { if (rep) xcd_barrier(bar, wave0 * 64 + lane_now() == 0); const float* lmods = mods + (size_t)layer * NMOD * ADA_N; (void)lmods; pg8::Gemm g = pg8::mk_gemm((const bf16*)(ws + WS_XC), (const bf16*)(ws + WS_WG) + (size_t)j * 8192 * 128, 128, D); pg8::GateOrder S; S.init(NTOK, 8192, F.G, cid);
                pg8::EpiGates E{(bf16*)(ws + WS_LA), (bf16*)(ws + WS_UU), (const bf16*)(ws + WS_XC), args.in[23] + (size_t)j * 2 * D, args.in[25] + (size_t)j * 2 * D, (const float*)(ws + WS_SP) + (size_t)j * 2 * D, (LAS float*)(F.lds + EDGE_OFF)};
                pg8::gemm_phase<pg8::EpiGates, pg8::GateOrder, MK_ALIGN_G, MK_SP2>(F.lds + RING_OFF, g, S, E, wave0); } }
            if (!MK_RS) SEAM(pb + 2);
            if (IN(pb + 3) && ON(10)) { PHASE_BEGIN(); for (int rep = 0; rep < NREP(10); ++rep) { if (rep) xcd_barrier(bar, wave0 * 64 + lane_now() == 0); const float* lmods = mods + (size_t)layer * NMOD * ADA_N; (void)lmods; if (MK_RS) rs_phase(F, args, j, wave0); else scan_phase(F, args, j); } }
            SEAM(pb + 3);
            if (IN(pb + 4) && ON(11)) { PHASE_BEGIN(); for (int rep = 0; rep < NREP(11); ++rep) { if (rep) xcd_barrier(bar, wave0 * 64 + lane_now() == 0); const float* lmods = mods + (size_t)layer * NMOD * ADA_N; (void)lmods; pg8::Gemm g = pg8::mk_gemm((const bf16*)(ws + WS_MIX), (const bf16*)(ws + WS_WROUT) + (size_t)j * D * D, D, D); pg8::StaticOrder S; S.init(NTOK, D, F.G, cid);
                pg8::EpiRes E{(NREP(11) == 2 && rep == 0) ? (bf16*)(ws + WS_RIN) : X, lmods + 2 * D};
                pg8::gemm_phase<pg8::EpiRes, pg8::StaticOrder, MK_ALIGN_RES, MK_SP2>(F.lds + RING_OFF, g, S, E, wave0); } }
            SEAM(pb + 4);
        }
        if (IN(pb + 5) && ON(12)) { PHASE_BEGIN(); for (int rep = 0; rep < NREP(12); ++rep) { if (rep) xcd_barrier(bar, wave0 * 64 + lane_now() == 0); const float* lmods = mods + (size_t)layer * NMOD * ADA_N; (void)lmods; norm_phase<1>(F, args, args.in[8] + (size_t)layer * D, lmods, 3); } }
        SEAM(pb + 5);
        if (IN(pb + 6) && ON(13)) { PHASE_BEGIN(); for (int rep = 0; rep < NREP(13); ++rep) { if (rep) xcd_barrier(bar, wave0 * 64 + lane_now() == 0); const float* lmods = mods + (size_t)layer * NMOD * ADA_N; (void)lmods; pg8::Gemm g = pg8::mk_gemm(Hb, (const bf16*)(ws + WS_WUP) + (size_t)layer * NUP * D, D, D); g.b_hstep = (size_t)DFF * D * 2; g.b_tstep = (size_t)pg8::HALF * D * 2;
            pg8::StaticOrder S; S.init(NTOK, NUP, F.G, cid);
            pg8::EpiFfn E{(bf16*)(ws + WS_ACT), (float*)(ws + WS_HALO), args.in[29] + (size_t)layer * 3 * NUP, args.in[30] + (size_t)layer * NUP, (LAS float*)(F.lds + EDGE_OFF)};
            pg8::gemm_phase<pg8::EpiFfn, pg8::StaticOrder, MK_ALIGN, MK_SP2>(F.lds + RING_OFF, g, S, E, wave0); } }
        SEAM2(pb + 6, pb + 8);
        if (IN(pb + 8) && ON(15)) { PHASE_BEGIN(); for (int rep = 0; rep < NREP(15); ++rep) { if (rep) xcd_barrier(bar, wave0 * 64 + lane_now() == 0); const float* lmods = mods + (size_t)layer * NMOD * ADA_N; (void)lmods; pg8::Gemm g = pg8::mk_gemm((const bf16*)(ws + WS_ACT), (const bf16*)(ws + WS_WDN) + (size_t)layer * D * ALD, DFF, ALD); g.ldb = ALD; g.b_hstep = (size_t)pg8::HALF * ALD * 2; g.b_tstep = (size_t)pg8::BM * ALD * 2; pg8::StaticOrder S; S.init(NTOK, D, F.G, cid);
            { pg8::Unit u0, u1; if (S.next(0, u0)) { ffn_fix_panel(F, args, layer, u0.pm); if (S.next(1, u1) && u1.pm != u0.pm) ffn_fix_panel(F, args, layer, u1.pm); }
              asm volatile("s_waitcnt vmcnt(0)" ::: "memory"); __syncthreads(); }
#ifdef MK_KREP
            typedef pg8::EpiResT<MK_KREP> EpiF3;
#else
            typedef pg8::EpiRes EpiF3;
#endif
            EpiF3 E{(NREP(15) == 2 && rep == 0) ? (bf16*)(ws + WS_U) : X, lmods + 5 * D};
            pg8::gemm_phase<EpiF3, pg8::StaticOrder, MK_ALIGN_RES, MK_SP2>(F.lds + RING_OFF, g, S, E, wave0); } }
        SEAM(pb + 8);
        if (IN(pb + 9) && ON(16)) { PHASE_BEGIN(); for (int rep = 0; rep < NREP(16); ++rep) { if (rep) xcd_barrier(bar, wave0 * 64 + lane_now() == 0); const float* lmods = mods + (size_t)layer * NMOD * ADA_N; (void)lmods; if (layer + 1 < NLAYER) norm_phase<1>(F, args, args.in[7] + (size_t)(layer + 1) * D, lmods + (size_t)NMOD * ADA_N, 0); else norm_phase<2>(F, args, args.in[9], mods, 0); } }
        if (layer + 1 < NLAYER) SEAM(pb + 9);
    }
#if MK_PROBE
    xcd_barrier(bar, wave0 * 64 + lane_now() == 0); STAMP(NPHASE);
    { float* cw = (float*)(args.ws + WS_CTL) + 8192;
      if (blockIdx.x == 0 && threadIdx.x == 0) { float T[17]; for (int i = 0; i < 17; ++i) T[i] = 0.f;
          const LAS unsigned long long* ts = (const LAS unsigned long long*)(F.lds + STAMP_OFF);
          float t1 = 0.f, t2 = 0.f;
          for (int p = 0; p < NPHASE; ++p) { const float dt = (float)(ts[p + 1] - ts[p]) * 0.01f; int kind;
              if (p < 2) kind = p; else { const int k = (p - 2) % 10, ly = (p - 2) / 10; kind = k < 5 ? ((ly & 1) ? 7 + k : 2 + k) : 7 + k; }
              if (kind == MK_SEL1 || MK_SEL1 == 99) t1 += dt; if (kind == MK_SEL2 || MK_SEL2 == 99) t2 += dt; }
          (void)T; cw[0] = sqrtf(t1); cw[1] = t2 * MK_SCALE2; }
      xcd_barrier(bar, wave0 * 64 + lane_now() == 0);
      const float c1 = cw[0], c2 = cw[1];
      for (size_t i = (size_t)blockIdx.x * 512 + threadIdx.x; i < OUT_TOTAL; i += (size_t)gridDim.x * 512)
          args.out[i] = (i >= (size_t)MCTX * D && i < 2ull * MCTX * D) ? c1 : (i == 0 ? c2 : 0.f); }
#endif
#undef IN
#undef SEAM
#undef SEAM2
}

extern "C" void kernel_launch(void* const* d_in, const int* in_sizes, int n_in, void* d_out, int out_size, void* d_ws, size_t ws_size, hipStream_t stream) {
    static int grid = 0;
    if (grid == 0) {
        if (n_in != 32 || in_sizes[0] != MCTX * D || in_sizes[1] != MCTX * D || (size_t)out_size != OUT_TOTAL || ws_size < WS_END) {
            fprintf(stderr, "kernel_launch: shape mismatch (n_in %d, out %d, ws %zu); nothing launched\n", n_in, out_size, ws_size); grid = -1; return; }
        int dev = 0, cus = 0, per_cu = 0;
        if (hipGetDevice(&dev) != hipSuccess || hipDeviceGetAttribute(&cus, hipDeviceAttributeMultiprocessorCount, dev) != hipSuccess) { grid = -1; return; }
        if (hipFuncSetAttribute((const void*)mk_fwd, hipFuncAttributeMaxDynamicSharedMemorySize, LDS_BYTES) != hipSuccess) { fprintf(stderr, "kernel_launch: hipFuncSetAttribute failed\n"); grid = -1; return; }
        if (hipOccupancyMaxActiveBlocksPerMultiprocessor(&per_cu, (const void*)mk_fwd, NWAVES * 64, LDS_BYTES) != hipSuccess || per_cu < 1)
            fprintf(stderr, "kernel_launch: note: occupancy query reports %d workgroups per CU\n", per_cu);
        (void)hipGetLastError();
        grid = cus;
        if (grid != 256) fprintf(stderr, "kernel_launch: note: %d CUs (tuned for 256)\n", grid);
    }
    if (grid < 0) return;
    if (hipMemsetAsync((char*)d_ws + WS_CTL, 0, CTL_ZERO_BYTES, stream) != hipSuccess) { fprintf(stderr, "kernel_launch: memset failed\n"); return; }
    Args a{};
    for (int i = 0; i < 32; ++i) a.in[i] = (const float*)d_in[i];
    a.out = (float*)d_out; a.ws = (unsigned char*)d_ws;
#if MK_PER_PHASE
    for (int p = 0; p < NPHASE && p < MK_STOP; ++p) { a.ph_lo = p; a.ph_hi = p + 1; hipLaunchKernelGGL(mk_fwd, dim3(grid), dim3(NWAVES * 64), LDS_BYTES, stream, a); }
#else
    a.ph_lo = 0; a.ph_hi = NPHASE; hipLaunchKernelGGL(mk_fwd, dim3(grid), dim3(NWAVES * 64), LDS_BYTES, stream, a);
#endif
    const hipError_t le = hipPeekAtLastError();
    if (le != hipSuccess) fprintf(stderr, "kernel_launch: launch failed: %s\n", hipGetErrorName(le));
}
```

```cpp
#define MK_REP 0u
#include <hip/hip_runtime.h>
#include <cstdio>
#include <cstdint>

constexpr int D = 2048, NTOK = 16384, MCTX = 8192, DFF = 5632, NUP = 2 * DFF, NLAYER = 4;
constexpr int QL = 512, KVL = 512, NH = 16, NOPE = 128, ROPE = 64, VD = 128, QKD = NOPE + ROPE;
constexpr int NIN = QL + KVL + ROPE  , NINP = 1280  , NQ = NH * QKD  , NKV = 2 * NH * NOPE  ;
constexpr int MKV = MCTX + 8 * 1280;
constexpr int NMOD = 9, ADA_N = 6 * D;
#ifndef MK_APAD
#define MK_APAD 64
#endif
constexpr int ALD = DFF + MK_APAD;
constexpr float NORM_EPS = 1e-6f;

__device__ __forceinline__ int lane_now() { int z = 0; asm volatile("" : "+v"(z)); return (int)__builtin_amdgcn_mbcnt_hi(~0u, __builtin_amdgcn_mbcnt_lo(~0u, (unsigned)z)); }

namespace pg8 {
#define PG8_LAS __attribute__((address_space(3)))
typedef unsigned short bf16_t;
typedef short bf16x8 __attribute__((ext_vector_type(8)));
typedef float f32x4 __attribute__((ext_vector_type(4)));
typedef float f32x2 __attribute__((ext_vector_type(2)));
typedef unsigned u32x4 __attribute__((ext_vector_type(4)));
typedef unsigned u32x2 __attribute__((ext_vector_type(2)));
constexpr int BM = 256, BK = 64, HALF = 128, HTB = HALF * BK * 2  , STAGE_BYTES = 8 * HTB, NXCD = 8, WGM = 8;

__host__ __device__ __forceinline__ int lds_byte(int r, int c) { const int st = (r >> 4) * 2 + (c >> 5), rr = r & 15, cc = c & 31, ob = rr * 64 + cc * 2; return st * 1024 + (ob ^ (((ob >> 9) & 1) << 5)); }
__host__ __device__ __forceinline__ void stage_rc(int b, int& R, int& C) { const int st = b / 1024, sb = b % 1024, swz = sb ^ (((sb >> 9) & 1) << 5); R = (st >> 1) * 16 + swz / 64; C = (st & 1) * 32 + (swz % 64) / 2; }
__host__ __device__ __forceinline__ int perm32(int rho) { const int n = rho >> 4, i = rho & 15; return 8 * (i >> 2) + 4 * n + (i & 3); }

struct Unit { int pm, pn; };
struct Gemm { const bf16_t* A; const bf16_t* Bt; int K; int lda; int ldb; int pad_; size_t b_hstep, b_tstep; };
__device__ __forceinline__ Gemm mk_gemm(const bf16_t* A, const bf16_t* Bt, int K, int lda) { Gemm g; g.A = A; g.Bt = Bt; g.K = K; g.lda = lda; g.ldb = K; g.pad_ = 0; g.b_hstep = (size_t)HALF * K * 2; g.b_tstep = (size_t)BM * K * 2; return g; }

struct StaticOrder {
    int nM, nN, nwg, G, c;
    __host__ __device__ void init(int M, int N, int G_, int c_) { nM = M / BM; nN = N / BM; nwg = nM * nN; G = G_; c = c_; }
    __host__ __device__ __forceinline__ bool next(int i, Unit& u) const {
        const long L = (long)i * G + c; if (L >= nwg) return false;
        int wgid = (int)L; { const int q = nwg / NXCD, r = nwg % NXCD, xcd = wgid % NXCD, off = wgid / NXCD; wgid = (xcd < r ? xcd * (q + 1) : r * (q + 1) + (xcd - r) * q) + off; }
        const int nig = WGM * nN, gid = wgid / nig, fm = gid * WGM, gsz = (nM - fm) < WGM ? (nM - fm) : WGM;
        u.pm = fm + ((wgid % nig) % gsz); u.pn = (wgid % nig) / gsz; return true;
    }
    __device__ __forceinline__ size_t acol(const Unit&) const { return 0; }
    __device__ __forceinline__ size_t bcol(const Unit&) const { return 0; }
    __device__ __forceinline__ void a_ready(const Unit&) const {}
    __device__ __forceinline__ void done(const Unit&) const {}
};
struct GateOrder : StaticOrder {
    __device__ __forceinline__ size_t acol(const Unit& u) const { return (size_t)(u.pn >> 1) * 256; }
};

struct OneUnit {
    int pm, pn;
    __device__ __forceinline__ bool next(int i, Unit& u) const { if (i) return false; u.pm = pm; u.pn = pn; return true; }
    __device__ __forceinline__ size_t acol(const Unit& u) const { return (size_t)(u.pn >> 1) * 256; }
    __device__ __forceinline__ size_t bcol(const Unit&) const { return 0; }
    __device__ __forceinline__ void a_ready(const Unit&) const {}
    __device__ __forceinline__ void done(const Unit&) const {}
};

struct KSplitOrder {
    int nwg, G, c; unsigned qbytes;
    __device__ void init(int M, int Kq, int G_, int c_) { nwg = (M / BM) * 4; G = G_; c = c_; qbytes = (unsigned)Kq * 2u; }
    __device__ __forceinline__ bool next(int i, Unit& u) const { const long L = (long)i * G + c; if (L >= nwg) return false; u.pm = (int)(L >> 2); u.pn = (int)(L & 3); return true; }
    __device__ __forceinline__ size_t acol(const Unit& u) const { return (size_t)u.pn * qbytes; }
    __device__ __forceinline__ size_t bcol(const Unit& u) const { return (size_t)u.pn * qbytes; }
    __device__ __forceinline__ void a_ready(const Unit&) const {}
    __device__ __forceinline__ void done(const Unit&) const {}
};

__device__ __forceinline__ unsigned cvt_pk_bf16(float lo, float hi) { unsigned r; asm volatile("v_cvt_pk_bf16_f32 %0, %1, %2" : "=v"(r) : "v"(lo), "v"(hi)); return r; }
__device__ __forceinline__ float bf_lo(unsigned w) { return __uint_as_float(w << 16); }
__device__ __forceinline__ float bf_hi(unsigned w) { return __uint_as_float(w & 0xffff0000u); }
__device__ __forceinline__ float fast_sigmoid(float x) { return __builtin_amdgcn_rcpf(1.0f + __builtin_amdgcn_exp2f(-1.4426950408889634f * x)); }
__device__ __forceinline__ float gelu_tanh(float x) { const float z = 0.7978845608028654f * (x + 0.044715f * x * x * x); return x * fast_sigmoid(2.0f * z); }

#ifndef MK_WT
#define MK_WT 0
#endif
template <int TG> __device__ __forceinline__ void gst16(void* p, u32x4 v) {
  if constexpr ((MK_WT >> TG) & 1) {
    asm volatile("global_store_dwordx4 %0, %1, off sc1\n\ts_nop 1" :: "v"(p), "v"(v) : "memory");
  } else {
    *(u32x4*)p = v; }
}
template <int TG> __device__ __forceinline__ void gst16f(void* p, f32x4 v) {
  if constexpr ((MK_WT >> TG) & 1) {
    asm volatile("global_store_dwordx4 %0, %1, off sc1\n\ts_nop 1" :: "v"(p), "v"(v) : "memory");
  } else {
    *(f32x4*)p = v; }
}
template <int TG> __device__ __forceinline__ void gst8(void* p, u32x2 v) {
  if constexpr ((MK_WT >> TG) & 1) {
    asm volatile("global_store_dwordx2 %0, %1, off sc1\n\ts_nop 1" :: "v"(p), "v"(v) : "memory");
  } else {
    *(u32x2*)p = v; }
}
struct EpiF32 {
    static constexpr int TAG = 0;
    static constexpr bool PERM = false, AFTER_DRAIN = false; static constexpr int KREP = 1;
    float* C; int ldc;
    __device__ __forceinline__ void operator()(const f32x4 (&acc)[2][2][4][2], const Unit& u, int wr, int wc, int fr, int fq) const {
        const int row0 = u.pm * BM + wr * 64 + fr, col0 = u.pn * BM + wc * 32 + 4 * fq;
#pragma unroll
        for (int ai = 0; ai < 2; ++ai)
#pragma unroll
            for (int m = 0; m < 4; ++m) { float* rowp = C + (size_t)(row0 + ai * HALF + m * 16) * ldc + col0;
#pragma unroll
                for (int bj = 0; bj < 2; ++bj)
#pragma unroll
                    for (int n = 0; n < 2; ++n) gst16f<TAG>(rowp + bj * HALF + n * 16, acc[ai][bj][m][n]); }
    }
};
struct EpiKr {
    static constexpr int TAG = 1;
    static constexpr bool PERM = false, AFTER_DRAIN = false; static constexpr int KREP = 1;
    float* P;
    __device__ __forceinline__ void operator()(const f32x4 (&acc)[2][2][4][2], const Unit& u, int wr, int wc, int fr, int fq) const {
        if (wc >= 2) return;
        float* base = P + ((size_t)u.pn * NTOK + u.pm * BM + wr * 64 + fr) * ROPE + wc * 32 + 4 * fq;
#pragma unroll
        for (int ai = 0; ai < 2; ++ai)
#pragma unroll
            for (int m = 0; m < 4; ++m)
#pragma unroll
                for (int n = 0; n < 2; ++n) gst16f<TAG>(base + (size_t)(ai * HALF + m * 16) * ROPE + n * 16, acc[ai][0][m][n]);
    }
};
template <int ACT> struct EpiBf16 {
    static constexpr int TAG = 2 + 10 * ACT;
    static constexpr bool PERM = true, AFTER_DRAIN = false; static constexpr int KREP = 1;
    bf16_t* O; int ldc; int split_cols; size_t split_stride; int act_tiles;
    __device__ __forceinline__ void operator()(const f32x4 (&acc)[2][2][4][2], const Unit& u, int wr, int wc, int fr, int fq) const {
        const int row0 = u.pm * BM + wr * 64 + fr; int colt = u.pn * BM; bf16_t* base = O;
        if (split_cols) { const int t = colt / split_cols; base += (size_t)t * split_stride; colt -= t * split_cols; }
        const int col0 = colt + wc * 32 + 8 * fq;
        const bool act = (ACT == 1) && (u.pn < act_tiles);
#pragma unroll
        for (int ai = 0; ai < 2; ++ai)
#pragma unroll
            for (int m = 0; m < 4; ++m) { bf16_t* rowp = base + (size_t)(row0 + ai * HALF + m * 16) * ldc + col0;
#pragma unroll
                for (int bj = 0; bj < 2; ++bj) { f32x4 v0 = acc[ai][bj][m][0], v1 = acc[ai][bj][m][1];
                    if (ACT == 1) { if (act) {
                        f32x4 e0 = v0 * (v0 * v0 * -0.10294324f + -2.3022082f), e1 = v1 * (v1 * v1 * -0.10294324f + -2.3022082f);
#pragma unroll
                        for (int j = 0; j < 4; ++j) { e0[j] = __builtin_amdgcn_exp2f(e0[j]); e1[j] = __builtin_amdgcn_exp2f(e1[j]); }
                        e0 = e0 + 1.0f; e1 = e1 + 1.0f;
#pragma unroll
                        for (int j = 0; j < 4; ++j) { e0[j] = __builtin_amdgcn_rcpf(e0[j]); e1[j] = __builtin_amdgcn_rcpf(e1[j]); }
                        v0 = v0 * e0; v1 = v1 * e1; } }
                    u32x4 w; w.x = cvt_pk_bf16(v0[0], v0[1]); w.y = cvt_pk_bf16(v0[2], v0[3]); w.z = cvt_pk_bf16(v1[0], v1[1]); w.w = cvt_pk_bf16(v1[2], v1[3]);
                    gst16<TAG>(rowp + bj * HALF, w); } }
    }
};
struct EpiQ {
    static constexpr int TAG = 3;
    static constexpr bool PERM = false, AFTER_DRAIN = false; static constexpr int KREP = 1;
    bf16_t* Q; const float* cosT; const float* sinT;
    __device__ __forceinline__ void operator()(const f32x4 (&acc)[2][2][4][2], const Unit& u, int wr, int wc, int fr, int fq) const {
        const int row0 = u.pm * BM + wr * 64 + fr; const bool sample = u.pm >= (MCTX / BM);
#pragma unroll
        for (int bj = 0; bj < 2; ++bj) {
            const int col32 = u.pn * BM + bj * HALF + wc * 32, head = col32 / QKD, d32 = col32 - head * QKD;
            const bool rope = sample && (d32 >= NOPE); const int grp = (d32 - NOPE) >> 5;
#pragma unroll
            for (int ai = 0; ai < 2; ++ai) {
                f32x4 cc[4], ss[4];
                if (rope) {
#pragma unroll
                    for (int m = 0; m < 4; ++m) { const int pos = (row0 + ai * HALF + m * 16 - MCTX) & 1023; cc[m] = *(const f32x4*)(cosT + pos * 32 + grp * 16 + 4 * fq); ss[m] = *(const f32x4*)(sinT + pos * 32 + grp * 16 + 4 * fq); } }
#pragma unroll
                for (int m = 0; m < 4; ++m) { const int row = row0 + ai * HALF + m * 16;
                    f32x4 v0 = acc[ai][bj][m][0], v1 = acc[ai][bj][m][1];
                    if (rope) { const f32x4 y0 = v0 * cc[m] - v1 * ss[m], y1 = v1 * cc[m] + v0 * ss[m]; v0 = y0; v1 = y1; }
                    u32x2 w0, w1; w0.x = cvt_pk_bf16(v0[0], v0[1]); w0.y = cvt_pk_bf16(v0[2], v0[3]); w1.x = cvt_pk_bf16(v1[0], v1[1]); w1.y = cvt_pk_bf16(v1[2], v1[3]);
                    const auto rx = __builtin_amdgcn_permlane16_swap(w0.x, w1.x, false, false), ry = __builtin_amdgcn_permlane16_swap(w0.y, w1.y, false, false);
                    u32x4 w4; w4.x = rx[0]; w4.y = ry[0]; w4.z = rx[1]; w4.w = ry[1];
                    gst16<TAG>(Q + (size_t)row * NQ + col32 + (fq >> 1) * 8 + (fq & 1) * 16, w4); } }
        }
    }
};
template <int KR = 1> struct EpiResT {
    static constexpr int TAG = 4;
    static constexpr bool PERM = true, AFTER_DRAIN = false; static constexpr int KREP = KR;
    bf16_t* X; const float* gate;
    __device__ __forceinline__ void operator()(const f32x4 (&acc)[2][2][4][2], const Unit& u, int wr, int wc, int fr, int fq) const {
        const int row0 = u.pm * BM + wr * 64 + fr, col0 = u.pn * BM + wc * 32 + 8 * fq;
        const int mod = u.pm < (MCTX / BM) ? 0 : 1 + ((u.pm - MCTX / BM) >> 2);
        const float* gp = gate + (size_t)mod * ADA_N + col0;
        f32x4 gv[2][2];
#pragma unroll
        for (int bj = 0; bj < 2; ++bj)
#pragma unroll
            for (int n = 0; n < 2; ++n) gv[bj][n] = *(const f32x4*)(gp + bj * HALF + n * 4);
        u32x4 cur[2], nxt[2];
#pragma unroll
        for (int bj = 0; bj < 2; ++bj) cur[bj] = *(const u32x4*)(X + (size_t)row0 * D + col0 + bj * HALF);
#pragma unroll
        for (int k = 0; k < 8; ++k) { const int ai = k >> 2, m = k & 3; bf16_t* rowp = X + (size_t)(row0 + ai * HALF + m * 16) * D + col0;
            if (k < 7) { const bf16_t* nrow = X + (size_t)(row0 + ((k + 1) >> 2) * HALF + ((k + 1) & 3) * 16) * D + col0;
#pragma unroll
                for (int bj = 0; bj < 2; ++bj) nxt[bj] = *(const u32x4*)(nrow + bj * HALF); }
#pragma unroll
            for (int bj = 0; bj < 2; ++bj) { const u32x4 xw = cur[bj];
                const f32x4 x0 = (f32x4){bf_lo(xw.x), bf_hi(xw.x), bf_lo(xw.y), bf_hi(xw.y)} + gv[bj][0] * acc[ai][bj][m][0];
                const f32x4 x1 = (f32x4){bf_lo(xw.z), bf_hi(xw.z), bf_lo(xw.w), bf_hi(xw.w)} + gv[bj][1] * acc[ai][bj][m][1];
                u32x4 w; w.x = cvt_pk_bf16(x0[0], x0[1]); w.y = cvt_pk_bf16(x0[2], x0[3]); w.z = cvt_pk_bf16(x1[0], x1[1]); w.w = cvt_pk_bf16(x1[2], x1[3]);
                gst16<TAG>(rowp + bj * HALF, w); cur[bj] = nxt[bj]; }
            asm volatile("" ::: "memory"); }
    }
};
typedef EpiResT<1> EpiRes;
#ifndef MK_GOLD
#define MK_GOLD 0
#endif
#if MK_GOLD
#define GSC_B 1.0f
#define GSC_S 1.0f
#else
#define GSC_B 1.4426950408889634f
#define GSC_S -1.0f
#endif
struct EpiGates {
    static constexpr int TAG = 5;
    static constexpr bool PERM = true, AFTER_DRAIN = false; static constexpr int KREP = 1;
    bf16_t* LA; bf16_t* UU; const bf16_t* XC; const float* bgx; const float* bga; const float* sp; PG8_LAS float* prm;
    __device__ __forceinline__ void operator()(const f32x4 (&acc)[2][2][4][2], const Unit& u, int wr, int wc, int fr, int fq) const {
        const int blk = u.pn >> 1, dir = u.pn & 1, row0 = u.pm * BM + wr * 64 + fr, chw = wc * 32 + 8 * fq, ch0 = blk * 128 + chw;
        const char* xcb = (const char*)XC; char* lab = (char*)(LA + (size_t)dir * NTOK * D); char* uub = (char*)(UU + (size_t)dir * NTOK * D);
        { const int t = (wr * 4 + wc) * 64 + fq * 16 + fr;
          const int c4 = (t & 31) * 4, go = dir * D + blk * 128 + c4;
          if (t < 32) *(PG8_LAS f32x4*)(prm + c4) = *(const f32x4*)(bgx + go) * GSC_B;
          else if (t < 64) *(PG8_LAS f32x4*)(prm + 128 + c4) = *(const f32x4*)(bga + go) * GSC_B;
          else if (t < 96) *(PG8_LAS f32x4*)(prm + 256 + c4) = *(const f32x4*)(sp + go) * GSC_S; }
        asm volatile("s_waitcnt vmcnt(0) lgkmcnt(0)" ::: "memory"); __builtin_amdgcn_s_barrier(); asm volatile("" ::: "memory");
#pragma unroll
        for (int aq = 0; aq < 4; ++aq) { const int ai = aq >> 1; u32x4 xw[4];
#pragma unroll
            for (int m = (aq & 1) * 2; m < (aq & 1) * 2 + 2; ++m) xw[m] = *(const u32x4*)(xcb + ((unsigned)(row0 + ai * HALF + m * 16) * D + ch0) * 2u);
#pragma unroll
            for (int m = (aq & 1) * 2; m < (aq & 1) * 2 + 2; ++m) { const unsigned ro = ((unsigned)(row0 + ai * HALF + m * 16) * D + ch0) * 2u; u32x4 wl, wu;
#pragma unroll
                for (int n = 0; n < 2; ++n) { const unsigned x01 = n ? xw[m].z : xw[m].x, x23 = n ? xw[m].w : xw[m].y;
                    const f32x4 bx = *(const PG8_LAS f32x4*)(prm + chw + 4 * n), ba = *(const PG8_LAS f32x4*)(prm + 128 + chw + 4 * n), sv = *(const PG8_LAS f32x4*)(prm + 256 + chw + 4 * n);
#if MK_GOLD
                    const float xv[4] = {bf_lo(x01), bf_hi(x01), bf_lo(x23), bf_hi(x23)}; float l2[4], uv[4];
#pragma unroll
                    for (int j = 0; j < 4; ++j) { const float sx = fast_sigmoid(acc[ai][0][m][n][j] + bx[j]), sa = fast_sigmoid(acc[ai][1][m][n][j] + ba[j]);
                        l2[j] = -sa * sv[j]; const float a2 = __builtin_amdgcn_exp2f(2.0f * l2[j]); uv[j] = __builtin_amdgcn_sqrtf(fmaxf(1.0f - a2, 0.0f)) * sx * xv[j]; }
#else
                    const f32x4 xv = {bf_lo(x01), bf_hi(x01), bf_lo(x23), bf_hi(x23)};
                    f32x4 ex = acc[ai][0][m][n] * 1.4426950408889634f + bx, ea = acc[ai][1][m][n] * 1.4426950408889634f + ba;
#pragma unroll
                    for (int j = 0; j < 4; ++j) { ex[j] = __builtin_amdgcn_exp2f(-ex[j]); ea[j] = __builtin_amdgcn_exp2f(-ea[j]); }
                    ex = ex + 1.0f; ea = ea + 1.0f;
#pragma unroll
                    for (int j = 0; j < 4; ++j) { ex[j] = __builtin_amdgcn_rcpf(ex[j]); ea[j] = __builtin_amdgcn_rcpf(ea[j]); }
                    const f32x4 l2 = ea * sv; f32x4 av;
#pragma unroll
                    for (int j = 0; j < 4; ++j) av[j] = __builtin_amdgcn_exp2f(l2[j]);
                    f32x4 om = av * av - 1.0f;
#pragma unroll
                    for (int j = 0; j < 4; ++j) om[j] = __builtin_amdgcn_sqrtf(__builtin_fabsf(om[j]));
                    const f32x4 uv = om * ex * xv;
#endif
                    if (n == 0) { wl.x = cvt_pk_bf16(l2[0], l2[1]); wl.y = cvt_pk_bf16(l2[2], l2[3]); wu.x = cvt_pk_bf16(uv[0], uv[1]); wu.y = cvt_pk_bf16(uv[2], uv[3]); }
                    else { wl.z = cvt_pk_bf16(l2[0], l2[1]); wl.w = cvt_pk_bf16(l2[2], l2[3]); wu.z = cvt_pk_bf16(uv[0], uv[1]); wu.w = cvt_pk_bf16(uv[2], uv[3]); }
                    __builtin_amdgcn_sched_barrier(0); }
                gst16<TAG>(lab + ro, wl); gst16<TAG>(uub + ro, wu); }
            asm volatile("" ::: "memory"); }
    }
};

struct EpiGatesLds {
    static constexpr int TAG = 7;
    static constexpr bool PERM = true, AFTER_DRAIN = true; static constexpr int KREP = 1;
    const bf16_t* XC; const float* bgx; const float* bga; const float* sp; PG8_LAS float* prm;
    __device__ __forceinline__ void operator()(const f32x4 (&)[2][2][4][2], const Unit&, int, int, int, int) const {}
    __device__ __forceinline__ f32x4 pre(const Unit& u, int t) const { f32x4 r = {0.f, 0.f, 0.f, 0.f};
        const int blk = u.pn >> 1, dir = u.pn & 1, go = dir * D + blk * 128 + (t & 31) * 4;
        if (t < 32) r = *(const f32x4*)(bgx + go); else if (t < 64) r = *(const f32x4*)(bga + go); else if (t < 96) r = *(const f32x4*)(sp + go);
        return r; }
    __device__ __forceinline__ void fused(const f32x4 (&acc)[2][2][4][2], const Unit& u, int wr, int wc, int fr, int fq, PG8_LAS unsigned char* img, const f32x4 pf) const {
        const int blk = u.pn >> 1, dir = u.pn & 1, rl0 = wr * 64 + fr, row0 = u.pm * BM + rl0, chw = wc * 32 + 8 * fq, ch0 = blk * 128 + chw;
        const char* xcb = (const char*)XC;
        u32x4 xa[2][4];
#pragma unroll
        for (int m = 0; m < 4; ++m) xa[0][m] = *(const u32x4*)(xcb + ((unsigned)(row0 + m * 16) * D + ch0) * 2u);
        { const int t = (wr * 4 + wc) * 64 + fq * 16 + fr;
          if (t < 96) *(PG8_LAS f32x4*)(prm + (t >> 5) * 128 + (t & 31) * 4) = pf * (t < 64 ? GSC_B : GSC_S); }
        asm volatile("s_waitcnt lgkmcnt(0)" ::: "memory"); __builtin_amdgcn_s_barrier(); asm volatile("" ::: "memory");
#pragma unroll
        for (int aq = 0; aq < 4; ++aq) { const int ai = aq >> 1;
            if (aq == 0) {
#pragma unroll
                for (int m = 0; m < 4; ++m) xa[1][m] = *(const u32x4*)(xcb + ((unsigned)(row0 + HALF + m * 16) * D + ch0) * 2u); }
#pragma unroll
            for (int m = (aq & 1) * 2; m < (aq & 1) * 2 + 2; ++m) { const int rl = rl0 + ai * HALF + m * 16;
#pragma unroll
                for (int n = 0; n < 2; ++n) { const unsigned x01 = n ? xa[ai][m].z : xa[ai][m].x, x23 = n ? xa[ai][m].w : xa[ai][m].y;
                    const f32x4 bx = *(const PG8_LAS f32x4*)(prm + chw + 4 * n), ba = *(const PG8_LAS f32x4*)(prm + 128 + chw + 4 * n), sv = *(const PG8_LAS f32x4*)(prm + 256 + chw + 4 * n);
                    const f32x4 xv = {bf_lo(x01), bf_hi(x01), bf_lo(x23), bf_hi(x23)};
                    f32x4 ex = acc[ai][0][m][n] * 1.4426950408889634f + bx, ea = acc[ai][1][m][n] * 1.4426950408889634f + ba;
#pragma unroll
                    for (int j = 0; j < 4; ++j) { ex[j] = __builtin_amdgcn_exp2f(-ex[j]); ea[j] = __builtin_amdgcn_exp2f(-ea[j]); }
                    ex = ex + 1.0f; ea = ea + 1.0f;
#pragma unroll
                    for (int j = 0; j < 4; ++j) { ex[j] = __builtin_amdgcn_rcpf(ex[j]); ea[j] = __builtin_amdgcn_rcpf(ea[j]); }
                    const f32x4 l2 = ea * sv; f32x4 av;
#pragma unroll
                    for (int j = 0; j < 4; ++j) av[j] = __builtin_amdgcn_exp2f(l2[j]);
                    f32x4 om = av * av - 1.0f;
#pragma unroll
                    for (int j = 0; j < 4; ++j) om[j] = __builtin_amdgcn_sqrtf(__builtin_fabsf(om[j]));
                    const f32x4 uv = om * ex * xv;
                    u32x4 w; w.x = cvt_pk_bf16(l2[0], uv[0]); w.y = cvt_pk_bf16(l2[1], uv[1]); w.z = cvt_pk_bf16(l2[2], uv[2]); w.w = cvt_pk_bf16(l2[3], uv[3]);
                    const int chunk = (wc * 8 + 2 * fq + n) ^ (rl & 31);
                    *(PG8_LAS u32x4*)(img + rl * 512 + chunk * 16) = w;
                    __builtin_amdgcn_sched_barrier(0); } }
            asm volatile("" ::: "memory"); }
    }
};

__device__ __forceinline__ f32x4 dpp_ror1(f32x4 v) { f32x4 r;
#pragma unroll
    for (int j = 0; j < 4; ++j) r[j] = __int_as_float(__builtin_amdgcn_mov_dpp(__float_as_int(v[j]), 0x121, 0xf, 0xf, false)); return r; }
__device__ __forceinline__ f32x4 dpp_rol1(f32x4 v) { f32x4 r;
#pragma unroll
    for (int j = 0; j < 4; ++j) r[j] = __int_as_float(__builtin_amdgcn_mov_dpp(__float_as_int(v[j]), 0x12f, 0xf, 0xf, false)); return r; }
#ifndef MK_KREP_F1
#define MK_KREP_F1 1
#endif
struct EpiFfn {
    static constexpr int TAG = 6;
    static constexpr bool PERM = true, AFTER_DRAIN = false; static constexpr int KREP = MK_KREP_F1;
    bf16_t* ACT; float* HALO; const float* wcv; const float* bcv; PG8_LAS float* edge;
    __device__ __forceinline__ f32x4 pre(const Unit& u, int t) const { f32x4 r = {0.f, 0.f, 0.f, 0.f};
        if (t < 256) { const int p2 = t >> 5, p = p2 >> 1, bjp = p2 & 1, c4 = (t & 31) * 4; const float* src = (p < 3 ? wcv + (size_t)p * NUP : bcv) + bjp * DFF + u.pn * HALF + c4; asm volatile("global_load_dwordx4 %0, %1, off" : "=&v"(r) : "v"(src) : "memory"); }
        return r; }
    __device__ __forceinline__ void operator()(const f32x4 (&acc)[2][2][4][2], const Unit& u, int wr, int wc, int fr, int fq, const f32x4 pf) const {
        const int chw = wc * 32 + 8 * fq;
#pragma unroll
        for (int ai = 0; ai < 2; ++ai) { const int grp = 2 * ai + wr;
            if (fr == 0) {
#pragma unroll
                for (int bj = 0; bj < 2; ++bj)
#pragma unroll
                    for (int n = 0; n < 2; ++n) *(PG8_LAS f32x4*)(edge + (grp * 2 + 0) * 256 + bj * HALF + chw + 4 * n) = acc[ai][bj][0][n]; }
            if (fr == 15) {
#pragma unroll
                for (int bj = 0; bj < 2; ++bj)
#pragma unroll
                    for (int n = 0; n < 2; ++n) *(PG8_LAS f32x4*)(edge + (grp * 2 + 1) * 256 + bj * HALF + chw + 4 * n) = acc[ai][bj][3][n]; } }
        PG8_LAS float* prm = edge + 4 * 2 * 256;
        { const int t = (wr * 4 + wc) * 64 + fq * 16 + fr;
          asm volatile("s_waitcnt vmcnt(8)" ::: "memory");
          if (t < 256) { const int p2 = t >> 5, bjp = p2 & 1, c4 = (t & 31) * 4;
              *(PG8_LAS f32x4*)(prm + p2 * 128 + c4) = pf * (bjp ? -0.6931471805599453f : -1.4426950408889634f); } }
        asm volatile("s_waitcnt lgkmcnt(0)" ::: "memory"); __builtin_amdgcn_s_barrier(); asm volatile("" ::: "memory");
        if (u.pm >= MCTX / BM) { float* hb = HALO + (size_t)u.pm * 4 * NUP + u.pn * HALF + chw;
            if (wr == 0 && fr < 2) {
#pragma unroll
                for (int bj = 0; bj < 2; ++bj)
#pragma unroll
                    for (int n = 0; n < 2; ++n) *(f32x4*)(hb + (size_t)fr * NUP + bj * DFF + 4 * n) = acc[0][bj][0][n]; }
            if (wr == 1 && fr >= 14) {
#pragma unroll
                for (int bj = 0; bj < 2; ++bj)
#pragma unroll
                    for (int n = 0; n < 2; ++n) *(f32x4*)(hb + (size_t)(fr - 12) * NUP + bj * DFF + 4 * n) = acc[1][bj][3][n]; } }
#pragma unroll
        for (int ai = 0; ai < 2; ++ai) { const int grp = 2 * ai + wr; u32x2 o0[4];
#pragma unroll
            for (int n = 0; n < 2; ++n) { f32x4 gval[4];
#pragma unroll
                for (int bj = 0; bj < 2; ++bj) {
                    const f32x4 w0 = *(const PG8_LAS f32x4*)(prm + (0 + bj) * 128 + chw + 4 * n), w1 = *(const PG8_LAS f32x4*)(prm + (2 + bj) * 128 + chw + 4 * n), w2 = *(const PG8_LAS f32x4*)(prm + (4 + bj) * 128 + chw + 4 * n), bb = *(const PG8_LAS f32x4*)(prm + (6 + bj) * 128 + chw + 4 * n);
                    const f32x4 hp = grp > 0 ? *(const PG8_LAS f32x4*)(edge + ((grp - 1) * 2 + 1) * 256 + bj * HALF + chw + 4 * n) : (f32x4){0.f, 0.f, 0.f, 0.f};
                    const f32x4 hn = grp < 3 ? *(const PG8_LAS f32x4*)(edge + ((grp + 1) * 2 + 0) * 256 + bj * HALF + chw + 4 * n) : (f32x4){0.f, 0.f, 0.f, 0.f};
                    f32x4 rr[4], ll[4];
#pragma unroll
                    for (int m = 0; m < 4; ++m) { rr[m] = dpp_ror1(acc[ai][bj][m][n]); ll[m] = dpp_rol1(acc[ai][bj][m][n]); }
#pragma unroll
                    for (int m = 0; m < 4; ++m) { const f32x4 rp = m > 0 ? rr[m - 1] : hp, ln = m < 3 ? ll[m + 1] : hn; f32x4 pv, nx;
#pragma unroll
                        for (int j = 0; j < 4; ++j) { pv[j] = __int_as_float(__builtin_amdgcn_update_dpp(__float_as_int(rp[j]), __float_as_int(acc[ai][bj][m][n][j]), 0x111, 0xf, 0xf, false));
                                                      nx[j] = __int_as_float(__builtin_amdgcn_update_dpp(__float_as_int(ln[j]), __float_as_int(acc[ai][bj][m][n][j]), 0x101, 0xf, 0xf, false)); }
                        const f32x4 val = bb + w0 * pv + w1 * acc[ai][bj][m][n] + w2 * nx;
                        if (bj == 0) gval[m] = val;
                        else { f32x4 e;
#pragma unroll
                            for (int j = 0; j < 4; ++j) e[j] = __builtin_amdgcn_exp2f(gval[m][j]);
                            e = e + 1.0f;
#pragma unroll
                            for (int j = 0; j < 4; ++j) e[j] = __builtin_amdgcn_rcpf(e[j]);
                            const f32x4 o = gval[m] * val * e;
                            u32x2 w; w.x = cvt_pk_bf16(o[0], o[1]); w.y = cvt_pk_bf16(o[2], o[3]);
                            if (n == 0) o0[m] = w;
                            else { u32x4 w4; w4.x = o0[m].x; w4.y = o0[m].y; w4.z = w.x; w4.w = w.y;
                                gst16<TAG>(ACT + (size_t)(u.pm * BM + ai * HALF + wr * 64 + m * 16 + fr) * ALD + u.pn * HALF + chw, w4); } } }
                    __builtin_amdgcn_sched_barrier(0); } } }
    }
};

template <class Epi, class Sched, bool ALIGN_EPI = false, bool SP2 = false>
__device__ __forceinline__ void gemm_phase(PG8_LAS unsigned char* lds, const Gemm g, const Sched& S, const Epi& E, int wave0  ) {
    int tid_ = wave0 * 64 + lane_now(); asm volatile("" : "+v"(tid_));
    const int tid = tid_, wid = __builtin_amdgcn_readfirstlane(tid >> 6), lane = tid & 63, wr = wid >> 2, wc = wid & 3, fr = lane & 15, fq = lane >> 4;
    const int K = g.K, nt = K / BK;
    unsigned voffA[2], voffB[2];
#pragma unroll
    for (int i = 0; i < 2; ++i) { int R, C; stage_rc(tid * 16 + i * 8192, R, C); const int Rb = Epi::PERM ? ((R & ~31) + perm32(R & 31)) : R;
        voffA[i] = (unsigned)(R * g.lda + C) * 2u; voffB[i] = (unsigned)(Rb * g.ldb + C) * 2u; }
    const size_t kstep = (size_t)(BK * 2);
    const size_t hstepA = (size_t)HALF * g.lda * 2, hstepB = g.b_hstep;
    const size_t tstepA = 2 * hstepA, tstepB = g.b_tstep;
    const unsigned ldsw = (unsigned)wid * 1024u;
    const int aoff = lds_byte(wr * 64 + fr, fq * 8), boff = lds_byte(wc * 32 + fr, fq * 8);
#define PG8_SA(b, h) (((b) * 2 + (h)) * HTB)
#define PG8_SB(b, h) ((4 + (b) * 2 + (h)) * HTB)
#define PG8_STAGE(bufoff, gbase, voff) do { _Pragma("unroll") for (int _i = 0; _i < 2; ++_i) { unsigned vo_ = (voff)[_i]; asm volatile("" : "+v"(vo_));     \
        __builtin_amdgcn_global_load_lds((const unsigned*)((const char*)(gbase) + vo_), (PG8_LAS unsigned*)(lds + (bufoff) + ldsw + _i * 8192), 16, 0, 0); } } while (0)
#define PG8_LDA(dst, b, h) do { _Pragma("unroll") for (int m = 0; m < 4; ++m) _Pragma("unroll") for (int k = 0; k < 2; ++k) dst[m][k] = *(const PG8_LAS bf16x8*)(lds + PG8_SA(b, h) + aoff + m * 2048 + k * 1024); } while (0)
#define PG8_LDB(dst, b, h) do { _Pragma("unroll") for (int n = 0; n < 2; ++n) _Pragma("unroll") for (int k = 0; k < 2; ++k) dst[n][k] = *(const PG8_LAS bf16x8*)(lds + PG8_SB(b, h) + boff + n * 2048 + k * 1024); } while (0)
#define PG8_MMA(ai, bj, At, Bt) do { __builtin_amdgcn_s_setprio(1); _Pragma("unroll") for (int m = 0; m < 4; ++m) _Pragma("unroll") for (int n = 0; n < 2; ++n) _Pragma("unroll") for (int k = 0; k < 2; ++k) \
        acc[ai][bj][m][n] = __builtin_amdgcn_mfma_f32_16x16x32_bf16(Bt[n][k], At[m][k], acc[ai][bj][m][n], 0, 0, 0); __builtin_amdgcn_s_setprio(0); } while (0)
#define PG8_WAIT_V(n) asm volatile("s_waitcnt vmcnt(" #n ")" ::: "memory")
#define PG8_WAIT_L(n) asm volatile("s_waitcnt lgkmcnt(" #n ")" ::: "memory")
#define PG8_BAR __builtin_amdgcn_s_barrier()
#define PG8_SCHED __builtin_amdgcn_sched_barrier(0)
    Unit cur, nxt; int ui = 0;
    if (!S.next(0, cur)) return;
    f32x4 acc[2][2][4][2];
#pragma unroll
    for (int a = 0; a < 2; ++a)
#pragma unroll
        for (int b = 0; b < 2; ++b)
#pragma unroll
            for (int m = 0; m < 4; ++m)
#pragma unroll
                for (int n = 0; n < 2; ++n) acc[a][b][m][n] = (f32x4){0.f, 0.f, 0.f, 0.f};
    bf16x8 At[4][2], B0[2][2], B1[2][2];
    const char* cA = (const char*)g.A + (size_t)cur.pm * tstepA + S.acol(cur); const char* cB = (const char*)g.Bt + (size_t)cur.pn * tstepB + S.bcol(cur);
    S.a_ready(cur);
    if constexpr (SP2) {
        PG8_STAGE(PG8_SB(0, 0), cB, voffB); PG8_STAGE(PG8_SB(0, 1), cB + hstepB, voffB); PG8_STAGE(PG8_SA(0, 0), cA, voffA); PG8_STAGE(PG8_SA(0, 1), cA + hstepA, voffA);
        if (wr == 1) PG8_BAR;
        PG8_WAIT_V(2); PG8_BAR;
        PG8_STAGE(PG8_SB(1, 0), cB + kstep, voffB); PG8_STAGE(PG8_SA(1, 0), cA + kstep, voffA); PG8_STAGE(PG8_SB(1, 1), cB + hstepB + kstep, voffB);
        PG8_WAIT_V(6); PG8_BAR;
    } else {
        PG8_STAGE(PG8_SB(0, 0), cB, voffB); PG8_STAGE(PG8_SA(0, 0), cA, voffA); PG8_STAGE(PG8_SB(0, 1), cB + hstepB, voffB); PG8_STAGE(PG8_SA(0, 1), cA + hstepA, voffA);
        if (wr == 1) PG8_BAR;
        PG8_WAIT_V(4); PG8_BAR;
        PG8_STAGE(PG8_SB(1, 0), cB + kstep, voffB); PG8_STAGE(PG8_SA(1, 0), cA + kstep, voffA); PG8_STAGE(PG8_SB(1, 1), cB + hstepB + kstep, voffB);
        PG8_WAIT_V(6); PG8_BAR;
    }
    f32x4 epre = {0.f, 0.f, 0.f, 0.f};
    if constexpr (Epi::TAG == 7) epre = E.pre(cur, tid);
    for (;;) {
        if constexpr (Epi::TAG == 6) epre = E.pre(cur, tid);
        const bool has_next = S.next(ui + 1, nxt);
        const char* nA = has_next ? (const char*)g.A + (size_t)nxt.pm * tstepA + S.acol(nxt) : cA; const char* nB = has_next ? (const char*)g.Bt + (size_t)nxt.pn * tstepB + S.bcol(nxt) : cB;
#ifdef MK_KREP
        const int ntt = nt * Epi::KREP;
        for (int t0_ = 0; t0_ < ntt; t0_ += 2) {
            const bool last = (t0_ == ntt - 2); const int t = t0_ % nt, tw = (t + 2) % nt;
#else
        for (int t = 0; t < nt; t += 2) {
            const bool last = (t == nt - 2); const int tw = t + 2;
#endif
            const char* a1 = cA + (size_t)(t + 1) * kstep;
            const char* a2 = last ? nA : cA + (size_t)tw * kstep; const char* b2 = last ? nB : cB + (size_t)tw * kstep;
            const char* a3 = a2 + kstep; const char* b3 = b2 + kstep;
            if (last && has_next) S.a_ready(nxt);
            if constexpr (SP2) {
            PG8_LDB(B0, 0, 0); PG8_LDB(B1, 0, 1); PG8_SCHED; PG8_LDA(At, 0, 0); PG8_STAGE(PG8_SA(1, 1), a1 + hstepA, voffA);
            PG8_WAIT_V(8); PG8_WAIT_L(0); PG8_BAR; PG8_MMA(0, 0, At, B0); PG8_MMA(0, 1, At, B1); PG8_BAR; PG8_SCHED;
            PG8_LDA(At, 0, 1); PG8_STAGE(PG8_SB(0, 0), b2, voffB); PG8_STAGE(PG8_SB(0, 1), b2 + hstepB, voffB); PG8_STAGE(PG8_SA(0, 0), a2, voffA);
            PG8_WAIT_V(8); PG8_WAIT_L(0); PG8_BAR; PG8_MMA(1, 0, At, B0); PG8_MMA(1, 1, At, B1); PG8_BAR; PG8_SCHED;
            PG8_LDB(B0, 1, 0); PG8_LDB(B1, 1, 1); PG8_SCHED; PG8_LDA(At, 1, 0); PG8_STAGE(PG8_SA(0, 1), a2 + hstepA, voffA);
            PG8_WAIT_V(8); PG8_WAIT_L(0); PG8_BAR; PG8_MMA(0, 0, At, B0); PG8_MMA(0, 1, At, B1); PG8_BAR; PG8_SCHED;
            PG8_LDA(At, 1, 1); PG8_STAGE(PG8_SB(1, 0), b3, voffB); PG8_STAGE(PG8_SB(1, 1), b3 + hstepB, voffB); PG8_STAGE(PG8_SA(1, 0), a3, voffA);
            PG8_WAIT_V(8); PG8_WAIT_L(0); PG8_BAR; PG8_MMA(1, 0, At, B0); PG8_MMA(1, 1, At, B1); PG8_BAR; PG8_SCHED;
            } else {
            PG8_LDB(B0, 0, 0); PG8_SCHED; PG8_LDA(At, 0, 0); PG8_STAGE(PG8_SA(1, 1), a1 + hstepA, voffA);
            PG8_WAIT_L(8); PG8_BAR; PG8_WAIT_L(0); PG8_MMA(0, 0, At, B0); PG8_BAR; PG8_SCHED;
            PG8_LDB(B1, 0, 1); PG8_STAGE(PG8_SB(0, 0), b2, voffB);
            PG8_BAR; PG8_WAIT_L(0); PG8_MMA(0, 1, At, B1); PG8_BAR;
            PG8_LDA(At, 0, 1); PG8_STAGE(PG8_SA(0, 0), a2, voffA);
            PG8_BAR; PG8_WAIT_L(0); PG8_MMA(1, 0, At, B0); PG8_BAR; PG8_SCHED;
            PG8_STAGE(PG8_SB(0, 1), b2 + hstepB, voffB);
            PG8_WAIT_V(6); PG8_BAR; PG8_MMA(1, 1, At, B1); PG8_BAR;
            PG8_LDB(B0, 1, 0); PG8_SCHED; PG8_LDA(At, 1, 0); PG8_STAGE(PG8_SA(0, 1), a2 + hstepA, voffA);
            PG8_WAIT_L(8); PG8_BAR; PG8_WAIT_L(0); PG8_MMA(0, 0, At, B0); PG8_BAR; PG8_SCHED;
            PG8_LDB(B1, 1, 1); PG8_STAGE(PG8_SB(1, 0), b3, voffB);
            PG8_BAR; PG8_WAIT_L(0); PG8_MMA(0, 1, At, B1); PG8_BAR;
            PG8_LDA(At, 1, 1); PG8_STAGE(PG8_SA(1, 0), a3, voffA);
            PG8_BAR; PG8_WAIT_L(0); PG8_MMA(1, 0, At, B0); PG8_BAR; PG8_SCHED;
            PG8_STAGE(PG8_SB(1, 1), b3 + hstepB, voffB);
            PG8_WAIT_V(6); PG8_BAR; PG8_MMA(1, 1, At, B1); PG8_BAR;
            }
        }
        if constexpr (ALIGN_EPI) { if (wr == 0) PG8_BAR; }
        #ifdef MK_KREP
        if constexpr (Epi::KREP > 1) {
#pragma unroll
            for (int a = 0; a < 2; ++a)
#pragma unroll
                for (int b = 0; b < 2; ++b)
#pragma unroll
                    for (int m = 0; m < 4; ++m)
#pragma unroll
                        for (int n = 0; n < 2; ++n) acc[a][b][m][n] *= (1.0f / Epi::KREP); }
#endif
        if constexpr (!Epi::AFTER_DRAIN) { int t2 = lane_now(); asm volatile("" : "+v"(t2));
            if constexpr (Epi::TAG == 6) E(acc, cur, wr, wc, t2 & 15, (t2 & 63) >> 4, epre); else E(acc, cur, wr, wc, t2 & 15, (t2 & 63) >> 4);
#ifdef MK_EPI2
            if constexpr (Epi::TAG == MK_EPI2 && Epi::TAG != 6) { asm volatile("" ::: "memory"); E(acc, cur, wr, wc, t2 & 15, (t2 & 63) >> 4); }
#endif
            S.done(cur); }
        if (!has_next) break;
#pragma unroll
        for (int a = 0; a < 2; ++a)
#pragma unroll
            for (int b = 0; b < 2; ++b)
#pragma unroll
                for (int m = 0; m < 4; ++m)
#pragma unroll
                    for (int n = 0; n < 2; ++n) acc[a][b][m][n] = (f32x4){0.f, 0.f, 0.f, 0.f};
        cur = nxt; cA = nA; cB = nB; ++ui;
        if constexpr (ALIGN_EPI) { if (wr == 1) PG8_BAR; }
    }
    PG8_WAIT_V(0);
    if constexpr (!ALIGN_EPI) { if (wr == 0) PG8_BAR; }
    PG8_BAR;
    if constexpr (Epi::AFTER_DRAIN) { if constexpr (Epi::TAG == 7) E.fused(acc, cur, wr, wc, fr, fq, lds, epre); else E.fused(acc, cur, wr, wc, fr, fq, lds, wid, lane); S.done(cur); }
#undef PG8_SA
#undef PG8_SB
#undef PG8_STAGE
#undef PG8_LDA
#undef PG8_LDB
#undef PG8_MMA
#undef PG8_WAIT_V
#undef PG8_WAIT_L
#undef PG8_BAR
#undef PG8_SCHED
}

__device__ __forceinline__ void gate_stage(PG8_LAS unsigned char* lds, const Gemm g, int pm, int pn, int wave0) {
    int tid_ = wave0 * 64 + lane_now(); asm volatile("" : "+v"(tid_));
    const int tid = tid_, wid = __builtin_amdgcn_readfirstlane(tid >> 6);
    const unsigned ldsw = (unsigned)wid * 1024u;
    const char* cA = (const char*)g.A + (size_t)pm * (2 * (size_t)HALF * g.lda * 2) + (size_t)(pn >> 1) * 256; const char* cB = (const char*)g.Bt + (size_t)pn * g.b_tstep;
    const size_t hstepA = (size_t)HALF * g.lda * 2, hstepB = g.b_hstep;
#pragma unroll
    for (int i = 0; i < 2; ++i) { int R, C; stage_rc(tid * 16 + i * 8192, R, C); const int Rb = (R & ~31) + perm32(R & 31);
        const unsigned voA = (unsigned)(R * g.lda + C) * 2u, voB = (unsigned)(Rb * g.ldb + C) * 2u;
#pragma unroll
        for (int b = 0; b < 2; ++b)
#pragma unroll
            for (int h = 0; h < 2; ++h) {
                __builtin_amdgcn_global_load_lds((const unsigned*)(cA + h * hstepA + b * (BK * 2) + voA), (PG8_LAS unsigned*)(lds + ((b * 2 + h) * HTB) + ldsw + i * 8192), 16, 0, 0);
                __builtin_amdgcn_global_load_lds((const unsigned*)(cB + h * hstepB + b * (BK * 2) + voB), (PG8_LAS unsigned*)(lds + ((4 + b * 2 + h) * HTB) + ldsw + i * 8192), 16, 0, 0); } }
}
__device__ __forceinline__ void gate_compute(const PG8_LAS unsigned char* lds, f32x4 (&acc)[2][2][4][2], int wr, int wc, int fr, int fq) {
    const int aoff = lds_byte(wr * 64 + fr, fq * 8), boff = lds_byte(wc * 32 + fr, fq * 8);
#pragma unroll
    for (int a = 0; a < 2; ++a)
#pragma unroll
        for (int b = 0; b < 2; ++b)
#pragma unroll
            for (int m = 0; m < 4; ++m)
#pragma unroll
                for (int n = 0; n < 2; ++n) acc[a][b][m][n] = (f32x4){0.f, 0.f, 0.f, 0.f};
#pragma unroll
    for (int kb = 0; kb < 2; ++kb) { bf16x8 B0[2][2], B1[2][2];
#pragma unroll
        for (int n = 0; n < 2; ++n)
#pragma unroll
            for (int k = 0; k < 2; ++k) { B0[n][k] = *(const PG8_LAS bf16x8*)(lds + (4 + kb * 2 + 0) * HTB + boff + n * 2048 + k * 1024); B1[n][k] = *(const PG8_LAS bf16x8*)(lds + (4 + kb * 2 + 1) * HTB + boff + n * 2048 + k * 1024); }
#pragma unroll
        for (int ai = 0; ai < 2; ++ai) { bf16x8 At[4][2];
#pragma unroll
            for (int m = 0; m < 4; ++m)
#pragma unroll
                for (int k = 0; k < 2; ++k) At[m][k] = *(const PG8_LAS bf16x8*)(lds + (kb * 2 + ai) * HTB + aoff + m * 2048 + k * 1024);
#pragma unroll
            for (int m = 0; m < 4; ++m)
#pragma unroll
                for (int n = 0; n < 2; ++n)
#pragma unroll
                    for (int k = 0; k < 2; ++k) { acc[ai][0][m][n] = __builtin_amdgcn_mfma_f32_16x16x32_bf16(B0[n][k], At[m][k], acc[ai][0][m][n], 0, 0, 0);
                                                  acc[ai][1][m][n] = __builtin_amdgcn_mfma_f32_16x16x32_bf16(B1[n][k], At[m][k], acc[ai][1][m][n], 0, 0, 0); } } }
}
}

#define GAS __attribute__((address_space(1)))
#define LAS __attribute__((address_space(3)))
typedef unsigned short bf16;
typedef unsigned v4u __attribute__((ext_vector_type(4)));
typedef float f32x4 __attribute__((ext_vector_type(4)));
typedef short bf16x8 __attribute__((ext_vector_type(8)));
typedef GAS unsigned gu32;
typedef GAS unsigned long long gu64;
#define RLX_AGENT __ATOMIC_RELAXED, __HIP_MEMORY_SCOPE_AGENT
#define LDS_WAIT() asm volatile("s_waitcnt lgkmcnt(0)" ::: "memory")
#define VM_WAIT() asm volatile("s_waitcnt vmcnt(0)" ::: "memory")
__device__ __forceinline__ unsigned long long rt() { return __builtin_amdgcn_s_memrealtime(); }
__device__ __forceinline__ unsigned f2bf(float f) { unsigned u = __builtin_bit_cast(unsigned, f); return (u + 0x7fffu + ((u >> 16) & 1u)) >> 16; }
__device__ __forceinline__ unsigned pk2(float lo, float hi) { unsigned r; asm("v_cvt_pk_bf16_f32 %0, %1, %2" : "=v"(r) : "v"(lo), "v"(hi)); return r; }

#define XB_TMO      128
#define XB_XCNT(j)  (256  + 64 * (j))
#define XB_XSUB(j)  (1280 + 64 * (j))
#define XB_XGEN(j)  (2304 + 64 * (j))
#define XB_TOP      3328
#define XB_TOPGEN   3392
#define XCD_BAR_WORDS 3456
#define XB_SPIN_CAP (1u << 18)

__device__ __forceinline__ unsigned xb_ld(unsigned* p)              { return __hip_atomic_load(p, __ATOMIC_RELAXED, __HIP_MEMORY_SCOPE_AGENT); }
__device__ __forceinline__ unsigned xb_add(unsigned* p, unsigned v) { return __hip_atomic_fetch_add(p, v, __ATOMIC_RELAXED, __HIP_MEMORY_SCOPE_AGENT); }
__device__ __forceinline__ unsigned xb_xcc_id() { return (unsigned)__builtin_amdgcn_s_getreg((3 << 11) | 20) & 0xFu; }
#define XB_SPIN(cond, bar) do { unsigned _sp = 0; while (cond) { __builtin_amdgcn_s_sleep(1); \
    if ((++_sp & 255u) == 0u) { if (xb_ld(&(bar)[XB_TMO])) break; if (_sp > XB_SPIN_CAP) { atomicAdd(&(bar)[XB_TMO], 1u); break; } } } } while (0)

struct XcdBarrier {
    unsigned* bar; unsigned x;
    volatile LAS unsigned* st;
};

__device__ __forceinline__ XcdBarrier xcd_barrier_post(unsigned* bar, volatile LAS unsigned* st, bool t0  ) {
    XcdBarrier b; b.bar = bar; b.x = xb_xcc_id(); b.st = st;
    if (t0) (void)xb_add(&bar[XB_XCNT(b.x)], 1u);
    return b;
}
__device__ __forceinline__ void xcd_barrier_complete(unsigned* bar, unsigned x, unsigned& nloc, unsigned& nx) {
    const unsigned G = gridDim.x * gridDim.y * gridDim.z;
    unsigned sum, cnt, mine, sp = 0u;
    for (;;) {
        sum = 0u; cnt = 0u; mine = 0u;
#pragma unroll
        for (unsigned j = 0; j < 16; ++j) { const unsigned c = xb_ld(&bar[XB_XCNT(j)]); sum += c; cnt += (c > 0u) ? 1u : 0u; mine = (j == x) ? c : mine; }
        if (sum == G) break;
        __builtin_amdgcn_s_sleep(1);
        if ((++sp & 255u) == 0u) { if (xb_ld(&bar[XB_TMO])) break; if (sp > XB_SPIN_CAP) { atomicAdd(&bar[XB_TMO], 1u); break; } }
    }
    nloc = mine > 0u ? mine : 1u; nx = cnt > 0u ? cnt : 1u;
}

__device__ __forceinline__ void xcd_barrier(const XcdBarrier& b, bool t0  ) {
    asm volatile("s_waitcnt vmcnt(0)" ::: "memory");
    __syncthreads();
    if (t0) {
        unsigned* bar = b.bar; asm volatile("" : "+s"(bar));
        __builtin_amdgcn_s_waitcnt(0);
        unsigned nloc = b.st[0], nx = b.st[1];
        if (nloc == 0u) { xcd_barrier_complete(bar, b.x, nloc, nx); b.st[0] = nloc; b.st[1] = nx; }
        const unsigned old = xb_add(&bar[XB_XSUB(b.x)], 1u);
        const unsigned gen = old / nloc;
        if (old + 1u == (gen + 1u) * nloc) {
            __builtin_amdgcn_fence(__ATOMIC_RELEASE, "agent");
            asm volatile("s_waitcnt vmcnt(0)" ::: "memory");
            const unsigned og = xb_add(&bar[XB_TOP], 1u);
            const unsigned tg = og / nx;
            if (og + 1u == (tg + 1u) * nx) xb_add(&bar[XB_TOPGEN], 1u);
            else XB_SPIN(xb_ld(&bar[XB_TOPGEN]) == tg, bar);
            __builtin_amdgcn_fence(__ATOMIC_ACQUIRE, "agent");
            xb_add(&bar[XB_XGEN(b.x)], 1u);
            asm volatile("s_waitcnt vmcnt(0)" ::: "memory");
        } else {
            XB_SPIN(xb_ld(&bar[XB_XGEN(b.x)]) == gen, bar);
            __builtin_amdgcn_fence(__ATOMIC_ACQUIRE, "agent");
            asm volatile("s_waitcnt vmcnt(0)" ::: "memory");
        }
    }
    __syncthreads();
}

namespace att {
using bf16x8 = __attribute__((ext_vector_type(8))) short;
using s16x4  = __attribute__((ext_vector_type(4))) short;
using f32x16 = __attribute__((ext_vector_type(16))) float;
using u32x4  = __attribute__((ext_vector_type(4))) unsigned;
using f32x4  = __attribute__((ext_vector_type(4))) float;
typedef unsigned short bf16;
constexpr int QBLK = 32, KVBLK = 64, NW = 8;
constexpr float SCALE = 0.07216878364870322f;
constexpr float THR = 8.f;
constexpr int LDQ = NQ, LDKN = D, LDKR = ROPE, LDV = D, LDO = D;
constexpr int SHM_V = KVBLK * 128 * 2, SHM_K = KVBLK * 128 * 2, SHM_R = KVBLK * 64 * 2;
constexpr int OFF_V = 0  , OFF_K = 3 * SHM_V  , OFF_R = OFF_K + 2 * SHM_K  , OFF_QR = OFF_R + 2 * SHM_R  , ATTN_LDS_BYTES = OFF_QR + NW * 4096;
#define KSWZ(row, colB) ((row) * 256 + ((colB) ^ (((row) & 7) << 4)))
#define RSWZ(row, colB) ((row) * 128 + ((colB) ^ ((((row) >> 1) & 7) << 4)))
#define SBAR() __builtin_amdgcn_sched_barrier(0)
__device__ __forceinline__ int crow(int r, int hi) { return (r & 3) + 8 * (r >> 2) + 4 * hi; }
__device__ __forceinline__ unsigned cvtpk(float lo, float hi) { unsigned r; asm("v_cvt_pk_bf16_f32 %0, %1, %2" : "=v"(r) : "v"(lo), "v"(hi)); return r; }
#define ATT_INTERLEAVE() do { _Pragma("unroll") for (int i_ = 0; i_ < 12; ++i_) { __builtin_amdgcn_sched_group_barrier(0x100, 3, 0); __builtin_amdgcn_sched_group_barrier(0x008, 2, 0); __builtin_amdgcn_sched_group_barrier(0x002, 12, 0); } } while (0)

__device__ __forceinline__ void partialSM(f32x16& p0, f32x16& p1, float& m_reg, float& mn, float& alpha) {
  constexpr float C = SCALE * 1.4426950408889634f;
  float pmax = p0[0];
#pragma unroll
  for (int r = 1; r < 16; ++r) pmax = fmaxf(pmax, p0[r]);
#pragma unroll
  for (int r = 0; r < 16; ++r) pmax = fmaxf(pmax, p1[r]);
  { auto rr = __builtin_amdgcn_permlane32_swap(__float_as_uint(pmax), __float_as_uint(pmax), false, false);
    pmax = fmaxf(__uint_as_float(rr[0]), __uint_as_float(rr[1])); }
  if (__builtin_expect(__all(pmax - m_reg <= THR / SCALE), 1)) { mn = m_reg; alpha = 1.f; }
  else { mn = fmaxf(m_reg, pmax); alpha = __builtin_amdgcn_exp2f((m_reg - mn) * C); m_reg = mn; }
  float mnC = -mn * C;
#pragma unroll
  for (int r = 0; r < 16; ++r) p0[r] = fmaf(p0[r], C, mnC);
#pragma unroll
  for (int r = 0; r < 16; ++r) p1[r] = fmaf(p1[r], C, mnC);
#pragma unroll
  for (int r = 0; r < 16; ++r) p0[r] = __builtin_amdgcn_exp2f(p0[r]);
}
__device__ __forceinline__ void finishSM(f32x16& p0, f32x16& p1, float alpha, float& l_reg, bf16x8& pa0, bf16x8& pa1, bf16x8& pa2, bf16x8& pa3) {
#pragma unroll
  for (int r = 0; r < 16; ++r) p1[r] = __builtin_amdgcn_exp2f(p1[r]);
  float ps = 0;
#pragma unroll
  for (int r = 0; r < 16; ++r) ps += p0[r];
#pragma unroll
  for (int r = 0; r < 16; ++r) ps += p1[r];
  { auto rr = __builtin_amdgcn_permlane32_swap(__float_as_uint(ps), __float_as_uint(ps), false, false);
    ps = __uint_as_float(rr[0]) + __uint_as_float(rr[1]); }
  l_reg = l_reg * alpha + ps;
#define PK4(P, BASE, OUT) do { unsigned a0 = cvtpk(P[BASE + 0], P[BASE + 1]), a1 = cvtpk(P[BASE + 2], P[BASE + 3]);   \
    unsigned b0 = cvtpk(P[BASE + 4], P[BASE + 5]), b1 = cvtpk(P[BASE + 6], P[BASE + 7]);                              \
    auto r0 = __builtin_amdgcn_permlane32_swap(a0, b0, false, false); auto r1 = __builtin_amdgcn_permlane32_swap(a1, b1, false, false); \
    u32x4 w = {r0[0], r1[0], r0[1], r1[1]}; OUT = *reinterpret_cast<bf16x8*>(&w); } while (0)
  PK4(p0, 0, pa0); PK4(p0, 8, pa1); PK4(p1, 0, pa2); PK4(p1, 8, pa3);
#undef PK4
}
__device__ __forceinline__ void qkt(f32x16& p0, f32x16& p1, const char* Ks, const char* Rs, const char* Qs, const char* Q7s  , const bf16x8* qr, int r32, int hi) {
  p0 = f32x16{}; p1 = f32x16{};
  bf16x8 b0 = *reinterpret_cast<const bf16x8*>(Ks + KSWZ(r32, (hi * 8) * 2)), b1 = *reinterpret_cast<const bf16x8*>(Ks + KSWZ(32 + r32, (hi * 8) * 2)), qf = qr[0];
#pragma unroll
  for (int d0 = 0; d0 < 12; ++d0) {
    bf16x8 n0 = b0, n1 = b1, nq = qf;
    if (d0 + 1 < 8) { const int cb = ((d0 + 1) * 16 + hi * 8) * 2; n0 = *reinterpret_cast<const bf16x8*>(Ks + KSWZ(r32, cb)); n1 = *reinterpret_cast<const bf16x8*>(Ks + KSWZ(32 + r32, cb)); if (d0 + 1 < 7) nq = qr[d0 + 1]; else nq = *reinterpret_cast<const bf16x8*>(Q7s); }
    else if (d0 + 1 < 12) { const int cb = ((d0 + 1 - 8) * 16 + hi * 8) * 2; n0 = *reinterpret_cast<const bf16x8*>(Rs + RSWZ(r32, cb)); n1 = *reinterpret_cast<const bf16x8*>(Rs + RSWZ(32 + r32, cb)); nq = *reinterpret_cast<const bf16x8*>(Qs + RSWZ(r32, cb)); }
    p0 = __builtin_amdgcn_mfma_f32_32x32x16_bf16(b0, qf, p0, 0, 0, 0);
    p1 = __builtin_amdgcn_mfma_f32_32x32x16_bf16(b1, qf, p1, 0, 0, 0);
    b0 = n0; b1 = n1; qf = nq; }
}
__device__ __forceinline__ int v_st(int k, int c) { const int kk = (k & ~0xC) | ((k & 4) << 1) | ((k & 8) >> 1); return ((kk >> 3) * 4 + (c >> 5)) * 512 + ((kk & 7) * 32 + (c & 31)) * 2; }
__device__ __forceinline__ int v_rd_base(int lane) { return ((lane & 3) << 3) | (((lane >> 2) & 3) << 6) | (((lane >> 4) & 1) << 5) | (((lane >> 5) & 1) << 8); }
constexpr int v_rd_off(int d0, int ks, int half) { return d0 * 512 + ks * 4096 + half * 2048; }
template <int OFF> __device__ __forceinline__ s16x4 tr_read(int vb) {
  s16x4 r; asm volatile("ds_read_b64_tr_b16 %0, %1 offset:%2" : "=&v"(r) : "v"(vb), "i"(OFF) : "memory"); return r;
}
template <int D0> __device__ __forceinline__ void pv_one(f32x16& od, int vb, bf16x8 pa0, bf16x8 pa1, bf16x8 pa2, bf16x8 pa3) {
  const s16x4 l0 = tr_read<v_rd_off(D0, 0, 0)>(vb), h0 = tr_read<v_rd_off(D0, 0, 1)>(vb), l1 = tr_read<v_rd_off(D0, 1, 0)>(vb), h1 = tr_read<v_rd_off(D0, 1, 1)>(vb);
  const s16x4 l2 = tr_read<v_rd_off(D0, 2, 0)>(vb), h2 = tr_read<v_rd_off(D0, 2, 1)>(vb), l3 = tr_read<v_rd_off(D0, 3, 0)>(vb), h3 = tr_read<v_rd_off(D0, 3, 1)>(vb);
  asm volatile("s_waitcnt lgkmcnt(0)" ::: "memory"); SBAR();
#define PK(L, H) (bf16x8){L[0], L[1], L[2], L[3], H[0], H[1], H[2], H[3]}
  od = __builtin_amdgcn_mfma_f32_32x32x16_bf16(pa0, PK(l0, h0), od, 0, 0, 0);
  od = __builtin_amdgcn_mfma_f32_32x32x16_bf16(pa1, PK(l1, h1), od, 0, 0, 0);
  od = __builtin_amdgcn_mfma_f32_32x32x16_bf16(pa2, PK(l2, h2), od, 0, 0, 0);
  od = __builtin_amdgcn_mfma_f32_32x32x16_bf16(pa3, PK(l3, h3), od, 0, 0, 0);
#undef PK
}
__device__ __forceinline__ void pv_d0(f32x16* o, int vb, bf16x8 pa0, bf16x8 pa1, bf16x8 pa2, bf16x8 pa3) {
  pv_one<0>(o[0], vb, pa0, pa1, pa2, pa3); pv_one<1>(o[1], vb, pa0, pa1, pa2, pa3); pv_one<2>(o[2], vb, pa0, pa1, pa2, pa3); pv_one<3>(o[3], vb, pa0, pa1, pa2, pa3);
}

__device__ __forceinline__ void attn_unit(const bf16* __restrict__ Qb, const bf16* __restrict__ Kn, const bf16* __restrict__ Kr, const bf16* __restrict__ Vh,
                                          bf16* __restrict__ Ob, int seq, char* lds, char* wsl, int wave0) {
  int tid_ = wave0 * 64 + lane_now(); asm volatile("" : "+v"(tid_));
  const int tid = tid_, wid = __builtin_amdgcn_readfirstlane(tid >> 6), lane = tid & 63, r32 = lane & 31, hi = lane >> 5;
  float* ws = (float*)wsl + wid * 64; float* li_l = ws; float* al_l = ws + 32;
  float m_reg = -1e30f, l_reg = 0; f32x16 o[4] = {}; bf16x8 qr[7];
  typedef __attribute__((address_space(3))) unsigned lds_u32;
#define DMA_TILE(t, vs, ks) do { const bf16* gk_ = Kn + (size_t)(t) * KVBLK * LDKN; const bf16* gv_ = Vh + (size_t)(t) * KVBLK * LDV; const bf16* gr_ = Kr + (size_t)(t) * KVBLK * LDKR; \
    int ln_ = lane; asm volatile("" : "+v"(ln_)); \
    _Pragma("unroll") for (int i_ = 0; i_ < 2; ++i_) { const int L16 = wid * 128 + i_ * 64 + ln_; \
      const int rowk_ = L16 >> 4, ck_ = (L16 & 15) ^ (rowk_ & 7); \
      const int sub_ = L16 >> 5, wi_ = L16 & 31, kk_ = ((sub_ >> 2) << 3) | (wi_ >> 2), cv_ = ((sub_ & 3) << 5) + ((wi_ & 3) << 3), kv_ = (kk_ & ~0xC) | ((kk_ & 4) << 1) | ((kk_ & 8) >> 1); \
      __builtin_amdgcn_global_load_lds((const unsigned*)(gv_ + (unsigned)(kv_ * LDV + cv_)), (lds_u32*)(lds + OFF_V + (vs) + (wid * 128 + i_ * 64) * 16), 16, 0, 0); \
      __builtin_amdgcn_global_load_lds((const unsigned*)(gk_ + (unsigned)(rowk_ * LDKN + ck_ * 8)), (lds_u32*)(lds + OFF_K + (ks) * SHM_K + (wid * 128 + i_ * 64) * 16), 16, 0, 0); } \
    { const int L16 = wid * 64 + ln_, rowr_ = L16 >> 3, cr_ = (L16 & 7) ^ ((rowr_ >> 1) & 7); \
      __builtin_amdgcn_global_load_lds((const unsigned*)(gr_ + (unsigned)(rowr_ * LDKR + cr_ * 8)), (lds_u32*)(lds + OFF_R + (ks) * SHM_R + (wid * 64) * 16), 16, 0, 0); } } while (0)
#define TILE_SYNC() do { asm volatile("s_waitcnt vmcnt(0)" ::: "memory"); __syncthreads(); } while (0)
#define RESC(a) do { if (__any((a) < 1.f)) { if (hi == 0) al_l[r32] = (a); asm volatile("s_waitcnt lgkmcnt(0)" ::: "memory"); \
    _Pragma("unroll") for (int d = 0; d < 4; ++d) _Pragma("unroll") for (int r = 0; r < 16; ++r) o[d][r] *= al_l[crow(r, hi)]; } } while (0)
  const int NT = seq / KVBLK;
  int s0 = 0, s1 = SHM_V, s2 = 2 * SHM_V;
  DMA_TILE(0, s0, 0); DMA_TILE(1, s1, 1);
  const bf16* Qw = Qb + (long)(wid * QBLK + r32) * LDQ + hi * 8;
#pragma unroll
  for (int d0 = 0; d0 < 7; ++d0) qr[d0] = *reinterpret_cast<const bf16x8*>(Qw + d0 * 16);
  char* Q7s = wsl + 2048 + wid * 1024 + r32 * 32 + hi * 16;
  *reinterpret_cast<bf16x8*>(Q7s) = *reinterpret_cast<const bf16x8*>(Qw + 7 * 16);
  char* Qs = lds + OFF_QR + wid * 4096;
  { bf16x8 qx[4];
#pragma unroll
    for (int d0 = 0; d0 < 4; ++d0) qx[d0] = *reinterpret_cast<const bf16x8*>(Qw + (8 + d0) * 16);
#pragma unroll
    for (int d0 = 0; d0 < 4; ++d0) *reinterpret_cast<bf16x8*>(Qs + RSWZ(r32, (d0 * 16 + hi * 8) * 2)) = qx[d0]; }
  const int vb0 = (int)(uintptr_t)lds + OFF_V + v_rd_base(lane);
  TILE_SYNC();
  f32x16 pA0, pA1, pB0, pB1; float mnA, mnB, alA, alB; bf16x8 pa0, pa1, pa2, pa3;
  qkt(pA0, pA1, lds + OFF_K, lds + OFF_R, Qs, Q7s, qr, r32, hi); partialSM(pA0, pA1, m_reg, mnA, alA);
  for (int j = 0; j < NT; j += 2) {
    if (j + 2 < NT) DMA_TILE(j + 2, s2, 0);
    SBAR(); qkt(pB0, pB1, lds + OFF_K + SHM_K, lds + OFF_R + SHM_R, Qs, Q7s, qr, r32, hi);
#ifdef MK_AQ2
    asm volatile("" : "+v"(pB0), "+v"(pB1)); qkt(pB0, pB1, lds + OFF_K + SHM_K, lds + OFF_R + SHM_R, Qs, Q7s, qr, r32, hi);
#endif
    finishSM(pA0, pA1, alA, l_reg, pa0, pa1, pa2, pa3); SBAR();
    pv_d0(o, vb0 + s0, pa0, pa1, pa2, pa3);
#ifdef MK_APV2
    { bf16x8 z_ = {0, 0, 0, 0, 0, 0, 0, 0}; asm volatile("" : "+v"(z_)); pv_d0(o, vb0 + s0, z_, z_, z_, z_); }
#endif
    partialSM(pB0, pB1, m_reg, mnB, alB);
    TILE_SYNC(); RESC(alB);
    const bool more = j + 2 < NT;
    if (j + 3 < NT) DMA_TILE(j + 3, s0, 1);
    SBAR(); if (more) qkt(pA0, pA1, lds + OFF_K, lds + OFF_R, Qs, Q7s, qr, r32, hi);
#ifdef MK_AQ2
    asm volatile("" : "+v"(pA0), "+v"(pA1)); if (more) qkt(pA0, pA1, lds + OFF_K, lds + OFF_R, Qs, Q7s, qr, r32, hi);
#endif
    finishSM(pB0, pB1, alB, l_reg, pa0, pa1, pa2, pa3); SBAR();
    pv_d0(o, vb0 + s1, pa0, pa1, pa2, pa3);
#ifdef MK_APV2
    { bf16x8 z_ = {0, 0, 0, 0, 0, 0, 0, 0}; asm volatile("" : "+v"(z_)); pv_d0(o, vb0 + s1, z_, z_, z_, z_); }
#endif
    if (more) partialSM(pA0, pA1, m_reg, mnA, alA);
    TILE_SYNC(); if (more) RESC(alA);
    const int t_ = s0; s0 = s2; s2 = s1; s1 = t_;
  }
  { const int le = lane_now(), r32e = le & 31, hie = le >> 5; float* li_e = (float*)wsl + wid * 64;
    if (hie == 0) li_e[r32e] = l_reg; asm volatile("s_waitcnt lgkmcnt(0)" ::: "memory");
    float rli[16];
#pragma unroll
    for (int r = 0; r < 16; ++r) rli[r] = __builtin_amdgcn_rcpf(li_e[crow(r, hie)]);
    float* os = (float*)(lds + wid * 16384);
#pragma unroll
    for (int r = 0; r < 16; ++r) { const int orow = crow(r, hie);
#pragma unroll
      for (int d0 = 0; d0 < 4; ++d0) os[orow * 128 + d0 * 32 + r32e] = o[d0][r] * rli[r]; }
    asm volatile("s_waitcnt lgkmcnt(0)" ::: "memory");
    bf16* Ow = Ob + (long)(wid * QBLK) * LDO;
#pragma unroll
    for (int i = 0; i < 8; ++i) { const int ch = i * 64 + le, row = ch >> 4, c8 = (ch & 15) * 8;
      const f32x4* sp = (const f32x4*)(os + row * 128 + c8); const f32x4 a = sp[0], b = sp[1];
      u32x4 w = {cvtpk(a[0], a[1]), cvtpk(a[2], a[3]), cvtpk(b[0], b[1]), cvtpk(b[2], b[3])};
      *reinterpret_cast<u32x4*>(Ow + (long)row * LDO + c8) = w; } }
#undef DMA_TILE
#undef TILE_SYNC
#undef RESC
}
}

constexpr size_t MiB = 1u << 20;
constexpr size_t WS_CTL = 0, CTL_ZERO_BYTES = 64 * 1024;
constexpr size_t WS_MODS = 1 * MiB;
constexpr size_t WS_COS = 3 * MiB, WS_SIN = WS_COS + 128 * 1024, WS_SP = WS_SIN + 128 * 1024;
constexpr size_t WS_WIN = 4 * MiB, WS_WUQ = 14 * MiB, WS_WUKV = 20 * MiB, WS_WO = 28 * MiB, WS_WRIN = 44 * MiB, WS_WG = 76 * MiB, WS_WROUT = 80 * MiB, WS_WUP = 96 * MiB, WS_WDN = 272 * MiB;
constexpr size_t WS_X = 362 * MiB, WS_H = 490 * MiB, WS_S = 554 * MiB, WS_END = 1194 * MiB;
constexpr size_t WS_U = WS_S, WS_HALO = WS_S, WS_ACT = WS_S + 352 * MiB;
constexpr size_t WS_PROJ = WS_S, WS_CQ = WS_S + 80 * MiB, WS_CKV = WS_S + 96 * MiB, WS_KR = WS_S + 114 * MiB, WS_Q = WS_S + 117 * MiB, WS_KN = WS_S + 213 * MiB, WS_V = WS_S + 285 * MiB, WS_O = WS_S + 357 * MiB, WS_PKR = WS_S + 421 * MiB;
constexpr size_t WS_RIN = WS_S, WS_XC = WS_S + 128 * MiB, WS_LA = WS_S + 192 * MiB, WS_UU = WS_S + 320 * MiB, WS_HB = WS_S + 448 * MiB, WS_MIX = WS_S + 576 * MiB;
static_assert(WS_WIN + 2ull * NINP * D * 2 <= WS_WUQ && WS_WUQ + 2ull * NQ * QL * 2 <= WS_WUKV && WS_WUKV + 2ull * NKV * KVL * 2 <= WS_WO && WS_WO + 2ull * D * D * 2 <= WS_WRIN, "ws map 1");
static_assert(WS_WRIN + 2ull * 2 * D * D * 2 <= WS_WG && WS_WG + 2ull * 8192 * 128 * 2 <= WS_WROUT && WS_WROUT + 2ull * D * D * 2 <= WS_WUP && WS_WUP + 4ull * NUP * D * 2 <= WS_WDN && WS_WDN + 4ull * D * ALD * 2 <= WS_X, "ws map 2");
static_assert(WS_X + (size_t)NTOK * D * 2 <= WS_H && WS_H + (size_t)NTOK * D * 2 <= WS_S, "ws map 3");
static_assert(WS_U + (size_t)NTOK * NUP * 2 <= WS_ACT && WS_ACT + (size_t)NTOK * ALD * 2 <= WS_END, "ws map ffn");
static_assert(WS_PROJ + (size_t)NTOK * NINP * 4 <= WS_CQ && WS_CQ + (size_t)NTOK * QL * 2 <= WS_CKV && WS_CKV + (size_t)MKV * KVL * 2 <= WS_KR && WS_KR + (size_t)MKV * ROPE * 2 <= WS_Q && WS_Q + (size_t)NTOK * NQ * 2 <= WS_KN
              && WS_KN + (size_t)MKV * D * 2 <= WS_V && WS_V + (size_t)MKV * D * 2 <= WS_O && WS_O + (size_t)NTOK * D * 2 <= WS_END, "ws map attn");
static_assert(WS_RIN + (size_t)NTOK * 2 * D * 2 <= WS_XC && WS_XC + (size_t)NTOK * D * 2 <= WS_LA && WS_LA + 2ull * NTOK * D * 2 <= WS_UU && WS_UU + 2ull * NTOK * D * 2 <= WS_HB && WS_HB + (size_t)NTOK * D * 4 <= WS_MIX && WS_MIX + (size_t)NTOK * D * 2 <= WS_END, "ws map rec");
constexpr int CW_BAR = 1024;
constexpr size_t OUT_Y = 0, OUT_CKV = 2ull * MCTX * D, OUT_KR = OUT_CKV + 32ull * 2 * 256 * KVL, OUT_ST = OUT_KR + 32ull * 2 * 256 * ROPE, OUT_TOTAL = OUT_ST + 32ull * 2 * 2 * D;

constexpr int NWAVES = 8;
constexpr int RING_OFF = 0, RING_BYTES = 131072;
constexpr int LDSCTL_OFF = RING_BYTES, MISC_OFF = LDSCTL_OFF + 320;
constexpr int EDGE_OFF = LDSCTL_OFF + 2048;
constexpr int LDS_BYTES = 147456;
static_assert(MISC_OFF + 128 <= LDS_BYTES && att::ATTN_LDS_BYTES <= RING_BYTES, "LDS map");

struct Args { const float* in[32]; float* out; unsigned char* ws; int ph_lo, ph_hi; };
static_assert(sizeof(Args) == 34 * 8 + 8, "Args has no padding");
struct Frame {
    LAS unsigned char* lds;
    volatile LAS unsigned* MISC;
    int tid, lane, wave;
    int vcu, G;
    float* out;
    unsigned char* ws;
};
__device__ __forceinline__ float shfl_xor_l(float v, int mask, int lane) { return __int_as_float(__builtin_amdgcn_ds_bpermute((lane ^ mask) << 2, __float_as_int(v))); }
__device__ __forceinline__ float wave_sum(float v, int lane) {
#pragma unroll
    for (int o = 1; o < 64; o <<= 1) v += shfl_xor_l(v, o, lane);
    return v;
}
__device__ __forceinline__ int mod_of_row(int m) { return m < MCTX ? 0 : 1 + ((m - MCTX) >> 10); }
__device__ __forceinline__ int kv_row(int m) { return m < MCTX ? m : MCTX + ((m - MCTX) >> 10) * 1280 + 256 + ((m - MCTX) & 1023); }

__device__ __forceinline__ void p0_transpose_item(const float* W, int K, int N, bf16* WT, int row_off, LAS float* scr, int item, int lane, int ldw = 0) {
    if (ldw == 0) ldw = K;
    const int nblk = N / 32; int kb = item / nblk, nb = item % nblk;
#ifndef MK_TRMAP
#define MK_TRMAP 1
#endif
    if (MK_TRMAP == 1 && ((K / 64) & 3) == 0) {
        const int g = item >> 3, w = item & 7, gn = nblk >> 1, kg = g / gn, ng = g - kg * gn; kb = 4 * kg + (w >> 1); nb = 2 * ng + (w & 1); }
    if (MK_TRMAP == 2 && ((K / 64) & 7) == 0) {
        const int g = item >> 3, w = item & 7, kg = g / nblk, ng = g - kg * nblk; kb = 8 * kg + w; nb = ng; }
    const int k0 = 64 * kb, n0 = 32 * nb;
    float wv[32];
#pragma unroll
    for (int i = 0; i < 32; ++i) wv[i] = *(const GAS float*)(W + (size_t)(k0 + 2 * i + (lane >> 5)) * N + n0 + (lane & 31));
#pragma unroll
    for (int i = 0; i < 32; ++i) scr[(2 * i + (lane >> 5)) * 33 + (lane & 31)] = wv[i];
    LDS_WAIT(); asm volatile("" ::: "memory");
    const int c = lane & 7;
#pragma unroll
    for (int j = 0; j < 4; ++j) { const int n = (lane >> 3) + 8 * j; const LAS float* s = scr + (8 * c) * 33 + n;
        v4u o; o.x = pk2(s[0 * 33], s[1 * 33]); o.y = pk2(s[2 * 33], s[3 * 33]); o.z = pk2(s[4 * 33], s[5 * 33]); o.w = pk2(s[6 * 33], s[7 * 33]);
        *(GAS v4u*)(WT + (size_t)(row_off + n0 + n) * ldw + k0 + 8 * c) = o; }
    LDS_WAIT(); asm volatile("" ::: "memory");
}

__device__ __forceinline__ void ada_task(Frame& F, const Args& A, int task) {
    constexpr int CW = 192;
    const int layer = task >> 6, cchunk = task & 63, al = F.lane < 48 ? F.lane : 47;
    LAS float* S = (LAS float*)(F.lds + RING_OFF);
    const float* c_ctx = A.in[6]; const float* cc = A.in[5];
    { f32x4 cv[NMOD];
#pragma unroll
        for (int q = 0; q < NMOD; ++q) cv[q] = *(const GAS f32x4*)((q == 0 ? c_ctx : cc + (q - 1) * D) + 4 * F.tid);
#pragma unroll
        for (int q = 0; q < NMOD; ++q)
#pragma unroll
            for (int i = 0; i < 4; ++i) { const float v = cv[q][i]; S[(4 * F.tid + i) * 12 + q] = v / (1.0f + __expf(-v)); } }
    __syncthreads();
    f32x4 acc[NMOD];
#pragma unroll
    for (int q = 0; q < NMOD; ++q) acc[q] = (f32x4){0.f, 0.f, 0.f, 0.f};
    const int k0 = F.wave * 256;
    const float* wp = A.in[10] + ((size_t)layer * D + k0) * ADA_N + cchunk * CW + al * 4;
    for (int kk = 0; kk < 256; kk += 8) {
        f32x4 w[8];
#pragma unroll
        for (int i = 0; i < 8; ++i) w[i] = *(const GAS f32x4*)(wp + (size_t)(kk + i) * ADA_N);
#pragma unroll
        for (int i = 0; i < 8; ++i) { const LAS f32x4* sp = (const LAS f32x4*)(S + (k0 + kk + i) * 12); const f32x4 s0 = sp[0], s1 = sp[1], s2 = sp[2];
            acc[0] += s0.x * w[i]; acc[1] += s0.y * w[i]; acc[2] += s0.z * w[i]; acc[3] += s0.w * w[i];
            acc[4] += s1.x * w[i]; acc[5] += s1.y * w[i]; acc[6] += s1.z * w[i]; acc[7] += s1.w * w[i]; acc[8] += s2.x * w[i]; }
    }
    __syncthreads();
    LAS float* R = (LAS float*)(F.lds + RING_OFF);
    if (F.lane < 48) {
#pragma unroll
        for (int q = 0; q < NMOD; ++q) *(LAS f32x4*)(R + (F.wave * NMOD + q) * CW + F.lane * 4) = acc[q]; }
    __syncthreads();
    float* mods = (float*)(F.ws + WS_MODS); const float* b_ada = A.in[11];
    for (int idx = F.tid; idx < NMOD * CW; idx += NWAVES * 64) { const int q = idx / CW, cl = idx % CW; float s = b_ada[layer * ADA_N + cchunk * CW + cl];
#pragma unroll
        for (int w = 0; w < NWAVES; ++w) s += R[(w * NMOD + q) * CW + cl];
        mods[(size_t)(layer * NMOD + q) * ADA_N + cchunk * CW + cl] = s; }
    __syncthreads();
}
__device__ __forceinline__ void p0_prologue(Frame& F, const Args& A) {
#ifndef MK_P0A
#define MK_P0A 1
#endif
#ifndef MK_P0T
#define MK_P0T 1
#endif
    for (int ra = 0; ra < MK_P0A; ++ra) if (F.vcu < 256) ada_task(F, A, F.vcu);
    LAS float* scr = (LAS float*)(F.lds + RING_OFF + F.wave * 16384);
    const int gw = F.vcu * NWAVES + F.wave, NGW = F.G * NWAVES;
    bf16* ws16 = (bf16*)F.ws;
    constexpr int I_IN = (D / 64) * (NIN / 32), I_UQ = (QL / 64) * (NQ / 32), I_UK = (KVL / 64) * (D / 32), I_O = (D / 64) * (D / 32), I_RIN = (D / 64) * (2 * D / 32), I_G = 2 * 16 * 8, I_UP = (D / 64) * (NUP / 32), I_DN = (DFF / 64) * (D / 32);
    constexpr int PER_J = I_IN + I_UQ + 2 * I_UK + I_O + I_RIN + I_O + 2 * I_G;
    constexpr int NITEMS = 2 * PER_J + 4 * (I_UP + I_DN);
    for (int rt = 0; rt < MK_P0T; ++rt)
    for (int it = gw; it < NITEMS; it += NGW) {
        int r = it;
        if (r < 2 * PER_J) {
            const int j = r / PER_J; r -= j * PER_J;
            if (r < I_IN) { p0_transpose_item(A.in[12] + (size_t)j * D * NIN, D, NIN, (bf16*)(F.ws + WS_WIN) + (size_t)j * NINP * D, 0, scr, r, F.lane); continue; } r -= I_IN;
            if (r < I_UQ) { p0_transpose_item(A.in[15] + (size_t)j * QL * NQ, QL, NQ, (bf16*)(F.ws + WS_WUQ) + (size_t)j * NQ * QL, 0, scr, r, F.lane); continue; } r -= I_UQ;
            if (r < I_UK) { p0_transpose_item(A.in[16] + (size_t)j * KVL * D, KVL, D, (bf16*)(F.ws + WS_WUKV) + (size_t)j * NKV * KVL, 0, scr, r, F.lane); continue; } r -= I_UK;
            if (r < I_UK) { p0_transpose_item(A.in[17] + (size_t)j * KVL * D, KVL, D, (bf16*)(F.ws + WS_WUKV) + (size_t)j * NKV * KVL, D, scr, r, F.lane); continue; } r -= I_UK;
            if (r < I_O) { p0_transpose_item(A.in[18] + (size_t)j * D * D, D, D, (bf16*)(F.ws + WS_WO) + (size_t)j * D * D, 0, scr, r, F.lane); continue; } r -= I_O;
            if (r < I_RIN) { p0_transpose_item(A.in[19] + (size_t)j * D * 2 * D, D, 2 * D, (bf16*)(F.ws + WS_WRIN) + (size_t)j * 2 * D * D, 0, scr, r, F.lane); continue; } r -= I_RIN;
            if (r < I_O) { p0_transpose_item(A.in[27] + (size_t)j * D * D, D, D, (bf16*)(F.ws + WS_WROUT) + (size_t)j * D * D, 0, scr, r, F.lane); continue; } r -= I_O;
            { const int gate = r / I_G; r -= gate * I_G; const int mat = r >> 3, sub = r & 7, dir = mat >> 4, blk = mat & 15;
              p0_transpose_item(A.in[gate ? 24 : 22] + ((size_t)j * 32 + mat) * 128 * 128, 128, 128, (bf16*)(F.ws + WS_WG) + (size_t)j * 8192 * 128, blk * 512 + dir * 256 + gate * 128, scr, sub, F.lane); continue; }
        }
        r -= 2 * PER_J;
        { const int l = r / (I_UP + I_DN); r -= l * (I_UP + I_DN);
          if (r < I_UP) { p0_transpose_item(A.in[28] + (size_t)l * D * NUP, D, NUP, (bf16*)(F.ws + WS_WUP) + (size_t)l * NUP * D, 0, scr, r, F.lane); continue; } r -= I_UP;
          p0_transpose_item(A.in[31] + (size_t)l * DFF * D, DFF, D, (bf16*)(F.ws + WS_WDN) + (size_t)l * D * ALD, 0, scr, r, F.lane, ALD); }
    }
    (void)ws16;
    const int gt = F.vcu * NWAVES * 64 + F.tid, NGT = F.G * NWAVES * 64;
    for (int i = gt; i < 2 * (NINP - NIN) * D / 8; i += NGT) { const int j = i / ((NINP - NIN) * D / 8), o = i % ((NINP - NIN) * D / 8);
        *(GAS v4u*)((bf16*)(F.ws + WS_WIN) + ((size_t)j * NINP + NIN) * D + (size_t)o * 8) = (v4u){0u, 0u, 0u, 0u}; }
    for (int i = gt; i < 1024 * 32; i += NGT) { const int pos = i >> 5, a = i & 31; const float inv = exp2f(-(float)(2 * (a & 15)) * (13.287712379549449f / 32.0f));
        const float ang = (float)((a < 16) ? (pos >> 6) : (pos & 63)) * inv; float sn, cs; sincosf(ang, &sn, &cs);
        ((float*)(F.ws + WS_COS))[i] = cs; ((float*)(F.ws + WS_SIN))[i] = sn; }
    for (int i = gt; i < 2 * 2 * D; i += NGT) { const float lam = A.in[26][i]; ((float*)(F.ws + WS_SP))[i] = 8.0f * 1.4426950408889634f * log1pf(expf(-lam)); }
}

template <int MODE>
__device__ __forceinline__ void norm_phase(Frame& F, const Args& A, const float* g, const float* modbase  , int shift_idx  ) {
    const int gw = F.vcu * NWAVES + F.wave, NGW = F.G * NWAVES;
    bf16* X = (bf16*)(F.ws + WS_X); bf16* H = (bf16*)(F.ws + WS_H);
    for (int blk = gw; blk < NTOK / 8; blk += NGW) {
        const int m0 = blk * 8;
        f32x4 gs[4][2], sh[4][2];
        if (MODE == 2) {
#pragma unroll
            for (int j = 0; j < 4; ++j)
#pragma unroll
                for (int h = 0; h < 2; ++h) gs[j][h] = *(const GAS f32x4*)(g + 8 * (F.lane + 64 * j) + 4 * h);
        } else { const float* mb = modbase + (size_t)mod_of_row(m0) * ADA_N + (size_t)shift_idx * D;
#pragma unroll
            for (int j = 0; j < 4; ++j)
#pragma unroll
                for (int h = 0; h < 2; ++h) { const int c = 8 * (F.lane + 64 * j) + 4 * h; gs[j][h] = *(const GAS f32x4*)(g + c) * (*(const GAS f32x4*)(mb + D + c) + 1.0f); sh[j][h] = *(const GAS f32x4*)(mb + c); } }
        f32x4 nx[4][2]; v4u nb[4];
#define NORM_LOAD(m) do { if (MODE == 0) { const float* src_ = (m) < MCTX ? A.in[0] + (size_t)(m) * D : A.in[1] + (size_t)((m) - MCTX) * D; \
            _Pragma("unroll") for (int j = 0; j < 4; ++j) { const GAS f32x4* p = (const GAS f32x4*)(src_ + 8 * (F.lane + 64 * j)); nx[j][0] = p[0]; nx[j][1] = p[1]; } } \
        else { _Pragma("unroll") for (int j = 0; j < 4; ++j) nb[j] = *(const GAS v4u*)(X + (size_t)(m) * D + 8 * (F.lane + 64 * j)); } } while (0)
        NORM_LOAD(m0);
#pragma unroll 1
        for (int r = 0; r < 8; ++r) { const int m = m0 + r;
            f32x4 v[4][2];
            if (MODE == 0) {
#pragma unroll
                for (int j = 0; j < 4; ++j) { v[j][0] = nx[j][0]; v[j][1] = nx[j][1]; }
            } else {
#pragma unroll
                for (int j = 0; j < 4; ++j) { const v4u w = nb[j];
                    v[j][0] = (f32x4){pg8::bf_lo(w.x), pg8::bf_hi(w.x), pg8::bf_lo(w.y), pg8::bf_hi(w.y)}; v[j][1] = (f32x4){pg8::bf_lo(w.z), pg8::bf_hi(w.z), pg8::bf_lo(w.w), pg8::bf_hi(w.w)}; } }
            if (r < 7) NORM_LOAD(m + 1);
            if (MODE == 0) {
#pragma unroll
                for (int j = 0; j < 4; ++j) *(GAS v4u*)(X + (size_t)m * D + 8 * (F.lane + 64 * j)) = (v4u){pk2(v[j][0].x, v[j][0].y), pk2(v[j][0].z, v[j][0].w), pk2(v[j][1].x, v[j][1].y), pk2(v[j][1].z, v[j][1].w)}; }
            float s = 0.f;
#pragma unroll
            for (int j = 0; j < 4; ++j)
#pragma unroll
                for (int h = 0; h < 2; ++h) s += (v[j][h].x * v[j][h].x + v[j][h].y * v[j][h].y) + (v[j][h].z * v[j][h].z + v[j][h].w * v[j][h].w);
            const float rstd = 1.0f / sqrtf(wave_sum(s, F.lane) * (1.0f / D) + NORM_EPS);
            if (MODE == 2) { float* yo = F.out + OUT_Y + (size_t)m * D;
#pragma unroll
                for (int j = 0; j < 4; ++j)
#pragma unroll
                    for (int h = 0; h < 2; ++h) *(GAS f32x4*)(yo + 8 * (F.lane + 64 * j) + 4 * h) = v[j][h] * rstd * gs[j][h];
            } else {
#pragma unroll
                for (int j = 0; j < 4; ++j) { const f32x4 h0 = v[j][0] * rstd * gs[j][0] + sh[j][0], h1 = v[j][1] * rstd * gs[j][1] + sh[j][1];
                    *(GAS v4u*)(H + (size_t)m * D + 8 * (F.lane + 64 * j)) = (v4u){pk2(h0.x, h0.y), pk2(h0.z, h0.w), pk2(h1.x, h1.y), pk2(h1.z, h1.w)}; }
            }
        }
#undef NORM_LOAD
    }
}

__device__ __forceinline__ void mla_mid_phase(Frame& F, const Args& A, int j) {
    const int gw = F.vcu * NWAVES + F.wave, NGW = F.G * NWAVES, lane = F.lane;
    const float* PROJ = (const float*)(F.ws + WS_PROJ); bf16* CQ = (bf16*)(F.ws + WS_CQ); bf16* CKV = (bf16*)(F.ws + WS_CKV); bf16* KR = (bf16*)(F.ws + WS_KR);
    const float* gq = A.in[13] + j * QL; const float* gkv = A.in[14] + j * KVL;
    const float* cosT = (const float*)(F.ws + WS_COS); const float* sinT = (const float*)(F.ws + WS_SIN);
    const f32x4 gq0 = *(const GAS f32x4*)(gq + 8 * lane), gq1 = *(const GAS f32x4*)(gq + 8 * lane + 4), gk0 = *(const GAS f32x4*)(gkv + 8 * lane), gk1 = *(const GAS f32x4*)(gkv + 8 * lane + 4);
    for (int m = gw; m < NTOK; m += NGW) {
        const float* pr = PROJ + (size_t)m * NINP;
        const f32x4 q0 = *(const GAS f32x4*)(pr + 8 * lane), q1 = *(const GAS f32x4*)(pr + 8 * lane + 4), k0 = *(const GAS f32x4*)(pr + QL + 8 * lane), k1 = *(const GAS f32x4*)(pr + QL + 8 * lane + 4);
        const float* pk = (const float*)(F.ws + WS_PKR) + (size_t)m * ROPE + lane;
        const float kr = (pk[0] + pk[(size_t)NTOK * ROPE]) + (pk[2ull * NTOK * ROPE] + pk[3ull * NTOK * ROPE]);
        const float sq = wave_sum((q0.x * q0.x + q0.y * q0.y) + (q0.z * q0.z + q0.w * q0.w) + (q1.x * q1.x + q1.y * q1.y) + (q1.z * q1.z + q1.w * q1.w), lane);
        const float sk = wave_sum((k0.x * k0.x + k0.y * k0.y) + (k0.z * k0.z + k0.w * k0.w) + (k1.x * k1.x + k1.y * k1.y) + (k1.z * k1.z + k1.w * k1.w), lane);
        const float rq = 1.0f / sqrtf(sq * (1.0f / QL) + NORM_EPS), rk = 1.0f / sqrtf(sk * (1.0f / KVL) + NORM_EPS);
        const f32x4 a0 = q0 * rq * gq0, a1 = q1 * rq * gq1, c0 = k0 * rk * gk0, c1 = k1 * rk * gk1;
        *(GAS v4u*)(CQ + (size_t)m * QL + 8 * lane) = (v4u){pk2(a0.x, a0.y), pk2(a0.z, a0.w), pk2(a1.x, a1.y), pk2(a1.z, a1.w)};
        const int kvr = kv_row(m);
        *(GAS v4u*)(CKV + (size_t)kvr * KVL + 8 * lane) = (v4u){pk2(c0.x, c0.y), pk2(c0.z, c0.w), pk2(c1.x, c1.y), pk2(c1.z, c1.w)};
        float krv = kr;
        if (m < MCTX) {
            const int b = m >> 8, t = m & 255; float* oc = F.out + OUT_CKV + ((size_t)(b * 2 + j) * 256 + t) * KVL + 8 * lane;
            *(GAS f32x4*)oc = c0; *(GAS f32x4*)(oc + 4) = c1;
            F.out[OUT_KR + ((size_t)(b * 2 + j) * 256 + t) * ROPE + lane] = kr;
        } else {
            const int pos = (m - MCTX) & 1023, ai = (lane & 15) + 16 * (lane >> 5); const float cs = cosT[pos * 32 + ai], sn = sinT[pos * 32 + ai];
            const float other = shfl_xor_l(kr, 16, lane);
            krv = (lane & 16) ? (kr * cs + other * sn) : (kr * cs - other * sn);
        }
        KR[(size_t)kvr * ROPE + lane] = (bf16)f2bf(krv);
    }
    for (int i = gw; i < 8 * 256; i += NGW) { const int b = i >> 8, t = i & 255; const size_t dst = (size_t)MCTX + 1280 * b + t;
        const float* sc = A.in[2] + ((size_t)(b * 2 + j) * 256 + t) * KVL + 8 * lane; const f32x4 c0 = *(const GAS f32x4*)sc, c1 = *(const GAS f32x4*)(sc + 4);
        *(GAS v4u*)(CKV + dst * KVL + 8 * lane) = (v4u){pk2(c0.x, c0.y), pk2(c0.z, c0.w), pk2(c1.x, c1.y), pk2(c1.z, c1.w)};
        KR[dst * ROPE + lane] = (bf16)f2bf(A.in[3][((size_t)(b * 2 + j) * 256 + t) * ROPE + lane]); }
}

__device__ __forceinline__ void attn_phase(Frame& F, char* lds) {
    const att::bf16* Q = (const att::bf16*)(F.ws + WS_Q); const att::bf16* KN = (const att::bf16*)(F.ws + WS_KN); const att::bf16* KR = (const att::bf16*)(F.ws + WS_KR);
    const att::bf16* V = (const att::bf16*)(F.ws + WS_V); att::bf16* O = (att::bf16*)(F.ws + WS_O);
    for (int i = 0; i < 4; ++i) {
        int qrow, krow, h, seq;
        if (i < 2) { const int id = F.vcu * 2 + i, b = id >> 6, rem = id & 63, qb = rem & 3; h = rem >> 2; qrow = MCTX + b * 1024 + qb * 256; krow = MCTX + b * 1280; seq = 1280; }
        else { const int id = F.vcu * 2 + (i - 2), s = id >> 4; h = id & 15; qrow = s * 256; krow = s * 256; seq = 256; }
        __syncthreads();
        att::attn_unit(Q + (size_t)qrow * NQ + h * QKD, KN + (size_t)krow * D + h * NOPE, KR + (size_t)krow * ROPE, V + (size_t)krow * D + h * VD, O + (size_t)qrow * D + h * VD, seq, lds, lds + RING_BYTES + 2048, F.wave);
    }
}

__device__ __forceinline__ void conv4_phase(Frame& F, const Args& A, int j) {
    const int gw = F.vcu * NWAVES + F.wave, NGW = F.G * NWAVES, lane = F.lane;
    const bf16* RIN = (const bf16*)(F.ws + WS_RIN); bf16* XC = (bf16*)(F.ws + WS_XC);
    const float* wc = A.in[20] + (size_t)j * 4 * D; const float* bc = A.in[21] + (size_t)j * D;
    for (int task = gw; task < (NTOK / 32) * 4; task += NGW) {
        const int cg = task & 3, chunk = task >> 2, c0 = cg * 512 + lane * 8;
        float w[4][8], bb[8];
#pragma unroll
        for (int t = 0; t < 4; ++t) { const f32x4 a = *(const GAS f32x4*)(wc + t * D + c0), b = *(const GAS f32x4*)(wc + t * D + c0 + 4); w[t][0] = a.x; w[t][1] = a.y; w[t][2] = a.z; w[t][3] = a.w; w[t][4] = b.x; w[t][5] = b.y; w[t][6] = b.z; w[t][7] = b.w; }
        { const f32x4 a = *(const GAS f32x4*)(bc + c0), b = *(const GAS f32x4*)(bc + c0 + 4); bb[0] = a.x; bb[1] = a.y; bb[2] = a.z; bb[3] = a.w; bb[4] = b.x; bb[5] = b.y; bb[6] = b.z; bb[7] = b.w; }
#pragma unroll 1
        for (int half = 0; half < 2; ++half) {
        const int r0 = chunk * 32 + half * 16;
        const int slen = r0 < MCTX ? 256 : 1024, sbeg = r0 < MCTX ? (r0 & ~255) : MCTX + ((r0 - MCTX) & ~1023), send = sbeg + slen;
        v4u raw[19];
#pragma unroll
        for (int i = 0; i < 19; ++i) { const int r = r0 - 2 + i; raw[i] = (r >= sbeg && r < send) ? *(const GAS v4u*)(RIN + (size_t)r * (2 * D) + D + c0) : (v4u){0u, 0u, 0u, 0u}; }
#pragma unroll
        for (int t = 0; t < 16; ++t) {
            float o[8];
#pragma unroll
            for (int c = 0; c < 8; ++c) o[c] = bb[c];
#pragma unroll
            for (int jj = 0; jj < 4; ++jj) { const v4u x = raw[t + jj];
                o[0] += w[jj][0] * pg8::bf_lo(x.x); o[1] += w[jj][1] * pg8::bf_hi(x.x); o[2] += w[jj][2] * pg8::bf_lo(x.y); o[3] += w[jj][3] * pg8::bf_hi(x.y);
                o[4] += w[jj][4] * pg8::bf_lo(x.z); o[5] += w[jj][5] * pg8::bf_hi(x.z); o[6] += w[jj][6] * pg8::bf_lo(x.w); o[7] += w[jj][7] * pg8::bf_hi(x.w); }
            *(GAS v4u*)(XC + (size_t)(r0 + t) * D + c0) = (v4u){pk2(o[0], o[1]), pk2(o[2], o[3]), pk2(o[4], o[5]), pk2(o[6], o[7])};
        }
        }
    }
}

typedef float sf2 __attribute__((ext_vector_type(2)));
__device__ __forceinline__ sf2 bf2_to_f2(unsigned w) { return (sf2){__uint_as_float(w << 16), __uint_as_float(w & 0xffff0000u)}; }
__device__ __forceinline__ void scan_phase(Frame& F, const Args& A, int j) {
    const int lane = F.lane, wave = F.wave;
    LAS float* aggb = (LAS float*)(F.lds + RING_OFF);
    LAS float* carb = aggb + 2 * 8 * 128 * 2;
    const int nunits = F.vcu < 128 ? 1 : 4; int pass = 0;
    for (int ui = 0; ui < nunits; ++ui) {
        int row0, nsub, cg, bidx; bool ctx;
        if (F.vcu < 128) { const int id = F.vcu; bidx = id >> 4; cg = id & 15; row0 = MCTX + bidx * 1024; nsub = 4; ctx = false; }
        else { const int id = (F.vcu - 128) * 4 + ui; bidx = id >> 4; cg = id & 15; row0 = bidx * 256; nsub = 1; ctx = true; }
        const int ch = cg * 128 + lane * 2;
        const bf16* LAf = (const bf16*)(F.ws + WS_LA) + ch; const bf16* LAb = LAf + (size_t)NTOK * D;
        const bf16* UUf = (const bf16*)(F.ws + WS_UU) + ch; const bf16* UUb = UUf + (size_t)NTOK * D;
        bf16* HB = (bf16*)(F.ws + WS_HB) + ch; const bf16* GY = (const bf16*)(F.ws + WS_RIN) + ch; bf16* MIX = (bf16*)(F.ws + WS_MIX) + ch;
        sf2 hf0 = (sf2){0.f, 0.f}, hb0 = (sf2){0.f, 0.f};
        if (!ctx) { const float* st = A.in[4] + ((size_t)(bidx * 2 + j) * 2) * D + ch; hf0 = *(const GAS sf2*)st; hb0 = *(const GAS sf2*)(st + D); }
        for (int sb = nsub - 1; sb >= 0; --sb, ++pass) {
            const size_t r0 = (size_t)(row0 + sb * 256 + wave * 32);
            unsigned L[32], U[32];
#pragma unroll
            for (int i = 0; i < 32; ++i) { L[i] = *(const GAS unsigned*)(LAb + (r0 + 31 - i) * D); U[i] = *(const GAS unsigned*)(UUb + (r0 + 31 - i) * D); }
            sf2 sl = (sf2){0.f, 0.f}, hl = (sf2){0.f, 0.f};
#pragma unroll
            for (int i = 0; i < 32; ++i) { const sf2 l = bf2_to_f2(L[i]), u = bf2_to_f2(U[i]); sl += l; hl.x = __builtin_amdgcn_exp2f(l.x) * hl.x + u.x; hl.y = __builtin_amdgcn_exp2f(l.y) * hl.y + u.y; }
            LAS float* ag = aggb + (((pass & 1) * 8 + wave) * 128 + lane * 2) * 2;
            *(LAS f32x4*)ag = (f32x4){__builtin_amdgcn_exp2f(sl.x), hl.x, __builtin_amdgcn_exp2f(sl.y), hl.y};
            __syncthreads();
            sf2 h = hb0; if (sb != nsub - 1) h = *(const LAS sf2*)(carb + (pass & 1) * 128 + lane * 2);
            for (int c = 7; c > wave; --c) { const f32x4 q = *(const LAS f32x4*)(aggb + (((pass & 1) * 8 + c) * 128 + lane * 2) * 2); h.x = q.x * h.x + q.y; h.y = q.z * h.y + q.w; }
#pragma unroll
            for (int i = 0; i < 32; ++i) { const sf2 l = bf2_to_f2(L[i]), u = bf2_to_f2(U[i]); h.x = __builtin_amdgcn_exp2f(l.x) * h.x + u.x; h.y = __builtin_amdgcn_exp2f(l.y) * h.y + u.y;
                *(GAS unsigned*)(HB + (r0 + 31 - i) * D) = pk2(h.x, h.y); }
            if (wave == 0) { *(LAS sf2*)(carb + ((pass + 1) & 1) * 128 + lane * 2) = h;
                if (ctx) *(GAS sf2*)(F.out + OUT_ST + ((size_t)(bidx * 2 + j) * 2 + 1) * D + ch) = h; }
        }
        for (int sb = 0; sb < nsub; ++sb, ++pass) {
            const size_t r0 = (size_t)(row0 + sb * 256 + wave * 32);
            unsigned L[32], U[32], G[32], Hh[32];
#pragma unroll
            for (int i = 0; i < 32; ++i) { L[i] = *(const GAS unsigned*)(LAf + (r0 + i) * D); U[i] = *(const GAS unsigned*)(UUf + (r0 + i) * D); }
#pragma unroll
            for (int i = 0; i < 32; ++i) { G[i] = *(const GAS unsigned*)(GY + (r0 + i) * (2 * D)); Hh[i] = *(const GAS unsigned*)(HB + (r0 + i) * D); }
            sf2 sl = (sf2){0.f, 0.f}, hl = (sf2){0.f, 0.f};
#pragma unroll
            for (int i = 0; i < 32; ++i) { const sf2 l = bf2_to_f2(L[i]), u = bf2_to_f2(U[i]); sl += l; hl.x = __builtin_amdgcn_exp2f(l.x) * hl.x + u.x; hl.y = __builtin_amdgcn_exp2f(l.y) * hl.y + u.y; }
            LAS float* ag = aggb + (((pass & 1) * 8 + wave) * 128 + lane * 2) * 2;
            *(LAS f32x4*)ag = (f32x4){__builtin_amdgcn_exp2f(sl.x), hl.x, __builtin_amdgcn_exp2f(sl.y), hl.y};
            __syncthreads();
            sf2 h = hf0; if (sb != 0) h = *(const LAS sf2*)(carb + (pass & 1) * 128 + lane * 2);
            for (int c = 0; c < wave; ++c) { const f32x4 q = *(const LAS f32x4*)(aggb + (((pass & 1) * 8 + c) * 128 + lane * 2) * 2); h.x = q.x * h.x + q.y; h.y = q.z * h.y + q.w; }
#pragma unroll
            for (int i = 0; i < 32; ++i) { const sf2 l = bf2_to_f2(L[i]), u = bf2_to_f2(U[i]), gy = bf2_to_f2(G[i]), hbv = bf2_to_f2(Hh[i]);
                h.x = __builtin_amdgcn_exp2f(l.x) * h.x + u.x; h.y = __builtin_amdgcn_exp2f(l.y) * h.y + u.y;
                *(GAS unsigned*)(MIX + (r0 + i) * D) = pk2((h.x + hbv.x) * gy.x, (h.y + hbv.y) * gy.y); }
            if (wave == 7) { *(LAS sf2*)(carb + ((pass + 1) & 1) * 128 + lane * 2) = h;
                if (ctx) *(GAS sf2*)(F.out + OUT_ST + ((size_t)(bidx * 2 + j) * 2 + 0) * D + ch) = h; }
        }
    }
    __syncthreads();
}


typedef unsigned v2u __attribute__((ext_vector_type(2)));
#define RS_BAR() do { asm volatile("s_waitcnt lgkmcnt(0)" ::: "memory"); __builtin_amdgcn_s_barrier(); asm volatile("" ::: "memory"); } while (0)
__device__ __forceinline__ void rs_phase(Frame& F, const Args& A, int j, int wave0) {
    const int nunits = F.vcu < 128 ? 1 : 4; int pass = 0;
    const pg8::Gemm g = pg8::mk_gemm((const pg8::bf16_t*)(F.ws + WS_XC), (const pg8::bf16_t*)(F.ws + WS_WG) + (size_t)j * 8192 * 128, 128, D);
    const pg8::EpiGatesLds E{(const pg8::bf16_t*)(F.ws + WS_XC), A.in[23] + (size_t)j * 2 * D, A.in[25] + (size_t)j * 2 * D, (const float*)(F.ws + WS_SP) + (size_t)j * 2 * D, (LAS float*)(F.lds + EDGE_OFF)};
    const bool lat = F.vcu < 128; const int nsub = lat ? 4 : 1, npass = 8;
    auto pass_unit = [&](int p, pg8::Unit& u) { const int ui = lat ? 0 : (p >> 1), q = lat ? p : (p & 1), sweep = q / nsub, si = q - sweep * nsub, sb = sweep ? si : nsub - 1 - si;
        const int id = lat ? F.vcu : (F.vcu - 128) * 4 + ui, bidx = id >> 4, cg = id & 15, row0 = lat ? MCTX + bidx * 1024 : bidx * 256;
        u.pm = (row0 >> 8) + sb; u.pn = 2 * cg + (sweep ? 0 : 1); };
    pg8::Unit ucur; pass_unit(0, ucur);
    f32x4 pf; { int tq = wave0 * 64 + lane_now(); asm volatile("" : "+v"(tq)); pf = E.pre(ucur, tq); }
    pg8::gate_stage(F.lds + RING_OFF, g, ucur.pm, ucur.pn, wave0);
    (void)nunits;
#pragma unroll 1
    for (int p = 0; p < npass; ++p, ++pass) {
        const int ui = lat ? 0 : (p >> 1), q = lat ? p : (p & 1), sweep = q / nsub, si = q - sweep * nsub, sb = sweep ? si : nsub - 1 - si;
        const int id = lat ? F.vcu : (F.vcu - 128) * 4 + ui, bidx = id >> 4, cg = id & 15, row0 = lat ? MCTX + bidx * 1024 : bidx * 256; const bool ctx = !lat;
        if (p == 0 || (sweep && si == 0)) asm volatile("s_waitcnt vmcnt(0)" ::: "memory"); else asm volatile("s_waitcnt vmcnt(32)" ::: "memory");
        RS_BAR();
        { int t_ = wave0 * 64 + lane_now(); asm volatile("" : "+v"(t_)); F.tid = t_; F.lane = t_ & 63; F.wave = __builtin_amdgcn_readfirstlane(t_ >> 6); }
        { f32x4 acc[2][2][4][2]; const int wr = F.wave >> 2, wc = F.wave & 3, fr = F.lane & 15, fq = F.lane >> 4;
          pg8::gate_compute(F.lds + RING_OFF, acc, wr, wc, fr, fq);
          RS_BAR();
          E.fused(acc, ucur, wr, wc, fr, fq, F.lds + RING_OFF, pf); }
        RS_BAR();
        const int lane = F.lane, wave = F.wave;
        LAS float* aggb = (LAS float*)(F.lds + EDGE_OFF + 2048);
        LAS float* carb = aggb + 8 * 128 * 2;
        const LAS unsigned char* img = F.lds + RING_OFF;
        const int ch = cg * 128 + lane * 2;
        bf16* HB = (bf16*)(F.ws + WS_HB) + ch; const bf16* GY = (const bf16*)(F.ws + WS_RIN) + ch; bf16* MIX = (bf16*)(F.ws + WS_MIX) + ch;
        const size_t r0 = (size_t)(row0 + sb * 256 + wave * 32);
        unsigned W0[32], W1[32];
#pragma unroll
        for (int i = 0; i < 32; ++i) { const int rl = wave * 32 + (sweep ? i : 31 - i);
            const v2u w = *(const LAS v2u*)(img + rl * 512 + (((lane >> 1) ^ (rl & 31)) << 4) + ((lane & 1) << 3)); W0[i] = w.x; W1[i] = w.y; }
        RS_BAR();
        if (p + 1 < npass) { pass_unit(p + 1, ucur); { int tq = wave0 * 64 + lane_now(); asm volatile("" : "+v"(tq)); pf = E.pre(ucur, tq); }
            pg8::gate_stage(F.lds + RING_OFF, g, ucur.pm, ucur.pn, wave0); }
        unsigned G[32], Hh[32];
#pragma unroll
        for (int i = 0; i < 32; ++i) { G[i] = 0u; Hh[i] = 0u; }
        if (sweep) {
#pragma unroll
            for (int i = 0; i < 32; ++i) { G[i] = *(const GAS unsigned*)(GY + (r0 + i) * (2 * D)); Hh[i] = *(const GAS unsigned*)(HB + (r0 + i) * D); } }
        sf2 sl = (sf2){0.f, 0.f}, hl = (sf2){0.f, 0.f}; float A0[32], A1[32];
#pragma unroll
        for (int i = 0; i < 32; ++i) { const sf2 l = (sf2){pg8::bf_lo(W0[i]), pg8::bf_lo(W1[i])}, u = (sf2){pg8::bf_hi(W0[i]), pg8::bf_hi(W1[i])};
            sl += l; A0[i] = __builtin_amdgcn_exp2f(l.x); A1[i] = __builtin_amdgcn_exp2f(l.y); hl.x = A0[i] * hl.x + u.x; hl.y = A1[i] * hl.y + u.y; }
        LAS float* ag = aggb + (wave * 128 + lane * 2) * 2;
        *(LAS f32x4*)ag = (f32x4){__builtin_amdgcn_exp2f(sl.x), hl.x, __builtin_amdgcn_exp2f(sl.y), hl.y};
        RS_BAR();
        sf2 h;
        if (si == 0) { h = (sf2){0.f, 0.f};
            if (!ctx) { const float* st = A.in[4] + ((size_t)(bidx * 2 + j) * 2) * D + ch; h = *(const GAS sf2*)(st + (sweep ? 0 : D)); } }
        else h = *(const LAS sf2*)(carb + (pass & 1) * 128 + lane * 2);
        if (sweep == 0) {
            for (int c = 7; c > wave; --c) { const f32x4 qv = *(const LAS f32x4*)(aggb + (c * 128 + lane * 2) * 2); h.x = qv.x * h.x + qv.y; h.y = qv.z * h.y + qv.w; }
#pragma unroll
            for (int i = 0; i < 32; ++i) { const sf2 u = (sf2){pg8::bf_hi(W0[i]), pg8::bf_hi(W1[i])};
                h.x = A0[i] * h.x + u.x; h.y = A1[i] * h.y + u.y;
                *(GAS unsigned*)(HB + (r0 + 31 - i) * D) = pk2(h.x, h.y); }
            if (wave == 0) { *(LAS sf2*)(carb + ((pass + 1) & 1) * 128 + lane * 2) = h;
                if (ctx) *(GAS sf2*)(F.out + OUT_ST + ((size_t)(bidx * 2 + j) * 2 + 1) * D + ch) = h; }
        } else {
            for (int c = 0; c < wave; ++c) { const f32x4 qv = *(const LAS f32x4*)(aggb + (c * 128 + lane * 2) * 2); h.x = qv.x * h.x + qv.y; h.y = qv.z * h.y + qv.w; }
#pragma unroll
            for (int i = 0; i < 32; ++i) { const sf2 u = (sf2){pg8::bf_hi(W0[i]), pg8::bf_hi(W1[i])}, gy = bf2_to_f2(G[i]), hbv = bf2_to_f2(Hh[i]);
                h.x = A0[i] * h.x + u.x; h.y = A1[i] * h.y + u.y;
                *(GAS unsigned*)(MIX + (r0 + i) * D) = pk2((h.x + hbv.x) * gy.x, (h.y + hbv.y) * gy.y); }
            if (wave == 7) { *(LAS sf2*)(carb + ((pass + 1) & 1) * 128 + lane * 2) = h;
                if (ctx) *(GAS sf2*)(F.out + OUT_ST + ((size_t)(bidx * 2 + j) * 2 + 0) * D + ch) = h; }
        }
    }
    asm volatile("s_waitcnt vmcnt(0)" ::: "memory"); __syncthreads();
}

__device__ __forceinline__ void ffn_fix_panel(Frame& F, const Args& A, int layer, int pm) {
    if (pm < MCTX / 256) return;
    const float* HALO = (const float*)(F.ws + WS_HALO); bf16* ACT = (bf16*)(F.ws + WS_ACT);
    const float* wc = A.in[29] + (size_t)layer * 3 * NUP; const float* bc = A.in[30] + (size_t)layer * NUP;
    const float* hc = HALO + (size_t)pm * 4 * NUP; const int k = (pm - MCTX / 256) & 3;
    const bool top = k != 0, bot = k != 3;
    for (int c4 = F.tid; c4 < DFF / 4; c4 += NWAVES * 64) { const int c0 = c4 * 4; f32x4 vt[2], vb[2];
#pragma unroll
        for (int bj = 0; bj < 2; ++bj) { const int cc = c0 + bj * DFF;
            const f32x4 b = *(const GAS f32x4*)(bc + cc), w0 = *(const GAS f32x4*)(wc + cc), w1 = *(const GAS f32x4*)(wc + NUP + cc), w2 = *(const GAS f32x4*)(wc + 2 * NUP + cc);
            const f32x4 z = (f32x4){0.f, 0.f, 0.f, 0.f};
            const f32x4 t0 = top ? *(const GAS f32x4*)(hc - NUP + cc) : z, t1 = top ? *(const GAS f32x4*)(hc + cc) : z, t2 = top ? *(const GAS f32x4*)(hc + NUP + cc) : z;
            const f32x4 b0 = bot ? *(const GAS f32x4*)(hc + 2 * NUP + cc) : z, b1 = bot ? *(const GAS f32x4*)(hc + 3 * NUP + cc) : z, b2 = bot ? *(const GAS f32x4*)(hc + 4 * NUP + cc) : z;
            vt[bj] = b + w0 * t0 + w1 * t1 + w2 * t2; vb[bj] = b + w0 * b0 + w1 * b1 + w2 * b2; }
        if (top) { float o[4];
#pragma unroll
            for (int j = 0; j < 4; ++j) o[j] = vt[0][j] * pg8::fast_sigmoid(vt[0][j]) * vt[1][j];
            *(GAS unsigned long long*)(ACT + (size_t)pm * 256 * ALD + c0) = (unsigned long long)pk2(o[0], o[1]) | ((unsigned long long)pk2(o[2], o[3]) << 32); }
        if (bot) { float o[4];
#pragma unroll
            for (int j = 0; j < 4; ++j) o[j] = vb[0][j] * pg8::fast_sigmoid(vb[0][j]) * vb[1][j];
            *(GAS unsigned long long*)(ACT + ((size_t)pm * 256 + 255) * ALD + c0) = (unsigned long long)pk2(o[0], o[1]) | ((unsigned long long)pk2(o[2], o[3]) << 32); } }
}

#ifndef MK_PER_PHASE
#define MK_PER_PHASE 0
#endif
#ifndef MK_MASK
#define MK_MASK 0xffffffffu
#endif
#define ON(i) ((MK_MASK >> (i)) & 1u)
#ifndef MK_REP
#define MK_REP 0u
#endif
#define NREP(i) (((MK_REP >> (i)) & 1u) ? 2 : 1)
#ifndef MK_RS
#define MK_RS 1
#endif
#ifndef MK_ALIGN
#define MK_ALIGN true
#endif
#ifndef MK_ALIGN_RES
#define MK_ALIGN_RES MK_ALIGN
#endif
#ifndef MK_ALIGN_G
#define MK_ALIGN_G MK_ALIGN
#endif
#ifndef MK_SP2
#define MK_SP2 true
#endif
#ifndef MK_STOP
#define MK_STOP 1000
#endif
constexpr int NPHASE = 2 + 10 * NLAYER;
#ifndef MK_PROBE
#define MK_PROBE 0
#endif
#ifndef MK_SEL1
#define MK_SEL1 0
#endif
#ifndef MK_SEL2
#define MK_SEL2 1
#endif
#ifndef MK_SCALE2
#define MK_SCALE2 1.0f
#endif
constexpr int STAMP_OFF = LDSCTL_OFF + 1024;

__global__ void __launch_bounds__(NWAVES * 64, 2) mk_fwd(Args args) {
    extern __shared__ __attribute__((aligned(16))) unsigned char lds[];
    Frame F;
    F.lds = (LAS unsigned char*)lds;
    F.MISC = (volatile LAS unsigned*)(F.lds + MISC_OFF);
    F.tid = threadIdx.x; F.lane = F.tid & 63; F.wave = __builtin_amdgcn_readfirstlane(F.tid >> 6);
    const int wave0 = F.wave;
    F.G = gridDim.x; { const int bx = blockIdx.x; F.vcu = (F.G % 8 == 0) ? (bx % 8) * (F.G / 8) + bx / 8 : bx; }
    F.out = args.out; F.ws = args.ws;
    for (int u = F.tid; u < (LDS_BYTES - LDSCTL_OFF) / 4; u += NWAVES * 64) ((LAS unsigned*)(F.lds + LDSCTL_OFF))[u] = 0u;
    __syncthreads();
    const int lo = args.ph_lo, hi = args.ph_hi < MK_STOP ? args.ph_hi : MK_STOP;
    unsigned* barw = (unsigned*)(args.ws + WS_CTL) + CW_BAR;
    XcdBarrier bar; bar.bar = barw; bar.x = 0; bar.st = nullptr;
    if (hi - lo > 1) bar = xcd_barrier_post(barw, F.MISC + 8, F.tid == 0);
#define IN(k) (lo <= (k) && (k) < hi)
#define PHASE_BEGIN() size_t z_ = 0; asm volatile("" : "+s"(z_)); unsigned char* ws = args.ws + z_;     \
    { int t_ = wave0 * 64 + lane_now(); asm volatile("" : "+v"(t_)); F.tid = t_; F.lane = t_ & 63; F.wave = __builtin_amdgcn_readfirstlane(t_ >> 6); F.ws = ws; } \
    const float* mods = (const float*)(ws + WS_MODS); bf16* Hb = (bf16*)(ws + WS_H); bf16* X = (bf16*)(ws + WS_X); (void)mods; (void)Hb; (void)X;
#if MK_PROBE
#define STAMP(i) do { if (blockIdx.x == 0 && threadIdx.x == 0) ((LAS unsigned long long*)(F.lds + STAMP_OFF))[i] = __builtin_amdgcn_s_memrealtime(); } while (0)
#define SEAM2(k, kn) do { if (IN(k) && IN(kn)) xcd_barrier(bar, wave0 * 64 + lane_now() == 0); STAMP((k) + 1); } while (0)
#define SEAM(k) SEAM2(k, (k) + 1)
#else
#define STAMP(i) do { } while (0)
#ifdef MK_BAR2
#define SEAM2(k, kn) do { if (IN(k) && IN(kn)) { xcd_barrier(bar, wave0 * 64 + lane_now() == 0); xcd_barrier(bar, wave0 * 64 + lane_now() == 0); } } while (0)
#define SEAM(k) SEAM2(k, (k) + 1)
#else
#define SEAM2(k, kn) do { if (IN(k) && IN(kn)) xcd_barrier(bar, wave0 * 64 + lane_now() == 0); } while (0)
#define SEAM(k) SEAM2(k, (k) + 1)
#endif
#endif
    const int cid = (int)blockIdx.x;

    STAMP(0);
    if (IN(0) && ON(0)) { PHASE_BEGIN(); for (int rep = 0; rep < NREP(0); ++rep) { if (rep) xcd_barrier(bar, wave0 * 64 + lane_now() == 0); p0_prologue(F, args); } }
    SEAM(0);
    if (IN(1) && ON(1)) { PHASE_BEGIN(); for (int rep = 0; rep < NREP(1); ++rep) { if (rep) xcd_barrier(bar, wave0 * 64 + lane_now() == 0); norm_phase<0>(F, args, args.in[7], mods, 0); } }
    SEAM(1);

#pragma nounroll
    for (int layer = 0; layer < NLAYER; ++layer) {
        const int pb = 2 + 10 * layer, j = layer >> 1;
        if ((layer & 1) == 0) {
            if (IN(pb + 0) && ON(2)) { PHASE_BEGIN(); for (int rep = 0; rep < NREP(2); ++rep) { if (rep) xcd_barrier(bar, wave0 * 64 + lane_now() == 0); const float* lmods = mods + (size_t)layer * NMOD * ADA_N; (void)lmods; pg8::Gemm g = pg8::mk_gemm(Hb, (const bf16*)(ws + WS_WIN) + (size_t)j * NINP * D, D, D); pg8::StaticOrder S; S.init(NTOK, QL + KVL, F.G, cid);
                pg8::EpiF32 E{(float*)(ws + WS_PROJ), NINP};
                pg8::gemm_phase<pg8::EpiF32, pg8::StaticOrder, MK_ALIGN, MK_SP2>(F.lds + RING_OFF, g, S, E, wave0);
                pg8::Gemm g2 = pg8::mk_gemm(Hb, (const bf16*)(ws + WS_WIN) + ((size_t)j * NINP + QL + KVL) * D, D / 4, D); g2.ldb = D; g2.b_hstep = (size_t)pg8::HALF * D * 2; g2.b_tstep = 0;
                pg8::KSplitOrder S2; S2.init(NTOK, D / 4, F.G, cid);
                pg8::EpiKr E2{(float*)(ws + WS_PKR)};
                pg8::gemm_phase<pg8::EpiKr, pg8::KSplitOrder, MK_ALIGN, MK_SP2>(F.lds + RING_OFF, g2, S2, E2, wave0); } }
            SEAM(pb + 0);
            if (IN(pb + 1) && ON(3)) { PHASE_BEGIN(); for (int rep = 0; rep < NREP(3); ++rep) { if (rep) xcd_barrier(bar, wave0 * 64 + lane_now() == 0); const float* lmods = mods + (size_t)layer * NMOD * ADA_N; (void)lmods; mla_mid_phase(F, args, j); } }
            SEAM(pb + 1);
            if (IN(pb + 2) && ON(4)) {
                PHASE_BEGIN(); for (int rep = 0; rep < NREP(4); ++rep) { if (rep) xcd_barrier(bar, wave0 * 64 + lane_now() == 0);
#ifdef MK_SKEW
                if ((cid >> 3) & 1) { for (int i = 0; i < MK_SKEW; ++i) __builtin_amdgcn_s_sleep(127); }
#endif
                { pg8::Gemm g = pg8::mk_gemm((const bf16*)(ws + WS_CQ), (const bf16*)(ws + WS_WUQ) + (size_t)j * NQ * QL, QL, QL); pg8::StaticOrder S; S.init(NTOK, NQ, F.G, cid);
                  pg8::EpiQ E{(bf16*)(ws + WS_Q), (const float*)(ws + WS_COS), (const float*)(ws + WS_SIN)};
                  pg8::gemm_phase<pg8::EpiQ, pg8::StaticOrder, MK_ALIGN, MK_SP2>(F.lds + RING_OFF, g, S, E, wave0); }
                { pg8::Gemm g = pg8::mk_gemm((const bf16*)(ws + WS_CKV), (const bf16*)(ws + WS_WUKV) + (size_t)j * NKV * KVL, KVL, KVL); pg8::StaticOrder S; S.init(MKV, NKV, F.G, cid);
                  pg8::EpiBf16<0> E{(bf16*)(ws + WS_KN), D, D, (size_t)(WS_V - WS_KN) / 2, 0};
                  pg8::gemm_phase<pg8::EpiBf16<0>, pg8::StaticOrder, MK_ALIGN, MK_SP2>(F.lds + RING_OFF, g, S, E, wave0); }
            } }
            SEAM(pb + 2);
            if (IN(pb + 3) && ON(5)) { PHASE_BEGIN(); for (int rep = 0; rep < NREP(5); ++rep) { if (rep) xcd_barrier(bar, wave0 * 64 + lane_now() == 0); const float* lmods = mods + (size_t)layer * NMOD * ADA_N; (void)lmods; attn_phase(F, (char*)lds + RING_OFF); } }
            SEAM(pb + 3);
            if (IN(pb + 4) && ON(6)) { PHASE_BEGIN(); for (int rep = 0; rep < NREP(6); ++rep) { if (rep) xcd_barrier(bar, wave0 * 64 + lane_now() == 0); const float* lmods = mods + (size_t)layer * NMOD * ADA_N; (void)lmods; pg8::Gemm g = pg8::mk_gemm((const bf16*)(ws + WS_O), (const bf16*)(ws + WS_WO) + (size_t)j * D * D, D, D); pg8::StaticOrder S; S.init(NTOK, D, F.G, cid);
                pg8::EpiRes E{(NREP(6) == 2 && rep == 0) ? (bf16*)(ws + WS_PROJ) : X, lmods + 2 * D};
                pg8::gemm_phase<pg8::EpiRes, pg8::StaticOrder, MK_ALIGN_RES, MK_SP2>(F.lds + RING_OFF, g, S, E, wave0); } }
            SEAM(pb + 4);
        } else {
            if (IN(pb + 0) && ON(7)) { PHASE_BEGIN(); for (int rep = 0; rep < NREP(7); ++rep) { if (rep) xcd_barrier(bar, wave0 * 64 + lane_now() == 0); const float* lmods = mods + (size_t)layer * NMOD * ADA_N; (void)lmods; pg8::Gemm g = pg8::mk_gemm(Hb, (const bf16*)(ws + WS_WRIN) + (size_t)j * 2 * D * D, D, D); pg8::StaticOrder S; S.init(NTOK, 2 * D, F.G, cid);
                pg8::EpiBf16<1> E{(bf16*)(ws + WS_RIN), 2 * D, 0, 0, D / 256};
                pg8::gemm_phase<pg8::EpiBf16<1>, pg8::StaticOrder, MK_ALIGN, MK_SP2>(F.lds + RING_OFF, g, S, E, wave0); } }
            SEAM(pb + 0);
            if (IN(pb + 1) && ON(8)) { PHASE_BEGIN(); for (int rep = 0; rep < NREP(8); ++rep) { if (rep) xcd_barrier(bar, wave0 * 64 + lane_now() == 0); const float* lmods = mods + (size_t)layer * NMOD * ADA_N; (void)lmods; conv4_phase(F, args, j); } }
            SEAM(pb + 1);
            if (!MK_RS && IN(pb + 2) && ON(9)) { PHASE_BEGIN(); for (int rep = 0; rep < NREP(9); ++rep) { if (rep) xcd_barrier(bar, wave0 * 64 + lane_now() == 0); const float* lmods = mods + (size_t)layer * NMOD * ADA_N; (void)lmods; pg8::Gemm g = pg8::mk_gemm((const bf16*)(ws + WS_XC), (const bf16*)(ws + WS_WG) + (size_t)j * 8192 * 128, 128, D); pg8::GateOrder S; S.init(NTOK, 8192, F.G, cid);
                pg8::EpiGates E{(bf16*)(ws + WS_LA), (bf16*)(ws + WS_UU), (const bf16*)(ws + WS_XC), args.in[23] + (size_t)j * 2 * D, args.in[25] + (size_t)j * 2 * D, (const float*)(ws + WS_SP) + (size_t)j * 2 * D, (LAS float*)(F.lds + EDGE_OFF)};
                pg8::gemm_phase<pg8::EpiGates, pg8::GateOrder, MK_ALIGN_G, MK_SP2>(F.lds + RING_OFF, g, S, E, wave0); } }
            if (!MK_RS) SEAM(pb + 2);
            if (IN(pb + 3) && ON(10)) { PHASE_BEGIN(); for (int rep = 0; rep < NREP(10); ++rep) { if (rep) xcd_barrier(bar, wave0 * 64 + lane_now() == 0); const float* lmods = mods + (size_t)layer * NMOD * ADA_N; (void)lmods; if (MK_RS) rs_phase(F, args, j, wave0); else scan_phase(F, args, j); } }
            SEAM(pb + 3);
            if (IN(pb + 4) && ON(11)) { PHASE_BEGIN(); for (int rep = 0; rep < NREP(11); ++rep) { if (rep) xcd_barrier(bar, wave0 * 64 + lane_now() == 0); const float* lmods = mods + (size_t)layer * NMOD * ADA_N; (void)lmods; pg8::Gemm g = pg8::mk_gemm((const bf16*)(ws + WS_MIX), (const bf16*)(ws + WS_WROUT) + (size_t)j * D * D, D, D); pg8::StaticOrder S; S.init(NTOK, D, F.G, cid);
                pg8::EpiRes E{(NREP(11) == 2 && rep == 0) ? (bf16*)(ws + WS_RIN) : X, lmods + 2 * D};
                pg8::gemm_phase<pg8::EpiRes, pg8::StaticOrder, MK_ALIGN_RES, MK_SP2>(F.lds + RING_OFF, g, S, E, wave0); } }
            SEAM(pb + 4);
        }
        if (IN(pb + 5) && ON(12)) { PHASE_BEGIN(); for (int rep = 0; rep < NREP(12); ++rep) { if (rep) xcd_barrier(bar, wave0 * 64 + lane_now() == 0); const float* lmods = mods + (size_t)layer * NMOD * ADA_N; (void)lmods; norm_phase<1>(F, args, args.in[8] + (size_t)layer * D, lmods, 3); } }
        SEAM(pb + 5);
        if (IN(pb + 6) && ON(13)) { PHASE_BEGIN(); for (int rep = 0; rep < NREP(13); ++rep) { if (rep) xcd_barrier(bar, wave0 * 64 + lane_now() == 0); const float* lmods = mods + (size_t)layer * NMOD * ADA_N; (void)lmods; pg8::Gemm g = pg8::mk_gemm(Hb, (const bf16*)(ws + WS_WUP) + (size_t)layer * NUP * D, D, D); g.b_hstep = (size_t)DFF * D * 2; g.b_tstep = (size_t)pg8::HALF * D * 2;
            pg8::StaticOrder S; S.init(NTOK, NUP, F.G, cid);
            pg8::EpiFfn E{(bf16*)(ws + WS_ACT), (float*)(ws + WS_HALO), args.in[29] + (size_t)layer * 3 * NUP, args.in[30] + (size_t)layer * NUP, (LAS float*)(F.lds + EDGE_OFF)};
            pg8::gemm_phase<pg8::EpiFfn, pg8::StaticOrder, MK_ALIGN, MK_SP2>(F.lds + RING_OFF, g, S, E, wave0); } }
        SEAM2(pb + 6, pb + 8);
        if (IN(pb + 8) && ON(15)) { PHASE_BEGIN(); for (int rep = 0; rep < NREP(15); ++rep) { if (rep) xcd_barrier(bar, wave0 * 64 + lane_now() == 0); const float* lmods = mods + (size_t)layer * NMOD * ADA_N; (void)lmods; pg8::Gemm g = pg8::mk_gemm((const bf16*)(ws + WS_ACT), (const bf16*)(ws + WS_WDN) + (size_t)layer * D * ALD, DFF, ALD); g.ldb = ALD; g.b_hstep = (size_t)pg8::HALF * ALD * 2; g.b_tstep = (size_t)pg8::BM * ALD * 2; pg8::StaticOrder S; S.init(NTOK, D, F.G, cid);
            { pg8::Unit u0, u1; if (S.next(0, u0)) { ffn_fix_panel(F, args, layer, u0.pm); if (S.next(1, u1) && u1.pm != u0.pm) ffn_fix_panel(F, args, layer, u1.pm); }
              asm volatile("s_waitcnt vmcnt(0)" ::: "memory"); __syncthreads(); }
#ifdef MK_KREP
            typedef pg8::EpiResT<MK_KREP> EpiF3;
#else
            typedef pg8::EpiRes EpiF3;
#endif
            EpiF3 E{(NREP(15) == 2 && rep == 0) ? (bf16*)(ws + WS_U) : X, lmods + 5 * D};
            pg8::gemm_phase<EpiF3, pg8::StaticOrder, MK_ALIGN_RES, MK_SP2>(F.lds + RING_OFF, g, S, E, wave0); } }
        SEAM(pb + 8);
        if (IN(pb + 9) && ON(16)) { PHASE_BEGIN(); for (int rep = 0; rep < NREP(16); ++rep) { if (rep) xcd_barrier(bar, wave0 * 64 + lane_now() == 0); const float* lmods = mods + (size_t)layer * NMOD * ADA_N; (void)lmods; if (layer + 1 < NLAYER) norm_phase<1>(F, args, args.in[7] + (size_t)(layer + 1) * D, lmods + (size_t)NMOD * ADA_N, 0); else norm_phase<2>(F, args, args.in[9], mods, 0); } }
        if (layer + 1 < NLAYER) SEAM(pb + 9);
    }
#if MK_PROBE
    xcd_barrier(bar, wave0 * 64 + lane_now() == 0); STAMP(NPHASE);
    { float* cw = (float*)(args.ws + WS_CTL) + 8192;
      if (blockIdx.x == 0 && threadIdx.x == 0) { float T[17]; for (int i = 0; i < 17; ++i) T[i] = 0.f;
          const LAS unsigned long long* ts = (const LAS unsigned long long*)(F.lds + STAMP_OFF);
          float t1 = 0.f, t2 = 0.f;
          for (int p = 0; p < NPHASE; ++p) { const float dt = (float)(ts[p + 1] - ts[p]) * 0.01f; int kind;
              if (p < 2) kind = p; else { const int k = (p - 2) % 10, ly = (p - 2) / 10; kind = k < 5 ? ((ly & 1) ? 7 + k : 2 + k) : 7 + k; }
              if (kind == MK_SEL1 || MK_SEL1 == 99) t1 += dt; if (kind == MK_SEL2 || MK_SEL2 == 99) t2 += dt; }
          (void)T; cw[0] = sqrtf(t1); cw[1] = t2 * MK_SCALE2; }
      xcd_barrier(bar, wave0 * 64 + lane_now() == 0);
      const float c1 = cw[0], c2 = cw[1];
      for (size_t i = (size_t)blockIdx.x * 512 + threadIdx.x; i < OUT_TOTAL; i += (size_t)gridDim.x * 512)
          args.out[i] = (i >= (size_t)MCTX * D && i < 2ull * MCTX * D) ? c1 : (i == 0 ? c2 : 0.f); }
#endif
#undef IN
#undef SEAM
#undef SEAM2
}

extern "C" void kernel_launch(void* const* d_in, const int* in_sizes, int n_in, void* d_out, int out_size, void* d_ws, size_t ws_size, hipStream_t stream) {
    static int grid = 0;
    if (grid == 0) {
        if (n_in != 32 || in_sizes[0] != MCTX * D || in_sizes[1] != MCTX * D || (size_t)out_size != OUT_TOTAL || ws_size < WS_END) {
            fprintf(stderr, "kernel_launch: shape mismatch (n_in %d, out %d, ws %zu); nothing launched\n", n_in, out_size, ws_size); grid = -1; return; }
        int dev = 0, cus = 0, per_cu = 0;
        if (hipGetDevice(&dev) != hipSuccess || hipDeviceGetAttribute(&cus, hipDeviceAttributeMultiprocessorCount, dev) != hipSuccess) { grid = -1; return; }
        if (hipFuncSetAttribute((const void*)mk_fwd, hipFuncAttributeMaxDynamicSharedMemorySize, LDS_BYTES) != hipSuccess) { fprintf(stderr, "kernel_launch: hipFuncSetAttribute failed\n"); grid = -1; return; }
        if (hipOccupancyMaxActiveBlocksPerMultiprocessor(&per_cu, (const void*)mk_fwd, NWAVES * 64, LDS_BYTES) != hipSuccess || per_cu < 1)
            fprintf(stderr, "kernel_launch: note: occupancy query reports %d workgroups per CU\n", per_cu);
        (void)hipGetLastError();
        grid = cus;
        if (grid != 256) fprintf(stderr, "kernel_launch: note: %d CUs (tuned for 256)\n", grid);
    }
    if (grid < 0) return;
    if (hipMemsetAsync((char*)d_ws + WS_CTL, 0, CTL_ZERO_BYTES, stream) != hipSuccess) { fprintf(stderr, "kernel_launch: memset failed\n"); return; }
    Args a{};
    for (int i = 0; i < 32; ++i) a.in[i] = (const float*)d_in[i];
    a.out = (float*)d_out; a.ws = (unsigned char*)d_ws;
#if MK_PER_PHASE
    for (int p = 0; p < NPHASE && p < MK_STOP; ++p) { a.ph_lo = p; a.ph_hi = p + 1; hipLaunchKernelGGL(mk_fwd, dim3(grid), dim3(NWAVES * 64), LDS_BYTES, stream, a); }
#else
    a.ph_lo = 0; a.ph_hi = NPHASE; hipLaunchKernelGGL(mk_fwd, dim3(grid), dim3(NWAVES * 64), LDS_BYTES, stream, a);
#endif
    const hipError_t le = hipPeekAtLastError();
    if (le != hipSuccess) fprintf(stderr, "kernel_launch: launch failed: %s\n", hipGetErrorName(le));
}
```

```cpp
#define MK_REP 0u
#include <hip/hip_runtime.h>
#include <cstdio>
#include <cstdint>

constexpr int D = 2048, NTOK = 16384, MCTX = 8192, DFF = 5632, NUP = 2 * DFF, NLAYER = 4;
constexpr int QL = 512, KVL = 512, NH = 16, NOPE = 128, ROPE = 64, VD = 128, QKD = NOPE + ROPE;
constexpr int NIN = QL + KVL + ROPE  , NINP = 1280  , NQ = NH * QKD  , NKV = 2 * NH * NOPE  ;
constexpr int MKV = MCTX + 8 * 1280;
constexpr int NMOD = 9, ADA_N = 6 * D;
#ifndef MK_APAD
#define MK_APAD 64
#endif
constexpr int ALD = DFF + MK_APAD;
constexpr float NORM_EPS = 1e-6f;

__device__ __forceinline__ int lane_now() { int z = 0; asm volatile("" : "+v"(z)); return (int)__builtin_amdgcn_mbcnt_hi(~0u, __builtin_amdgcn_mbcnt_lo(~0u, (unsigned)z)); }

namespace pg8 {
#define PG8_LAS __attribute__((address_space(3)))
typedef unsigned short bf16_t;
typedef short bf16x8 __attribute__((ext_vector_type(8)));
typedef float f32x4 __attribute__((ext_vector_type(4)));
typedef float f32x2 __attribute__((ext_vector_type(2)));
typedef unsigned u32x4 __attribute__((ext_vector_type(4)));
typedef unsigned u32x2 __attribute__((ext_vector_type(2)));
constexpr int BM = 256, BK = 64, HALF = 128, HTB = HALF * BK * 2  , STAGE_BYTES = 8 * HTB, NXCD = 8, WGM = 8;

__host__ __device__ __forceinline__ int lds_byte(int r, int c) { const int st = (r >> 4) * 2 + (c >> 5), rr = r & 15, cc = c & 31, ob = rr * 64 + cc * 2; return st * 1024 + (ob ^ (((ob >> 9) & 1) << 5)); }
__host__ __device__ __forceinline__ void stage_rc(int b, int& R, int& C) { const int st = b / 1024, sb = b % 1024, swz = sb ^ (((sb >> 9) & 1) << 5); R = (st >> 1) * 16 + swz / 64; C = (st & 1) * 32 + (swz % 64) / 2; }
__host__ __device__ __forceinline__ int perm32(int rho) { const int n = rho >> 4, i = rho & 15; return 8 * (i >> 2) + 4 * n + (i & 3); }

struct Unit { int pm, pn; };
struct Gemm { const bf16_t* A; const bf16_t* Bt; int K; int lda; int ldb; int pad_; size_t b_hstep, b_tstep; };
__device__ __forceinline__ Gemm mk_gemm(const bf16_t* A, const bf16_t* Bt, int K, int lda) { Gemm g; g.A = A; g.Bt = Bt; g.K = K; g.lda = lda; g.ldb = K; g.pad_ = 0; g.b_hstep = (size_t)HALF * K * 2; g.b_tstep = (size_t)BM * K * 2; return g; }

struct StaticOrder {
    int nM, nN, nwg, G, c;
    __host__ __device__ void init(int M, int N, int G_, int c_) { nM = M / BM; nN = N / BM; nwg = nM * nN; G = G_; c = c_; }
    __host__ __device__ __forceinline__ bool next(int i, Unit& u) const {
        const long L = (long)i * G + c; if (L >= nwg) return false;
        int wgid = (int)L; { const int q = nwg / NXCD, r = nwg % NXCD, xcd = wgid % NXCD, off = wgid / NXCD; wgid = (xcd < r ? xcd * (q + 1) : r * (q + 1) + (xcd - r) * q) + off; }
        const int nig = WGM * nN, gid = wgid / nig, fm = gid * WGM, gsz = (nM - fm) < WGM ? (nM - fm) : WGM;
        u.pm = fm + ((wgid % nig) % gsz); u.pn = (wgid % nig) / gsz; return true;
    }
    __device__ __forceinline__ size_t acol(const Unit&) const { return 0; }
    __device__ __forceinline__ size_t bcol(const Unit&) const { return 0; }
    __device__ __forceinline__ void a_ready(const Unit&) const {}
    __device__ __forceinline__ void done(const Unit&) const {}
};
struct GateOrder : StaticOrder {
    __device__ __forceinline__ size_t acol(const Unit& u) const { return (size_t)(u.pn >> 1) * 256; }
};

struct OneUnit {
    int pm, pn;
    __device__ __forceinline__ bool next(int i, Unit& u) const { if (i) return false; u.pm = pm; u.pn = pn; return true; }
    __device__ __forceinline__ size_t acol(const Unit& u) const { return (size_t)(u.pn >> 1) * 256; }
    __device__ __forceinline__ size_t bcol(const Unit&) const { return 0; }
    __device__ __forceinline__ void a_ready(const Unit&) const {}
    __device__ __forceinline__ void done(const Unit&) const {}
};

struct KSplitOrder {
    int nwg, G, c; unsigned qbytes;
    __device__ void init(int M, int Kq, int G_, int c_) { nwg = (M / BM) * 4; G = G_; c = c_; qbytes = (unsigned)Kq * 2u; }
    __device__ __forceinline__ bool next(int i, Unit& u) const { const long L = (long)i * G + c; if (L >= nwg) return false; u.pm = (int)(L >> 2); u.pn = (int)(L & 3); return true; }
    __device__ __forceinline__ size_t acol(const Unit& u) const { return (size_t)u.pn * qbytes; }
    __device__ __forceinline__ size_t bcol(const Unit& u) const { return (size_t)u.pn * qbytes; }
    __device__ __forceinline__ void a_ready(const Unit&) const {}
    __device__ __forceinline__ void done(const Unit&) const {}
};

__device__ __forceinline__ unsigned cvt_pk_bf16(float lo, float hi) { unsigned r; asm volatile("v_cvt_pk_bf16_f32 %0, %1, %2" : "=v"(r) : "v"(lo), "v"(hi)); return r; }
__device__ __forceinline__ float bf_lo(unsigned w) { return __uint_as_float(w << 16); }
__device__ __forceinline__ float bf_hi(unsigned w) { return __uint_as_float(w & 0xffff0000u); }
__device__ __forceinline__ float fast_sigmoid(float x) { return __builtin_amdgcn_rcpf(1.0f + __builtin_amdgcn_exp2f(-1.4426950408889634f * x)); }
__device__ __forceinline__ float gelu_tanh(float x) { const float z = 0.7978845608028654f * (x + 0.044715f * x * x * x); return x * fast_sigmoid(2.0f * z); }

#ifndef MK_WT
#define MK_WT 0
#endif
template <int TG> __device__ __forceinline__ void gst16(void* p, u32x4 v) {
  if constexpr ((MK_WT >> TG) & 1) {
    asm volatile("global_store_dwordx4 %0, %1, off sc1\n\ts_nop 1" :: "v"(p), "v"(v) : "memory");
  } else {
    *(u32x4*)p = v; }
}
template <int TG> __device__ __forceinline__ void gst16f(void* p, f32x4 v) {
  if constexpr ((MK_WT >> TG) & 1) {
    asm volatile("global_store_dwordx4 %0, %1, off sc1\n\ts_nop 1" :: "v"(p), "v"(v) : "memory");
  } else {
    *(f32x4*)p = v; }
}
template <int TG> __device__ __forceinline__ void gst8(void* p, u32x2 v) {
  if constexpr ((MK_WT >> TG) & 1) {
    asm volatile("global_store_dwordx2 %0, %1, off sc1\n\ts_nop 1" :: "v"(p), "v"(v) : "memory");
  } else {
    *(u32x2*)p = v; }
}
struct EpiF32 {
    static constexpr int TAG = 0;
    static constexpr bool PERM = false, AFTER_DRAIN = false; static constexpr int KREP = 1;
    float* C; int ldc;
    __device__ __forceinline__ void operator()(const f32x4 (&acc)[2][2][4][2], const Unit& u, int wr, int wc, int fr, int fq) const {
        const int row0 = u.pm * BM + wr * 64 + fr, col0 = u.pn * BM + wc * 32 + 4 * fq;
#pragma unroll
        for (int ai = 0; ai < 2; ++ai)
#pragma unroll
            for (int m = 0; m < 4; ++m) { float* rowp = C + (size_t)(row0 + ai * HALF + m * 16) * ldc + col0;
#pragma unroll
                for (int bj = 0; bj < 2; ++bj)
#pragma unroll
                    for (int n = 0; n < 2; ++n) gst16f<TAG>(rowp + bj * HALF + n * 16, acc[ai][bj][m][n]); }
    }
};
struct EpiKr {
    static constexpr int TAG = 1;
    static constexpr bool PERM = false, AFTER_DRAIN = false; static constexpr int KREP = 1;
    float* P;
    __device__ __forceinline__ void operator()(const f32x4 (&acc)[2][2][4][2], const Unit& u, int wr, int wc, int fr, int fq) const {
        if (wc >= 2) return;
        float* base = P + ((size_t)u.pn * NTOK + u.pm * BM + wr * 64 + fr) * ROPE + wc * 32 + 4 * fq;
#pragma unroll
        for (int ai = 0; ai < 2; ++ai)
#pragma unroll
            for (int m = 0; m < 4; ++m)
#pragma unroll
                for (int n = 0; n < 2; ++n) gst16f<TAG>(base + (size_t)(ai * HALF + m * 16) * ROPE + n * 16, acc[ai][0][m][n]);
    }
};
template <int ACT> struct EpiBf16 {
    static constexpr int TAG = 2 + 10 * ACT;
    static constexpr bool PERM = true, AFTER_DRAIN = false; static constexpr int KREP = 1;
    bf16_t* O; int ldc; int split_cols; size_t split_stride; int act_tiles;
    __device__ __forceinline__ void operator()(const f32x4 (&acc)[2][2][4][2], const Unit& u, int wr, int wc, int fr, int fq) const {
        const int row0 = u.pm * BM + wr * 64 + fr; int colt = u.pn * BM; bf16_t* base = O;
        if (split_cols) { const int t = colt / split_cols; base += (size_t)t * split_stride; colt -= t * split_cols; }
        const int col0 = colt + wc * 32 + 8 * fq;
        const bool act = (ACT == 1) && (u.pn < act_tiles);
#pragma unroll
        for (int ai = 0; ai < 2; ++ai)
#pragma unroll
            for (int m = 0; m < 4; ++m) { bf16_t* rowp = base + (size_t)(row0 + ai * HALF + m * 16) * ldc + col0;
#pragma unroll
                for (int bj = 0; bj < 2; ++bj) { f32x4 v0 = acc[ai][bj][m][0], v1 = acc[ai][bj][m][1];
                    if (ACT == 1) { if (act) {
                        f32x4 e0 = v0 * (v0 * v0 * -0.10294324f + -2.3022082f), e1 = v1 * (v1 * v1 * -0.10294324f + -2.3022082f);
#pragma unroll
                        for (int j = 0; j < 4; ++j) { e0[j] = __builtin_amdgcn_exp2f(e0[j]); e1[j] = __builtin_amdgcn_exp2f(e1[j]); }
                        e0 = e0 + 1.0f; e1 = e1 + 1.0f;
#pragma unroll
                        for (int j = 0; j < 4; ++j) { e0[j] = __builtin_amdgcn_rcpf(e0[j]); e1[j] = __builtin_amdgcn_rcpf(e1[j]); }
                        v0 = v0 * e0; v1 = v1 * e1; } }
                    u32x4 w; w.x = cvt_pk_bf16(v0[0], v0[1]); w.y = cvt_pk_bf16(v0[2], v0[3]); w.z = cvt_pk_bf16(v1[0], v1[1]); w.w = cvt_pk_bf16(v1[2], v1[3]);
                    gst16<TAG>(rowp + bj * HALF, w); } }
    }
};
struct EpiQ {
    static constexpr int TAG = 3;
    static constexpr bool PERM = false, AFTER_DRAIN = false; static constexpr int KREP = 1;
    bf16_t* Q; const float* cosT; const float* sinT;
    __device__ __forceinline__ void operator()(const f32x4 (&acc)[2][2][4][2], const Unit& u, int wr, int wc, int fr, int fq) const {
        const int row0 = u.pm * BM + wr * 64 + fr; const bool sample = u.pm >= (MCTX / BM);
#pragma unroll
        for (int bj = 0; bj < 2; ++bj) {
            const int col32 = u.pn * BM + bj * HALF + wc * 32, head = col32 / QKD, d32 = col32 - head * QKD;
            const bool rope = sample && (d32 >= NOPE); const int grp = (d32 - NOPE) >> 5;
#pragma unroll
            for (int ai = 0; ai < 2; ++ai) {
                f32x4 cc[4], ss[4];
                if (rope) {
#pragma unroll
                    for (int m = 0; m < 4; ++m) { const int pos = (row0 + ai * HALF + m * 16 - MCTX) & 1023; cc[m] = *(const f32x4*)(cosT + pos * 32 + grp * 16 + 4 * fq); ss[m] = *(const f32x4*)(sinT + pos * 32 + grp * 16 + 4 * fq); } }
#pragma unroll
                for (int m = 0; m < 4; ++m) { const int row = row0 + ai * HALF + m * 16;
                    f32x4 v0 = acc[ai][bj][m][0], v1 = acc[ai][bj][m][1];
                    if (rope) { const f32x4 y0 = v0 * cc[m] - v1 * ss[m], y1 = v1 * cc[m] + v0 * ss[m]; v0 = y0; v1 = y1; }
                    u32x2 w0, w1; w0.x = cvt_pk_bf16(v0[0], v0[1]); w0.y = cvt_pk_bf16(v0[2], v0[3]); w1.x = cvt_pk_bf16(v1[0], v1[1]); w1.y = cvt_pk_bf16(v1[2], v1[3]);
                    const auto rx = __builtin_amdgcn_permlane16_swap(w0.x, w1.x, false, false), ry = __builtin_amdgcn_permlane16_swap(w0.y, w1.y, false, false);
                    u32x4 w4; w4.x = rx[0]; w4.y = ry[0]; w4.z = rx[1]; w4.w = ry[1];
                    gst16<TAG>(Q + (size_t)row * NQ + col32 + (fq >> 1) * 8 + (fq & 1) * 16, w4); } }
        }
    }
};
template <int KR = 1> struct EpiResT {
    static constexpr int TAG = 4;
    static constexpr bool PERM = true, AFTER_DRAIN = false; static constexpr int KREP = KR;
    bf16_t* X; const float* gate;
    __device__ __forceinline__ void operator()(const f32x4 (&acc)[2][2][4][2], const Unit& u, int wr, int wc, int fr, int fq) const {
        const int row0 = u.pm * BM + wr * 64 + fr, col0 = u.pn * BM + wc * 32 + 8 * fq;
        const int mod = u.pm < (MCTX / BM) ? 0 : 1 + ((u.pm - MCTX / BM) >> 2);
        const float* gp = gate + (size_t)mod * ADA_N + col0;
        f32x4 gv[2][2];
#pragma unroll
        for (int bj = 0; bj < 2; ++bj)
#pragma unroll
            for (int n = 0; n < 2; ++n) gv[bj][n] = *(const f32x4*)(gp + bj * HALF + n * 4);
        u32x4 cur[2], nxt[2];
#pragma unroll
        for (int bj = 0; bj < 2; ++bj) cur[bj] = *(const u32x4*)(X + (size_t)row0 * D + col0 + bj * HALF);
#pragma unroll
        for (int k = 0; k < 8; ++k) { const int ai = k >> 2, m = k & 3; bf16_t* rowp = X + (size_t)(row0 + ai * HALF + m * 16) * D + col0;
            if (k < 7) { const bf16_t* nrow = X + (size_t)(row0 + ((k + 1) >> 2) * HALF + ((k + 1) & 3) * 16) * D + col0;
#pragma unroll
                for (int bj = 0; bj < 2; ++bj) nxt[bj] = *(const u32x4*)(nrow + bj * HALF); }
#pragma unroll
            for (int bj = 0; bj < 2; ++bj) { const u32x4 xw = cur[bj];
                const f32x4 x0 = (f32x4){bf_lo(xw.x), bf_hi(xw.x), bf_lo(xw.y), bf_hi(xw.y)} + gv[bj][0] * acc[ai][bj][m][0];
                const f32x4 x1 = (f32x4){bf_lo(xw.z), bf_hi(xw.z), bf_lo(xw.w), bf_hi(xw.w)} + gv[bj][1] * acc[ai][bj][m][1];
                u32x4 w; w.x = cvt_pk_bf16(x0[0], x0[1]); w.y = cvt_pk_bf16(x0[2], x0[3]); w.z = cvt_pk_bf16(x1[0], x1[1]); w.w = cvt_pk_bf16(x1[2], x1[3]);
                gst16<TAG>(rowp + bj * HALF, w); cur[bj] = nxt[bj]; }
            asm volatile("" ::: "memory"); }
    }
};
typedef EpiResT<1> EpiRes;
#ifndef MK_GOLD
#define MK_GOLD 0
#endif
#if MK_GOLD
#define GSC_B 1.0f
#define GSC_S 1.0f
#else
#define GSC_B 1.4426950408889634f
#define GSC_S -1.0f
#endif
struct EpiGates {
    static constexpr int TAG = 5;
    static constexpr bool PERM = true, AFTER_DRAIN = false; static constexpr int KREP = 1;
    bf16_t* LA; bf16_t* UU; const bf16_t* XC; const float* bgx; const float* bga; const float* sp; PG8_LAS float* prm;
    __device__ __forceinline__ void operator()(const f32x4 (&acc)[2][2][4][2], const Unit& u, int wr, int wc, int fr, int fq) const {
        const int blk = u.pn >> 1, dir = u.pn & 1, row0 = u.pm * BM + wr * 64 + fr, chw = wc * 32 + 8 * fq, ch0 = blk * 128 + chw;
        const char* xcb = (const char*)XC; char* lab = (char*)(LA + (size_t)dir * NTOK * D); char* uub = (char*)(UU + (size_t)dir * NTOK * D);
        { const int t = (wr * 4 + wc) * 64 + fq * 16 + fr;
          const int c4 = (t & 31) * 4, go = dir * D + blk * 128 + c4;
          if (t < 32) *(PG8_LAS f32x4*)(prm + c4) = *(const f32x4*)(bgx + go) * GSC_B;
          else if (t < 64) *(PG8_LAS f32x4*)(prm + 128 + c4) = *(const f32x4*)(bga + go) * GSC_B;
          else if (t < 96) *(PG8_LAS f32x4*)(prm + 256 + c4) = *(const f32x4*)(sp + go) * GSC_S; }
        asm volatile("s_waitcnt vmcnt(0) lgkmcnt(0)" ::: "memory"); __builtin_amdgcn_s_barrier(); asm volatile("" ::: "memory");
#pragma unroll
        for (int aq = 0; aq < 4; ++aq) { const int ai = aq >> 1; u32x4 xw[4];
#pragma unroll
            for (int m = (aq & 1) * 2; m < (aq & 1) * 2 + 2; ++m) xw[m] = *(const u32x4*)(xcb + ((unsigned)(row0 + ai * HALF + m * 16) * D + ch0) * 2u);
#pragma unroll
            for (int m = (aq & 1) * 2; m < (aq & 1) * 2 + 2; ++m) { const unsigned ro = ((unsigned)(row0 + ai * HALF + m * 16) * D + ch0) * 2u; u32x4 wl, wu;
#pragma unroll
                for (int n = 0; n < 2; ++n) { const unsigned x01 = n ? xw[m].z : xw[m].x, x23 = n ? xw[m].w : xw[m].y;
                    const f32x4 bx = *(const PG8_LAS f32x4*)(prm + chw + 4 * n), ba = *(const PG8_LAS f32x4*)(prm + 128 + chw + 4 * n), sv = *(const PG8_LAS f32x4*)(prm + 256 + chw + 4 * n);
#if MK_GOLD
                    const float xv[4] = {bf_lo(x01), bf_hi(x01), bf_lo(x23), bf_hi(x23)}; float l2[4], uv[4];
#pragma unroll
                    for (int j = 0; j < 4; ++j) { const float sx = fast_sigmoid(acc[ai][0][m][n][j] + bx[j]), sa = fast_sigmoid(acc[ai][1][m][n][j] + ba[j]);
                        l2[j] = -sa * sv[j]; const float a2 = __builtin_amdgcn_exp2f(2.0f * l2[j]); uv[j] = __builtin_amdgcn_sqrtf(fmaxf(1.0f - a2, 0.0f)) * sx * xv[j]; }
#else
                    const f32x4 xv = {bf_lo(x01), bf_hi(x01), bf_lo(x23), bf_hi(x23)};
                    f32x4 ex = acc[ai][0][m][n] * 1.4426950408889634f + bx, ea = acc[ai][1][m][n] * 1.4426950408889634f + ba;
#pragma unroll
                    for (int j = 0; j < 4; ++j) { ex[j] = __builtin_amdgcn_exp2f(-ex[j]); ea[j] = __builtin_amdgcn_exp2f(-ea[j]); }
                    ex = ex + 1.0f; ea = ea + 1.0f;
#pragma unroll
                    for (int j = 0; j < 4; ++j) { ex[j] = __builtin_amdgcn_rcpf(ex[j]); ea[j] = __builtin_amdgcn_rcpf(ea[j]); }
                    const f32x4 l2 = ea * sv; f32x4 av;
#pragma unroll
                    for (int j = 0; j < 4; ++j) av[j] = __builtin_amdgcn_exp2f(l2[j]);
                    f32x4 om = av * av - 1.0f;
#pragma unroll
                    for (int j = 0; j < 4; ++j) om[j] = __builtin_amdgcn_sqrtf(__builtin_fabsf(om[j]));
                    const f32x4 uv = om * ex * xv;
#endif
                    if (n == 0) { wl.x = cvt_pk_bf16(l2[0], l2[1]); wl.y = cvt_pk_bf16(l2[2], l2[3]); wu.x = cvt_pk_bf16(uv[0], uv[1]); wu.y = cvt_pk_bf16(uv[2], uv[3]); }
                    else { wl.z = cvt_pk_bf16(l2[0], l2[1]); wl.w = cvt_pk_bf16(l2[2], l2[3]); wu.z = cvt_pk_bf16(uv[0], uv[1]); wu.w = cvt_pk_bf16(uv[2], uv[3]); }
                    __builtin_amdgcn_sched_barrier(0); }
                gst16<TAG>(lab + ro, wl); gst16<TAG>(uub + ro, wu); }
            asm volatile("" ::: "memory"); }
    }
};

struct EpiGatesLds {
    static constexpr int TAG = 7;
    static constexpr bool PERM = true, AFTER_DRAIN = true; static constexpr int KREP = 1;
    const bf16_t* XC; const float* bgx; const float* bga; const float* sp; PG8_LAS float* prm;
    __device__ __forceinline__ void operator()(const f32x4 (&)[2][2][4][2], const Unit&, int, int, int, int) const {}
    __device__ __forceinline__ f32x4 pre(const Unit& u, int t) const { f32x4 r = {0.f, 0.f, 0.f, 0.f};
        const int blk = u.pn >> 1, dir = u.pn & 1, go = dir * D + blk * 128 + (t & 31) * 4;
        if (t < 32) r = *(const f32x4*)(bgx + go); else if (t < 64) r = *(const f32x4*)(bga + go); else if (t < 96) r = *(const f32x4*)(sp + go);
        return r; }
    __device__ __forceinline__ void fused(const f32x4 (&acc)[2][2][4][2], const Unit& u, int wr, int wc, int fr, int fq, PG8_LAS unsigned char* img, const f32x4 pf) const {
        const int blk = u.pn >> 1, dir = u.pn & 1, rl0 = wr * 64 + fr, row0 = u.pm * BM + rl0, chw = wc * 32 + 8 * fq, ch0 = blk * 128 + chw;
        const char* xcb = (const char*)XC;
        u32x4 xa[2][4];
#pragma unroll
        for (int m = 0; m < 4; ++m) xa[0][m] = *(const u32x4*)(xcb + ((unsigned)(row0 + m * 16) * D + ch0) * 2u);
        { const int t = (wr * 4 + wc) * 64 + fq * 16 + fr;
          if (t < 96) *(PG8_LAS f32x4*)(prm + (t >> 5) * 128 + (t & 31) * 4) = pf * (t < 64 ? GSC_B : GSC_S); }
        asm volatile("s_waitcnt lgkmcnt(0)" ::: "memory"); __builtin_amdgcn_s_barrier(); asm volatile("" ::: "memory");
#pragma unroll
        for (int aq = 0; aq < 4; ++aq) { const int ai = aq >> 1;
            if (aq == 0) {
#pragma unroll
                for (int m = 0; m < 4; ++m) xa[1][m] = *(const u32x4*)(xcb + ((unsigned)(row0 + HALF + m * 16) * D + ch0) * 2u); }
#pragma unroll
            for (int m = (aq & 1) * 2; m < (aq & 1) * 2 + 2; ++m) { const int rl = rl0 + ai * HALF + m * 16;
#pragma unroll
                for (int n = 0; n < 2; ++n) { const unsigned x01 = n ? xa[ai][m].z : xa[ai][m].x, x23 = n ? xa[ai][m].w : xa[ai][m].y;
                    const f32x4 bx = *(const PG8_LAS f32x4*)(prm + chw + 4 * n), ba = *(const PG8_LAS f32x4*)(prm + 128 + chw + 4 * n), sv = *(const PG8_LAS f32x4*)(prm + 256 + chw + 4 * n);
                    const f32x4 xv = {bf_lo(x01), bf_hi(x01), bf_lo(x23), bf_hi(x23)};
                    f32x4 ex = acc[ai][0][m][n] * 1.4426950408889634f + bx, ea = acc[ai][1][m][n] * 1.4426950408889634f + ba;
#pragma unroll
                    for (int j = 0; j < 4; ++j) { ex[j] = __builtin_amdgcn_exp2f(-ex[j]); ea[j] = __builtin_amdgcn_exp2f(-ea[j]); }
                    ex = ex + 1.0f; ea = ea + 1.0f;
#pragma unroll
                    for (int j = 0; j < 4; ++j) { ex[j] = __builtin_amdgcn_rcpf(ex[j]); ea[j] = __builtin_amdgcn_rcpf(ea[j]); }
                    const f32x4 l2 = ea * sv; f32x4 av;
#pragma unroll
                    for (int j = 0; j < 4; ++j) av[j] = __builtin_amdgcn_exp2f(l2[j]);
                    f32x4 om = av * av - 1.0f;
#pragma unroll
                    for (int j = 0; j < 4; ++j) om[j] = __builtin_amdgcn_sqrtf(__builtin_fabsf(om[j]));
                    const f32x4 uv = om * ex * xv;
                    u32x4 w; w.x = cvt_pk_bf16(l2[0], uv[0]); w.y = cvt_pk_bf16(l2[1], uv[1]); w.z = cvt_pk_bf16(l2[2], uv[2]); w.w = cvt_pk_bf16(l2[3], uv[3]);
                    const int chunk = (wc * 8 + 2 * fq + n) ^ (rl & 31);
                    *(PG8_LAS u32x4*)(img + rl * 512 + chunk * 16) = w;
                    __builtin_amdgcn_sched_barrier(0); } }
            asm volatile("" ::: "memory"); }
    }
};

__device__ __forceinline__ f32x4 dpp_ror1(f32x4 v) { f32x4 r;
#pragma unroll
    for (int j = 0; j < 4; ++j) r[j] = __int_as_float(__builtin_amdgcn_mov_dpp(__float_as_int(v[j]), 0x121, 0xf, 0xf, false)); return r; }
__device__ __forceinline__ f32x4 dpp_rol1(f32x4 v) { f32x4 r;
#pragma unroll
    for (int j = 0; j < 4; ++j) r[j] = __int_as_float(__builtin_amdgcn_mov_dpp(__float_as_int(v[j]), 0x12f, 0xf, 0xf, false)); return r; }
#ifndef MK_KREP_F1
#define MK_KREP_F1 1
#endif
struct EpiFfn {
    static constexpr int TAG = 6;
    static constexpr bool PERM = true, AFTER_DRAIN = false; static constexpr int KREP = MK_KREP_F1;
    bf16_t* ACT; float* HALO; const float* wcv; const float* bcv; PG8_LAS float* edge;
    __device__ __forceinline__ f32x4 pre(const Unit& u, int t) const { f32x4 r = {0.f, 0.f, 0.f, 0.f};
        if (t < 256) { const int p2 = t >> 5, p = p2 >> 1, bjp = p2 & 1, c4 = (t & 31) * 4; const float* src = (p < 3 ? wcv + (size_t)p * NUP : bcv) + bjp * DFF + u.pn * HALF + c4; asm volatile("global_load_dwordx4 %0, %1, off" : "=&v"(r) : "v"(src) : "memory"); }
        return r; }
    __device__ __forceinline__ void operator()(const f32x4 (&acc)[2][2][4][2], const Unit& u, int wr, int wc, int fr, int fq, const f32x4 pf) const {
        const int chw = wc * 32 + 8 * fq;
#pragma unroll
        for (int ai = 0; ai < 2; ++ai) { const int grp = 2 * ai + wr;
            if (fr == 0) {
#pragma unroll
                for (int bj = 0; bj < 2; ++bj)
#pragma unroll
                    for (int n = 0; n < 2; ++n) *(PG8_LAS f32x4*)(edge + (grp * 2 + 0) * 256 + bj * HALF + chw + 4 * n) = acc[ai][bj][0][n]; }
            if (fr == 15) {
#pragma unroll
                for (int bj = 0; bj < 2; ++bj)
#pragma unroll
                    for (int n = 0; n < 2; ++n) *(PG8_LAS f32x4*)(edge + (grp * 2 + 1) * 256 + bj * HALF + chw + 4 * n) = acc[ai][bj][3][n]; } }
        PG8_LAS float* prm = edge + 4 * 2 * 256;
        { const int t = (wr * 4 + wc) * 64 + fq * 16 + fr;
          asm volatile("s_waitcnt vmcnt(8)" ::: "memory");
          if (t < 256) { const int p2 = t >> 5, bjp = p2 & 1, c4 = (t & 31) * 4;
              *(PG8_LAS f32x4*)(prm + p2 * 128 + c4) = pf * (bjp ? -0.6931471805599453f : -1.4426950408889634f); } }
        asm volatile("s_waitcnt lgkmcnt(0)" ::: "memory"); __builtin_amdgcn_s_barrier(); asm volatile("" ::: "memory");
        if (u.pm >= MCTX / BM) { float* hb = HALO + (size_t)u.pm * 4 * NUP + u.pn * HALF + chw;
            if (wr == 0 && fr == 0) {
#pragma unroll
                for (int m = 0; m < 2; ++m)
#pragma unroll
                    for (int bj = 0; bj < 2; ++bj)
#pragma unroll
                        for (int n = 0; n < 2; ++n) *(f32x4*)(hb + (size_t)m * NUP + bj * DFF + 4 * n) = acc[0][bj][m][n]; }
            if (wr == 1 && fr == 15) {
#pragma unroll
                for (int m = 2; m < 4; ++m)
#pragma unroll
                    for (int bj = 0; bj < 2; ++bj)
#pragma unroll
                        for (int n = 0; n < 2; ++n) *(f32x4*)(hb + (size_t)m * NUP + bj * DFF + 4 * n) = acc[1][bj][m][n]; } }
#pragma unroll
        for (int ai = 0; ai < 2; ++ai) { const int grp = 2 * ai + wr; u32x2 o0[4];
#pragma unroll
            for (int n = 0; n < 2; ++n) { f32x4 gval[4];
#pragma unroll
                for (int bj = 0; bj < 2; ++bj) {
                    const f32x4 w0 = *(const PG8_LAS f32x4*)(prm + (0 + bj) * 128 + chw + 4 * n), w1 = *(const PG8_LAS f32x4*)(prm + (2 + bj) * 128 + chw + 4 * n), w2 = *(const PG8_LAS f32x4*)(prm + (4 + bj) * 128 + chw + 4 * n), bb = *(const PG8_LAS f32x4*)(prm + (6 + bj) * 128 + chw + 4 * n);
                    const f32x4 hp = grp > 0 ? *(const PG8_LAS f32x4*)(edge + ((grp - 1) * 2 + 1) * 256 + bj * HALF + chw + 4 * n) : (f32x4){0.f, 0.f, 0.f, 0.f};
                    const f32x4 hn = grp < 3 ? *(const PG8_LAS f32x4*)(edge + ((grp + 1) * 2 + 0) * 256 + bj * HALF + chw + 4 * n) : (f32x4){0.f, 0.f, 0.f, 0.f};
                    f32x4 pfirst, nlast;
#pragma unroll
                    for (int j = 0; j < 4; ++j) { pfirst[j] = __int_as_float(__builtin_amdgcn_update_dpp(__float_as_int(hp[j]), __float_as_int(acc[ai][bj][3][n][j]), 0x111, 0xf, 0xf, false));
                                                  nlast[j] = __int_as_float(__builtin_amdgcn_update_dpp(__float_as_int(hn[j]), __float_as_int(acc[ai][bj][0][n][j]), 0x101, 0xf, 0xf, false)); }
#pragma unroll
                    for (int m = 0; m < 4; ++m) { const f32x4 pv = m > 0 ? acc[ai][bj][m - 1][n] : pfirst, nx = m < 3 ? acc[ai][bj][m + 1][n] : nlast;
                        const f32x4 val = bb + w0 * pv + w1 * acc[ai][bj][m][n] + w2 * nx;
                        if (bj == 0) gval[m] = val;
                        else { f32x4 e;
#pragma unroll
                            for (int j = 0; j < 4; ++j) e[j] = __builtin_amdgcn_exp2f(gval[m][j]);
                            e = e + 1.0f;
#pragma unroll
                            for (int j = 0; j < 4; ++j) e[j] = __builtin_amdgcn_rcpf(e[j]);
                            const f32x4 o = gval[m] * val * e;
                            u32x2 w; w.x = cvt_pk_bf16(o[0], o[1]); w.y = cvt_pk_bf16(o[2], o[3]);
                            if (n == 0) o0[m] = w;
                            else { u32x4 w4; w4.x = o0[m].x; w4.y = o0[m].y; w4.z = w.x; w4.w = w.y;
                                gst16<TAG>(ACT + (size_t)(u.pm * BM + ai * HALF + wr * 64 + 4 * fr + m) * ALD + u.pn * HALF + chw, w4); } } }
                    __builtin_amdgcn_sched_barrier(0); } } }
    }
};

template <class Epi, class Sched, bool ALIGN_EPI = false, bool SP2 = false>
__device__ __forceinline__ void gemm_phase(PG8_LAS unsigned char* lds, const Gemm g, const Sched& S, const Epi& E, int wave0  ) {
    int tid_ = wave0 * 64 + lane_now(); asm volatile("" : "+v"(tid_));
    const int tid = tid_, wid = __builtin_amdgcn_readfirstlane(tid >> 6), lane = tid & 63, wr = wid >> 2, wc = wid & 3, fr = lane & 15, fq = lane >> 4;
    const int K = g.K, nt = K / BK;
    unsigned voffA[2], voffB[2];
#pragma unroll
    for (int i = 0; i < 2; ++i) { int R, C; stage_rc(tid * 16 + i * 8192, R, C); const int Rb = Epi::PERM ? ((R & ~31) + perm32(R & 31)) : R;
        const int Ra = (Epi::TAG == 6) ? ((R & ~63) + 4 * (R & 15) + ((R & 63) >> 4)) : R;
        voffA[i] = (unsigned)(Ra * g.lda + C) * 2u; voffB[i] = (unsigned)(Rb * g.ldb + C) * 2u; }
    const size_t kstep = (size_t)(BK * 2);
    const size_t hstepA = (size_t)HALF * g.lda * 2, hstepB = g.b_hstep;
    const size_t tstepA = 2 * hstepA, tstepB = g.b_tstep;
    const unsigned ldsw = (unsigned)wid * 1024u;
    const int aoff = lds_byte(wr * 64 + fr, fq * 8), boff = lds_byte(wc * 32 + fr, fq * 8);
#define PG8_SA(b, h) (((b) * 2 + (h)) * HTB)
#define PG8_SB(b, h) ((4 + (b) * 2 + (h)) * HTB)
#define PG8_STAGE(bufoff, gbase, voff) do { _Pragma("unroll") for (int _i = 0; _i < 2; ++_i) { unsigned vo_ = (voff)[_i]; asm volatile("" : "+v"(vo_));     \
        __builtin_amdgcn_global_load_lds((const unsigned*)((const char*)(gbase) + vo_), (PG8_LAS unsigned*)(lds + (bufoff) + ldsw + _i * 8192), 16, 0, 0); } } while (0)
#define PG8_LDA(dst, b, h) do { _Pragma("unroll") for (int m = 0; m < 4; ++m) _Pragma("unroll") for (int k = 0; k < 2; ++k) dst[m][k] = *(const PG8_LAS bf16x8*)(lds + PG8_SA(b, h) + aoff + m * 2048 + k * 1024); } while (0)
#define PG8_LDB(dst, b, h) do { _Pragma("unroll") for (int n = 0; n < 2; ++n) _Pragma("unroll") for (int k = 0; k < 2; ++k) dst[n][k] = *(const PG8_LAS bf16x8*)(lds + PG8_SB(b, h) + boff + n * 2048 + k * 1024); } while (0)
#define PG8_MMA(ai, bj, At, Bt) do { __builtin_amdgcn_s_setprio(1); _Pragma("unroll") for (int m = 0; m < 4; ++m) _Pragma("unroll") for (int n = 0; n < 2; ++n) _Pragma("unroll") for (int k = 0; k < 2; ++k) \
        acc[ai][bj][m][n] = __builtin_amdgcn_mfma_f32_16x16x32_bf16(Bt[n][k], At[m][k], acc[ai][bj][m][n], 0, 0, 0); __builtin_amdgcn_s_setprio(0); } while (0)
#define PG8_WAIT_V(n) asm volatile("s_waitcnt vmcnt(" #n ")" ::: "memory")
#define PG8_WAIT_L(n) asm volatile("s_waitcnt lgkmcnt(" #n ")" ::: "memory")
#define PG8_BAR __builtin_amdgcn_s_barrier()
#define PG8_SCHED __builtin_amdgcn_sched_barrier(0)
    Unit cur, nxt; int ui = 0;
    if (!S.next(0, cur)) return;
    f32x4 acc[2][2][4][2];
#pragma unroll
    for (int a = 0; a < 2; ++a)
#pragma unroll
        for (int b = 0; b < 2; ++b)
#pragma unroll
            for (int m = 0; m < 4; ++m)
#pragma unroll
                for (int n = 0; n < 2; ++n) acc[a][b][m][n] = (f32x4){0.f, 0.f, 0.f, 0.f};
    bf16x8 At[4][2], B0[2][2], B1[2][2];
    const char* cA = (const char*)g.A + (size_t)cur.pm * tstepA + S.acol(cur); const char* cB = (const char*)g.Bt + (size_t)cur.pn * tstepB + S.bcol(cur);
    S.a_ready(cur);
    if constexpr (SP2) {
        PG8_STAGE(PG8_SB(0, 0), cB, voffB); PG8_STAGE(PG8_SB(0, 1), cB + hstepB, voffB); PG8_STAGE(PG8_SA(0, 0), cA, voffA); PG8_STAGE(PG8_SA(0, 1), cA + hstepA, voffA);
        if (wr == 1) PG8_BAR;
        PG8_WAIT_V(2); PG8_BAR;
        PG8_STAGE(PG8_SB(1, 0), cB + kstep, voffB); PG8_STAGE(PG8_SA(1, 0), cA + kstep, voffA); PG8_STAGE(PG8_SB(1, 1), cB + hstepB + kstep, voffB);
        PG8_WAIT_V(6); PG8_BAR;
    } else {
        PG8_STAGE(PG8_SB(0, 0), cB, voffB); PG8_STAGE(PG8_SA(0, 0), cA, voffA); PG8_STAGE(PG8_SB(0, 1), cB + hstepB, voffB); PG8_STAGE(PG8_SA(0, 1), cA + hstepA, voffA);
        if (wr == 1) PG8_BAR;
        PG8_WAIT_V(4); PG8_BAR;
        PG8_STAGE(PG8_SB(1, 0), cB + kstep, voffB); PG8_STAGE(PG8_SA(1, 0), cA + kstep, voffA); PG8_STAGE(PG8_SB(1, 1), cB + hstepB + kstep, voffB);
        PG8_WAIT_V(6); PG8_BAR;
    }
    f32x4 epre = {0.f, 0.f, 0.f, 0.f};
    if constexpr (Epi::TAG == 7) epre = E.pre(cur, tid);
    for (;;) {
        if constexpr (Epi::TAG == 6) epre = E.pre(cur, tid);
        const bool has_next = S.next(ui + 1, nxt);
        const char* nA = has_next ? (const char*)g.A + (size_t)nxt.pm * tstepA + S.acol(nxt) : cA; const char* nB = has_next ? (const char*)g.Bt + (size_t)nxt.pn * tstepB + S.bcol(nxt) : cB;
#ifdef MK_KREP
        const int ntt = nt * Epi::KREP;
        for (int t0_ = 0; t0_ < ntt; t0_ += 2) {
            const bool last = (t0_ == ntt - 2); const int t = t0_ % nt, tw = (t + 2) % nt;
#else
        for (int t = 0; t < nt; t += 2) {
            const bool last = (t == nt - 2); const int tw = t + 2;
#endif
            const char* a1 = cA + (size_t)(t + 1) * kstep;
            const char* a2 = last ? nA : cA + (size_t)tw * kstep; const char* b2 = last ? nB : cB + (size_t)tw * kstep;
            const char* a3 = a2 + kstep; const char* b3 = b2 + kstep;
            if (last && has_next) S.a_ready(nxt);
            if constexpr (SP2) {
            PG8_LDB(B0, 0, 0); PG8_LDB(B1, 0, 1); PG8_SCHED; PG8_LDA(At, 0, 0); PG8_STAGE(PG8_SA(1, 1), a1 + hstepA, voffA);
            PG8_WAIT_V(8); PG8_WAIT_L(0); PG8_BAR; PG8_MMA(0, 0, At, B0); PG8_MMA(0, 1, At, B1); PG8_BAR; PG8_SCHED;
            PG8_LDA(At, 0, 1); PG8_STAGE(PG8_SB(0, 0), b2, voffB); PG8_STAGE(PG8_SB(0, 1), b2 + hstepB, voffB); PG8_STAGE(PG8_SA(0, 0), a2, voffA);
            PG8_WAIT_V(8); PG8_WAIT_L(0); PG8_BAR; PG8_MMA(1, 0, At, B0); PG8_MMA(1, 1, At, B1); PG8_BAR; PG8_SCHED;
            PG8_LDB(B0, 1, 0); PG8_LDB(B1, 1, 1); PG8_SCHED; PG8_LDA(At, 1, 0); PG8_STAGE(PG8_SA(0, 1), a2 + hstepA, voffA);
            PG8_WAIT_V(8); PG8_WAIT_L(0); PG8_BAR; PG8_MMA(0, 0, At, B0); PG8_MMA(0, 1, At, B1); PG8_BAR; PG8_SCHED;
            PG8_LDA(At, 1, 1); PG8_STAGE(PG8_SB(1, 0), b3, voffB); PG8_STAGE(PG8_SB(1, 1), b3 + hstepB, voffB); PG8_STAGE(PG8_SA(1, 0), a3, voffA);
            PG8_WAIT_V(8); PG8_WAIT_L(0); PG8_BAR; PG8_MMA(1, 0, At, B0); PG8_MMA(1, 1, At, B1); PG8_BAR; PG8_SCHED;
            } else {
            PG8_LDB(B0, 0, 0); PG8_SCHED; PG8_LDA(At, 0, 0); PG8_STAGE(PG8_SA(1, 1), a1 + hstepA, voffA);
            PG8_WAIT_L(8); PG8_BAR; PG8_WAIT_L(0); PG8_MMA(0, 0, At, B0); PG8_BAR; PG8_SCHED;
            PG8_LDB(B1, 0, 1); PG8_STAGE(PG8_SB(0, 0), b2, voffB);
            PG8_BAR; PG8_WAIT_L(0); PG8_MMA(0, 1, At, B1); PG8_BAR;
            PG8_LDA(At, 0, 1); PG8_STAGE(PG8_SA(0, 0), a2, voffA);
            PG8_BAR; PG8_WAIT_L(0); PG8_MMA(1, 0, At, B0); PG8_BAR; PG8_SCHED;
            PG8_STAGE(PG8_SB(0, 1), b2 + hstepB, voffB);
            PG8_WAIT_V(6); PG8_BAR; PG8_MMA(1, 1, At, B1); PG8_BAR;
            PG8_LDB(B0, 1, 0); PG8_SCHED; PG8_LDA(At, 1, 0); PG8_STAGE(PG8_SA(0, 1), a2 + hstepA, voffA);
            PG8_WAIT_L(8); PG8_BAR; PG8_WAIT_L(0); PG8_MMA(0, 0, At, B0); PG8_BAR; PG8_SCHED;
            PG8_LDB(B1, 1, 1); PG8_STAGE(PG8_SB(1, 0), b3, voffB);
            PG8_BAR; PG8_WAIT_L(0); PG8_MMA(0, 1, At, B1); PG8_BAR;
            PG8_LDA(At, 1, 1); PG8_STAGE(PG8_SA(1, 0), a3, voffA);
            PG8_BAR; PG8_WAIT_L(0); PG8_MMA(1, 0, At, B0); PG8_BAR; PG8_SCHED;
            PG8_STAGE(PG8_SB(1, 1), b3 + hstepB, voffB);
            PG8_WAIT_V(6); PG8_BAR; PG8_MMA(1, 1, At, B1); PG8_BAR;
            }
        }
        if constexpr (ALIGN_EPI) { if (wr == 0) PG8_BAR; }
        #ifdef MK_KREP
        if constexpr (Epi::KREP > 1) {
#pragma unroll
            for (int a = 0; a < 2; ++a)
#pragma unroll
                for (int b = 0; b < 2; ++b)
#pragma unroll
                    for (int m = 0; m < 4; ++m)
#pragma unroll
                        for (int n = 0; n < 2; ++n) acc[a][b][m][n] *= (1.0f / Epi::KREP); }
#endif
        if constexpr (!Epi::AFTER_DRAIN) { int t2 = lane_now(); asm volatile("" : "+v"(t2));
            if constexpr (Epi::TAG == 6) E(acc, cur, wr, wc, t2 & 15, (t2 & 63) >> 4, epre); else E(acc, cur, wr, wc, t2 & 15, (t2 & 63) >> 4);
#ifdef MK_EPI2
            if constexpr (Epi::TAG == MK_EPI2 && Epi::TAG != 6) { asm volatile("" ::: "memory"); E(acc, cur, wr, wc, t2 & 15, (t2 & 63) >> 4); }
#endif
            S.done(cur); }
        if (!has_next) break;
#pragma unroll
        for (int a = 0; a < 2; ++a)
#pragma unroll
            for (int b = 0; b < 2; ++b)
#pragma unroll
                for (int m = 0; m < 4; ++m)
#pragma unroll
                    for (int n = 0; n < 2; ++n) acc[a][b][m][n] = (f32x4){0.f, 0.f, 0.f, 0.f};
        cur = nxt; cA = nA; cB = nB; ++ui;
        if constexpr (ALIGN_EPI) { if (wr == 1) PG8_BAR; }
    }
    PG8_WAIT_V(0);
    if constexpr (!ALIGN_EPI) { if (wr == 0) PG8_BAR; }
    PG8_BAR;
    if constexpr (Epi::AFTER_DRAIN) { if constexpr (Epi::TAG == 7) E.fused(acc, cur, wr, wc, fr, fq, lds, epre); else E.fused(acc, cur, wr, wc, fr, fq, lds, wid, lane); S.done(cur); }
#undef PG8_SA
#undef PG8_SB
#undef PG8_STAGE
#undef PG8_LDA
#undef PG8_LDB
#undef PG8_MMA
#undef PG8_WAIT_V
#undef PG8_WAIT_L
#undef PG8_BAR
#undef PG8_SCHED
}

__device__ __forceinline__ void gate_stage(PG8_LAS unsigned char* lds, const Gemm g, int pm, int pn, int wave0) {
    int tid_ = wave0 * 64 + lane_now(); asm volatile("" : "+v"(tid_));
    const int tid = tid_, wid = __builtin_amdgcn_readfirstlane(tid >> 6);
    const unsigned ldsw = (unsigned)wid * 1024u;
    const char* cA = (const char*)g.A + (size_t)pm * (2 * (size_t)HALF * g.lda * 2) + (size_t)(pn >> 1) * 256; const char* cB = (const char*)g.Bt + (size_t)pn * g.b_tstep;
    const size_t hstepA = (size_t)HALF * g.lda * 2, hstepB = g.b_hstep;
#pragma unroll
    for (int i = 0; i < 2; ++i) { int R, C; stage_rc(tid * 16 + i * 8192, R, C); const int Rb = (R & ~31) + perm32(R & 31);
        const unsigned voA = (unsigned)(R * g.lda + C) * 2u, voB = (unsigned)(Rb * g.ldb + C) * 2u;
#pragma unroll
        for (int b = 0; b < 2; ++b)
#pragma unroll
            for (int h = 0; h < 2; ++h) {
                __builtin_amdgcn_global_load_lds((const unsigned*)(cA + h * hstepA + b * (BK * 2) + voA), (PG8_LAS unsigned*)(lds + ((b * 2 + h) * HTB) + ldsw + i * 8192), 16, 0, 0);
                __builtin_amdgcn_global_load_lds((const unsigned*)(cB + h * hstepB + b * (BK * 2) + voB), (PG8_LAS unsigned*)(lds + ((4 + b * 2 + h) * HTB) + ldsw + i * 8192), 16, 0, 0); } }
}
__device__ __forceinline__ void gate_compute(const PG8_LAS unsigned char* lds, f32x4 (&acc)[2][2][4][2], int wr, int wc, int fr, int fq) {
    const int aoff = lds_byte(wr * 64 + fr, fq * 8), boff = lds_byte(wc * 32 + fr, fq * 8);
#pragma unroll
    for (int a = 0; a < 2; ++a)
#pragma unroll
        for (int b = 0; b < 2; ++b)
#pragma unroll
            for (int m = 0; m < 4; ++m)
#pragma unroll
                for (int n = 0; n < 2; ++n) acc[a][b][m][n] = (f32x4){0.f, 0.f, 0.f, 0.f};
#pragma unroll
    for (int kb = 0; kb < 2; ++kb) { bf16x8 B0[2][2], B1[2][2];
#pragma unroll
        for (int n = 0; n < 2; ++n)
#pragma unroll
            for (int k = 0; k < 2; ++k) { B0[n][k] = *(const PG8_LAS bf16x8*)(lds + (4 + kb * 2 + 0) * HTB + boff + n * 2048 + k * 1024); B1[n][k] = *(const PG8_LAS bf16x8*)(lds + (4 + kb * 2 + 1) * HTB + boff + n * 2048 + k * 1024); }
#pragma unroll
        for (int ai = 0; ai < 2; ++ai) { bf16x8 At[4][2];
#pragma unroll
            for (int m = 0; m < 4; ++m)
#pragma unroll
                for (int k = 0; k < 2; ++k) At[m][k] = *(const PG8_LAS bf16x8*)(lds + (kb * 2 + ai) * HTB + aoff + m * 2048 + k * 1024);
#pragma unroll
            for (int m = 0; m < 4; ++m)
#pragma unroll
                for (int n = 0; n < 2; ++n)
#pragma unroll
                    for (int k = 0; k < 2; ++k) { acc[ai][0][m][n] = __builtin_amdgcn_mfma_f32_16x16x32_bf16(B0[n][k], At[m][k], acc[ai][0][m][n], 0, 0, 0);
                                                  acc[ai][1][m][n] = __builtin_amdgcn_mfma_f32_16x16x32_bf16(B1[n][k], At[m][k], acc[ai][1][m][n], 0, 0, 0); } } }
}
}

#define GAS __attribute__((address_space(1)))
#define LAS __attribute__((address_space(3)))
typedef unsigned short bf16;
typedef unsigned v4u __attribute__((ext_vector_type(4)));
typedef float f32x4 __attribute__((ext_vector_type(4)));
typedef short bf16x8 __attribute__((ext_vector_type(8)));
typedef GAS unsigned gu32;
typedef GAS unsigned long long gu64;
#define RLX_AGENT __ATOMIC_RELAXED, __HIP_MEMORY_SCOPE_AGENT
#define LDS_WAIT() asm volatile("s_waitcnt lgkmcnt(0)" ::: "memory")
#define VM_WAIT() asm volatile("s_waitcnt vmcnt(0)" ::: "memory")
__device__ __forceinline__ unsigned long long rt() { return __builtin_amdgcn_s_memrealtime(); }
__device__ __forceinline__ unsigned f2bf(float f) { unsigned u = __builtin_bit_cast(unsigned, f); return (u + 0x7fffu + ((u >> 16) & 1u)) >> 16; }
__device__ __forceinline__ unsigned pk2(float lo, float hi) { unsigned r; asm("v_cvt_pk_bf16_f32 %0, %1, %2" : "=v"(r) : "v"(lo), "v"(hi)); return r; }

#define XB_TMO      128
#define XB_XCNT(j)  (256  + 64 * (j))
#define XB_XSUB(j)  (1280 + 64 * (j))
#define XB_XGEN(j)  (2304 + 64 * (j))
#define XB_TOP      3328
#define XB_TOPGEN   3392
#define XCD_BAR_WORDS 3456
#define XB_SPIN_CAP (1u << 18)

__device__ __forceinline__ unsigned xb_ld(unsigned* p)              { return __hip_atomic_load(p, __ATOMIC_RELAXED, __HIP_MEMORY_SCOPE_AGENT); }
__device__ __forceinline__ unsigned xb_add(unsigned* p, unsigned v) { return __hip_atomic_fetch_add(p, v, __ATOMIC_RELAXED, __HIP_MEMORY_SCOPE_AGENT); }
__device__ __forceinline__ unsigned xb_xcc_id() { return (unsigned)__builtin_amdgcn_s_getreg((3 << 11) | 20) & 0xFu; }
#define XB_SPIN(cond, bar) do { unsigned _sp = 0; while (cond) { __builtin_amdgcn_s_sleep(1); \
    if ((++_sp & 255u) == 0u) { if (xb_ld(&(bar)[XB_TMO])) break; if (_sp > XB_SPIN_CAP) { atomicAdd(&(bar)[XB_TMO], 1u); break; } } } } while (0)

struct XcdBarrier {
    unsigned* bar; unsigned x;
    volatile LAS unsigned* st;
};

__device__ __forceinline__ XcdBarrier xcd_barrier_post(unsigned* bar, volatile LAS unsigned* st, bool t0  ) {
    XcdBarrier b; b.bar = bar; b.x = xb_xcc_id(); b.st = st;
    if (t0) (void)xb_add(&bar[XB_XCNT(b.x)], 1u);
    return b;
}
__device__ __forceinline__ void xcd_barrier_complete(unsigned* bar, unsigned x, unsigned& nloc, unsigned& nx) {
    const unsigned G = gridDim.x * gridDim.y * gridDim.z;
    unsigned sum, cnt, mine, sp = 0u;
    for (;;) {
        sum = 0u; cnt = 0u; mine = 0u;
#pragma unroll
        for (unsigned j = 0; j < 16; ++j) { const unsigned c = xb_ld(&bar[XB_XCNT(j)]); sum += c; cnt += (c > 0u) ? 1u : 0u; mine = (j == x) ? c : mine; }
        if (sum == G) break;
        __builtin_amdgcn_s_sleep(1);
        if ((++sp & 255u) == 0u) { if (xb_ld(&bar[XB_TMO])) break; if (sp > XB_SPIN_CAP) { atomicAdd(&bar[XB_TMO], 1u); break; } }
    }
    nloc = mine > 0u ? mine : 1u; nx = cnt > 0u ? cnt : 1u;
}

__device__ __forceinline__ void xcd_barrier(const XcdBarrier& b, bool t0  ) {
    asm volatile("s_waitcnt vmcnt(0)" ::: "memory");
    __syncthreads();
    if (t0) {
        unsigned* bar = b.bar; asm volatile("" : "+s"(bar));
        __builtin_amdgcn_s_waitcnt(0);
        unsigned nloc = b.st[0], nx = b.st[1];
        if (nloc == 0u) { xcd_barrier_complete(bar, b.x, nloc, nx); b.st[0] = nloc; b.st[1] = nx; }
        const unsigned old = xb_add(&bar[XB_XSUB(b.x)], 1u);
        const unsigned gen = old / nloc;
        if (old + 1u == (gen + 1u) * nloc) {
            __builtin_amdgcn_fence(__ATOMIC_RELEASE, "agent");
            asm volatile("s_waitcnt vmcnt(0)" ::: "memory");
            const unsigned og = xb_add(&bar[XB_TOP], 1u);
            const unsigned tg = og / nx;
            if (og + 1u == (tg + 1u) * nx) xb_add(&bar[XB_TOPGEN], 1u);
            else XB_SPIN(xb_ld(&bar[XB_TOPGEN]) == tg, bar);
            __builtin_amdgcn_fence(__ATOMIC_ACQUIRE, "agent");
            xb_add(&bar[XB_XGEN(b.x)], 1u);
            asm volatile("s_waitcnt vmcnt(0)" ::: "memory");
        } else {
            XB_SPIN(xb_ld(&bar[XB_XGEN(b.x)]) == gen, bar);
            __builtin_amdgcn_fence(__ATOMIC_ACQUIRE, "agent");
            asm volatile("s_waitcnt vmcnt(0)" ::: "memory");
        }
    }
    __syncthreads();
}

namespace att {
using bf16x8 = __attribute__((ext_vector_type(8))) short;
using s16x4  = __attribute__((ext_vector_type(4))) short;
using f32x16 = __attribute__((ext_vector_type(16))) float;
using u32x4  = __attribute__((ext_vector_type(4))) unsigned;
using f32x4  = __attribute__((ext_vector_type(4))) float;
typedef unsigned short bf16;
constexpr int QBLK = 32, KVBLK = 64, NW = 8;
constexpr float SCALE = 0.07216878364870322f;
constexpr float THR = 8.f;
constexpr int LDQ = NQ, LDKN = D, LDKR = ROPE, LDV = D, LDO = D;
constexpr int SHM_V = KVBLK * 128 * 2, SHM_K = KVBLK * 128 * 2, SHM_R = KVBLK * 64 * 2;
constexpr int OFF_V = 0  , OFF_K = 3 * SHM_V  , OFF_R = OFF_K + 2 * SHM_K  , OFF_QR = OFF_R + 2 * SHM_R  , ATTN_LDS_BYTES = OFF_QR + NW * 4096;
#define KSWZ(row, colB) ((row) * 256 + ((colB) ^ (((row) & 7) << 4)))
#define RSWZ(row, colB) ((row) * 128 + ((colB) ^ ((((row) >> 1) & 7) << 4)))
#define SBAR() __builtin_amdgcn_sched_barrier(0)
__device__ __forceinline__ int crow(int r, int hi) { return (r & 3) + 8 * (r >> 2) + 4 * hi; }
__device__ __forceinline__ unsigned cvtpk(float lo, float hi) { unsigned r; asm("v_cvt_pk_bf16_f32 %0, %1, %2" : "=v"(r) : "v"(lo), "v"(hi)); return r; }
#define ATT_INTERLEAVE() do { _Pragma("unroll") for (int i_ = 0; i_ < 12; ++i_) { __builtin_amdgcn_sched_group_barrier(0x100, 3, 0); __builtin_amdgcn_sched_group_barrier(0x008, 2, 0); __builtin_amdgcn_sched_group_barrier(0x002, 12, 0); } } while (0)

__device__ __forceinline__ void partialSM(f32x16& p0, f32x16& p1, float& m_reg, float& mn, float& alpha) {
  constexpr float C = SCALE * 1.4426950408889634f;
  float pmax = p0[0];
#pragma unroll
  for (int r = 1; r < 16; ++r) pmax = fmaxf(pmax, p0[r]);
#pragma unroll
  for (int r = 0; r < 16; ++r) pmax = fmaxf(pmax, p1[r]);
  { auto rr = __builtin_amdgcn_permlane32_swap(__float_as_uint(pmax), __float_as_uint(pmax), false, false);
    pmax = fmaxf(__uint_as_float(rr[0]), __uint_as_float(rr[1])); }
  if (__builtin_expect(__all(pmax - m_reg <= THR / SCALE), 1)) { mn = m_reg; alpha = 1.f; }
  else { mn = fmaxf(m_reg, pmax); alpha = __builtin_amdgcn_exp2f((m_reg - mn) * C); m_reg = mn; }
  float mnC = -mn * C;
#pragma unroll
  for (int r = 0; r < 16; ++r) p0[r] = fmaf(p0[r], C, mnC);
#pragma unroll
  for (int r = 0; r < 16; ++r) p1[r] = fmaf(p1[r], C, mnC);
#pragma unroll
  for (int r = 0; r < 16; ++r) p0[r] = __builtin_amdgcn_exp2f(p0[r]);
}
__device__ __forceinline__ void finishSM(f32x16& p0, f32x16& p1, float alpha, float& l_reg, bf16x8& pa0, bf16x8& pa1, bf16x8& pa2, bf16x8& pa3) {
#pragma unroll
  for (int r = 0; r < 16; ++r) p1[r] = __builtin_amdgcn_exp2f(p1[r]);
  float ps = 0;
#pragma unroll
  for (int r = 0; r < 16; ++r) ps += p0[r];
#pragma unroll
  for (int r = 0; r < 16; ++r) ps += p1[r];
  { auto rr = __builtin_amdgcn_permlane32_swap(__float_as_uint(ps), __float_as_uint(ps), false, false);
    ps = __uint_as_float(rr[0]) + __uint_as_float(rr[1]); }
  l_reg = l_reg * alpha + ps;
#define PK4(P, BASE, OUT) do { unsigned a0 = cvtpk(P[BASE + 0], P[BASE + 1]), a1 = cvtpk(P[BASE + 2], P[BASE + 3]);   \
    unsigned b0 = cvtpk(P[BASE + 4], P[BASE + 5]), b1 = cvtpk(P[BASE + 6], P[BASE + 7]);                              \
    auto r0 = __builtin_amdgcn_permlane32_swap(a0, b0, false, false); auto r1 = __builtin_amdgcn_permlane32_swap(a1, b1, false, false); \
    u32x4 w = {r0[0], r1[0], r0[1], r1[1]}; OUT = *reinterpret_cast<bf16x8*>(&w); } while (0)
  PK4(p0, 0, pa0); PK4(p0, 8, pa1); PK4(p1, 0, pa2); PK4(p1, 8, pa3);
#undef PK4
}
__device__ __forceinline__ void qkt(f32x16& p0, f32x16& p1, const char* Ks, const char* Rs, const char* Qs, const char* Q7s  , const bf16x8* qr, int r32, int hi) {
  p0 = f32x16{}; p1 = f32x16{};
  bf16x8 b0 = *reinterpret_cast<const bf16x8*>(Ks + KSWZ(r32, (hi * 8) * 2)), b1 = *reinterpret_cast<const bf16x8*>(Ks + KSWZ(32 + r32, (hi * 8) * 2)), qf = qr[0];
#pragma unroll
  for (int d0 = 0; d0 < 12; ++d0) {
    bf16x8 n0 = b0, n1 = b1, nq = qf;
    if (d0 + 1 < 8) { const int cb = ((d0 + 1) * 16 + hi * 8) * 2; n0 = *reinterpret_cast<const bf16x8*>(Ks + KSWZ(r32, cb)); n1 = *reinterpret_cast<const bf16x8*>(Ks + KSWZ(32 + r32, cb)); if (d0 + 1 < 7) nq = qr[d0 + 1]; else nq = *reinterpret_cast<const bf16x8*>(Q7s); }
    else if (d0 + 1 < 12) { const int cb = ((d0 + 1 - 8) * 16 + hi * 8) * 2; n0 = *reinterpret_cast<const bf16x8*>(Rs + RSWZ(r32, cb)); n1 = *reinterpret_cast<const bf16x8*>(Rs + RSWZ(32 + r32, cb)); nq = *reinterpret_cast<const bf16x8*>(Qs + RSWZ(r32, cb)); }
    p0 = __builtin_amdgcn_mfma_f32_32x32x16_bf16(b0, qf, p0, 0, 0, 0);
    p1 = __builtin_amdgcn_mfma_f32_32x32x16_bf16(b1, qf, p1, 0, 0, 0);
    b0 = n0; b1 = n1; qf = nq; }
}
__device__ __forceinline__ int v_st(int k, int c) { const int kk = (k & ~0xC) | ((k & 4) << 1) | ((k & 8) >> 1); return ((kk >> 3) * 4 + (c >> 5)) * 512 + ((kk & 7) * 32 + (c & 31)) * 2; }
__device__ __forceinline__ int v_rd_base(int lane) { return ((lane & 3) << 3) | (((lane >> 2) & 3) << 6) | (((lane >> 4) & 1) << 5) | (((lane >> 5) & 1) << 8); }
constexpr int v_rd_off(int d0, int ks, int half) { return d0 * 512 + ks * 4096 + half * 2048; }
template <int OFF> __device__ __forceinline__ s16x4 tr_read(int vb) {
  s16x4 r; asm volatile("ds_read_b64_tr_b16 %0, %1 offset:%2" : "=&v"(r) : "v"(vb), "i"(OFF) : "memory"); return r;
}
template <int D0> __device__ __forceinline__ void pv_one(f32x16& od, int vb, bf16x8 pa0, bf16x8 pa1, bf16x8 pa2, bf16x8 pa3) {
  const s16x4 l0 = tr_read<v_rd_off(D0, 0, 0)>(vb), h0 = tr_read<v_rd_off(D0, 0, 1)>(vb), l1 = tr_read<v_rd_off(D0, 1, 0)>(vb), h1 = tr_read<v_rd_off(D0, 1, 1)>(vb);
  const s16x4 l2 = tr_read<v_rd_off(D0, 2, 0)>(vb), h2 = tr_read<v_rd_off(D0, 2, 1)>(vb), l3 = tr_read<v_rd_off(D0, 3, 0)>(vb), h3 = tr_read<v_rd_off(D0, 3, 1)>(vb);
  asm volatile("s_waitcnt lgkmcnt(0)" ::: "memory"); SBAR();
#define PK(L, H) (bf16x8){L[0], L[1], L[2], L[3], H[0], H[1], H[2], H[3]}
  od = __builtin_amdgcn_mfma_f32_32x32x16_bf16(pa0, PK(l0, h0), od, 0, 0, 0);
  od = __builtin_amdgcn_mfma_f32_32x32x16_bf16(pa1, PK(l1, h1), od, 0, 0, 0);
  od = __builtin_amdgcn_mfma_f32_32x32x16_bf16(pa2, PK(l2, h2), od, 0, 0, 0);
  od = __builtin_amdgcn_mfma_f32_32x32x16_bf16(pa3, PK(l3, h3), od, 0, 0, 0);
#undef PK
}
__device__ __forceinline__ void pv_d0(f32x16* o, int vb, bf16x8 pa0, bf16x8 pa1, bf16x8 pa2, bf16x8 pa3) {
  pv_one<0>(o[0], vb, pa0, pa1, pa2, pa3); pv_one<1>(o[1], vb, pa0, pa1, pa2, pa3); pv_one<2>(o[2], vb, pa0, pa1, pa2, pa3); pv_one<3>(o[3], vb, pa0, pa1, pa2, pa3);
}

__device__ __forceinline__ void attn_unit(const bf16* __restrict__ Qb, const bf16* __restrict__ Kn, const bf16* __restrict__ Kr, const bf16* __restrict__ Vh,
                                          bf16* __restrict__ Ob, int seq, char* lds, char* wsl, int wave0) {
  int tid_ = wave0 * 64 + lane_now(); asm volatile("" : "+v"(tid_));
  const int tid = tid_, wid = __builtin_amdgcn_readfirstlane(tid >> 6), lane = tid & 63, r32 = lane & 31, hi = lane >> 5;
  float* ws = (float*)wsl + wid * 64; float* li_l = ws; float* al_l = ws + 32;
  float m_reg = -1e30f, l_reg = 0; f32x16 o[4] = {}; bf16x8 qr[7];
  typedef __attribute__((address_space(3))) unsigned lds_u32;
#define DMA_TILE(t, vs, ks) do { const bf16* gk_ = Kn + (size_t)(t) * KVBLK * LDKN; const bf16* gv_ = Vh + (size_t)(t) * KVBLK * LDV; const bf16* gr_ = Kr + (size_t)(t) * KVBLK * LDKR; \
    int ln_ = lane; asm volatile("" : "+v"(ln_)); \
    _Pragma("unroll") for (int i_ = 0; i_ < 2; ++i_) { const int L16 = wid * 128 + i_ * 64 + ln_; \
      const int rowk_ = L16 >> 4, ck_ = (L16 & 15) ^ (rowk_ & 7); \
      const int sub_ = L16 >> 5, wi_ = L16 & 31, kk_ = ((sub_ >> 2) << 3) | (wi_ >> 2), cv_ = ((sub_ & 3) << 5) + ((wi_ & 3) << 3), kv_ = (kk_ & ~0xC) | ((kk_ & 4) << 1) | ((kk_ & 8) >> 1); \
      __builtin_amdgcn_global_load_lds((const unsigned*)(gv_ + (unsigned)(kv_ * LDV + cv_)), (lds_u32*)(lds + OFF_V + (vs) + (wid * 128 + i_ * 64) * 16), 16, 0, 0); \
      __builtin_amdgcn_global_load_lds((const unsigned*)(gk_ + (unsigned)(rowk_ * LDKN + ck_ * 8)), (lds_u32*)(lds + OFF_K + (ks) * SHM_K + (wid * 128 + i_ * 64) * 16), 16, 0, 0); } \
    { const int L16 = wid * 64 + ln_, rowr_ = L16 >> 3, cr_ = (L16 & 7) ^ ((rowr_ >> 1) & 7); \
      __builtin_amdgcn_global_load_lds((const unsigned*)(gr_ + (unsigned)(rowr_ * LDKR + cr_ * 8)), (lds_u32*)(lds + OFF_R + (ks) * SHM_R + (wid * 64) * 16), 16, 0, 0); } } while (0)
#define TILE_SYNC() do { asm volatile("s_waitcnt vmcnt(0)" ::: "memory"); __syncthreads(); } while (0)
#define RESC(a) do { if (__any((a) < 1.f)) { if (hi == 0) al_l[r32] = (a); asm volatile("s_waitcnt lgkmcnt(0)" ::: "memory"); \
    _Pragma("unroll") for (int d = 0; d < 4; ++d) _Pragma("unroll") for (int r = 0; r < 16; ++r) o[d][r] *= al_l[crow(r, hi)]; } } while (0)
  const int NT = seq / KVBLK;
  int s0 = 0, s1 = SHM_V, s2 = 2 * SHM_V;
  DMA_TILE(0, s0, 0); DMA_TILE(1, s1, 1);
  const bf16* Qw = Qb + (long)(wid * QBLK + r32) * LDQ + hi * 8;
#pragma unroll
  for (int d0 = 0; d0 < 7; ++d0) qr[d0] = *reinterpret_cast<const bf16x8*>(Qw + d0 * 16);
  char* Q7s = wsl + 2048 + wid * 1024 + r32 * 32 + hi * 16;
  *reinterpret_cast<bf16x8*>(Q7s) = *reinterpret_cast<const bf16x8*>(Qw + 7 * 16);
  char* Qs = lds + OFF_QR + wid * 4096;
  { bf16x8 qx[4];
#pragma unroll
    for (int d0 = 0; d0 < 4; ++d0) qx[d0] = *reinterpret_cast<const bf16x8*>(Qw + (8 + d0) * 16);
#pragma unroll
    for (int d0 = 0; d0 < 4; ++d0) *reinterpret_cast<bf16x8*>(Qs + RSWZ(r32, (d0 * 16 + hi * 8) * 2)) = qx[d0]; }
  const int vb0 = (int)(uintptr_t)lds + OFF_V + v_rd_base(lane);
  TILE_SYNC();
  f32x16 pA0, pA1, pB0, pB1; float mnA, mnB, alA, alB; bf16x8 pa0, pa1, pa2, pa3;
  qkt(pA0, pA1, lds + OFF_K, lds + OFF_R, Qs, Q7s, qr, r32, hi); partialSM(pA0, pA1, m_reg, mnA, alA);
  for (int j = 0; j < NT; j += 2) {
    if (j + 2 < NT) DMA_TILE(j + 2, s2, 0);
    SBAR(); qkt(pB0, pB1, lds + OFF_K + SHM_K, lds + OFF_R + SHM_R, Qs, Q7s, qr, r32, hi);
#ifdef MK_AQ2
    asm volatile("" : "+v"(pB0), "+v"(pB1)); qkt(pB0, pB1, lds + OFF_K + SHM_K, lds + OFF_R + SHM_R, Qs, Q7s, qr, r32, hi);
#endif
    finishSM(pA0, pA1, alA, l_reg, pa0, pa1, pa2, pa3); SBAR();
    pv_d0(o, vb0 + s0, pa0, pa1, pa2, pa3);
#ifdef MK_APV2
    { bf16x8 z_ = {0, 0, 0, 0, 0, 0, 0, 0}; asm volatile("" : "+v"(z_)); pv_d0(o, vb0 + s0, z_, z_, z_, z_); }
#endif
    partialSM(pB0, pB1, m_reg, mnB, alB);
    TILE_SYNC(); RESC(alB);
    const bool more = j + 2 < NT;
    if (j + 3 < NT) DMA_TILE(j + 3, s0, 1);
    SBAR(); if (more) qkt(pA0, pA1, lds + OFF_K, lds + OFF_R, Qs, Q7s, qr, r32, hi);
#ifdef MK_AQ2
    asm volatile("" : "+v"(pA0), "+v"(pA1)); if (more) qkt(pA0, pA1, lds + OFF_K, lds + OFF_R, Qs, Q7s, qr, r32, hi);
#endif
    finishSM(pB0, pB1, alB, l_reg, pa0, pa1, pa2, pa3); SBAR();
    pv_d0(o, vb0 + s1, pa0, pa1, pa2, pa3);
#ifdef MK_APV2
    { bf16x8 z_ = {0, 0, 0, 0, 0, 0, 0, 0}; asm volatile("" : "+v"(z_)); pv_d0(o, vb0 + s1, z_, z_, z_, z_); }
#endif
    if (more) partialSM(pA0, pA1, m_reg, mnA, alA);
    TILE_SYNC(); if (more) RESC(alA);
    const int t_ = s0; s0 = s2; s2 = s1; s1 = t_;
  }
  { const int le = lane_now(), r32e = le & 31, hie = le >> 5; float* li_e = (float*)wsl + wid * 64;
    if (hie == 0) li_e[r32e] = l_reg; asm volatile("s_waitcnt lgkmcnt(0)" ::: "memory");
    float rli[16];
#pragma unroll
    for (int r = 0; r < 16; ++r) rli[r] = __builtin_amdgcn_rcpf(li_e[crow(r, hie)]);
    float* os = (float*)(lds + wid * 16384);
#pragma unroll
    for (int r = 0; r < 16; ++r) { const int orow = crow(r, hie);
#pragma unroll
      for (int d0 = 0; d0 < 4; ++d0) os[orow * 128 + d0 * 32 + r32e] = o[d0][r] * rli[r]; }
    asm volatile("s_waitcnt lgkmcnt(0)" ::: "memory");
    bf16* Ow = Ob + (long)(wid * QBLK) * LDO;
#pragma unroll
    for (int i = 0; i < 8; ++i) { const int ch = i * 64 + le, row = ch >> 4, c8 = (ch & 15) * 8;
      const f32x4* sp = (const f32x4*)(os + row * 128 + c8); const f32x4 a = sp[0], b = sp[1];
      u32x4 w = {cvtpk(a[0], a[1]), cvtpk(a[2], a[3]), cvtpk(b[0], b[1]), cvtpk(b[2], b[3])};
      *reinterpret_cast<u32x4*>(Ow + (long)row * LDO + c8) = w; } }
#undef DMA_TILE
#undef TILE_SYNC
#undef RESC
}
}

constexpr size_t MiB = 1u << 20;
constexpr size_t WS_CTL = 0, CTL_ZERO_BYTES = 64 * 1024;
constexpr size_t WS_MODS = 1 * MiB;
constexpr size_t WS_COS = 3 * MiB, WS_SIN = WS_COS + 128 * 1024, WS_SP = WS_SIN + 128 * 1024;
constexpr size_t WS_WIN = 4 * MiB, WS_WUQ = 14 * MiB, WS_WUKV = 20 * MiB, WS_WO = 28 * MiB, WS_WRIN = 44 * MiB, WS_WG = 76 * MiB, WS_WROUT = 80 * MiB, WS_WUP = 96 * MiB, WS_WDN = 272 * MiB;
constexpr size_t WS_X = 362 * MiB, WS_H = 490 * MiB, WS_S = 554 * MiB, WS_END = 1194 * MiB;
constexpr size_t WS_U = WS_S, WS_HALO = WS_S, WS_ACT = WS_S + 352 * MiB;
constexpr size_t WS_PROJ = WS_S, WS_CQ = WS_S + 80 * MiB, WS_CKV = WS_S + 96 * MiB, WS_KR = WS_S + 114 * MiB, WS_Q = WS_S + 117 * MiB, WS_KN = WS_S + 213 * MiB, WS_V = WS_S + 285 * MiB, WS_O = WS_S + 357 * MiB, WS_PKR = WS_S + 421 * MiB;
constexpr size_t WS_RIN = WS_S, WS_XC = WS_S + 128 * MiB, WS_LA = WS_S + 192 * MiB, WS_UU = WS_S + 320 * MiB, WS_HB = WS_S + 448 * MiB, WS_MIX = WS_S + 576 * MiB;
static_assert(WS_WIN + 2ull * NINP * D * 2 <= WS_WUQ && WS_WUQ + 2ull * NQ * QL * 2 <= WS_WUKV && WS_WUKV + 2ull * NKV * KVL * 2 <= WS_WO && WS_WO + 2ull * D * D * 2 <= WS_WRIN, "ws map 1");
static_assert(WS_WRIN + 2ull * 2 * D * D * 2 <= WS_WG && WS_WG + 2ull * 8192 * 128 * 2 <= WS_WROUT && WS_WROUT + 2ull * D * D * 2 <= WS_WUP && WS_WUP + 4ull * NUP * D * 2 <= WS_WDN && WS_WDN + 4ull * D * ALD * 2 <= WS_X, "ws map 2");
static_assert(WS_X + (size_t)NTOK * D * 2 <= WS_H && WS_H + (size_t)NTOK * D * 2 <= WS_S, "ws map 3");
static_assert(WS_U + (size_t)NTOK * NUP * 2 <= WS_ACT && WS_ACT + (size_t)NTOK * ALD * 2 <= WS_END, "ws map ffn");
static_assert(WS_PROJ + (size_t)NTOK * NINP * 4 <= WS_CQ && WS_CQ + (size_t)NTOK * QL * 2 <= WS_CKV && WS_CKV + (size_t)MKV * KVL * 2 <= WS_KR && WS_KR + (size_t)MKV * ROPE * 2 <= WS_Q && WS_Q + (size_t)NTOK * NQ * 2 <= WS_KN
              && WS_KN + (size_t)MKV * D * 2 <= WS_V && WS_V + (size_t)MKV * D * 2 <= WS_O && WS_O + (size_t)NTOK * D * 2 <= WS_END, "ws map attn");
static_assert(WS_RIN + (size_t)NTOK * 2 * D * 2 <= WS_XC && WS_XC + (size_t)NTOK * D * 2 <= WS_LA && WS_LA + 2ull * NTOK * D * 2 <= WS_UU && WS_UU + 2ull * NTOK * D * 2 <= WS_HB && WS_HB + (size_t)NTOK * D * 4 <= WS_MIX && WS_MIX + (size_t)NTOK * D * 2 <= WS_END, "ws map rec");
constexpr int CW_BAR = 1024;
constexpr size_t OUT_Y = 0, OUT_CKV = 2ull * MCTX * D, OUT_KR = OUT_CKV + 32ull * 2 * 256 * KVL, OUT_ST = OUT_KR + 32ull * 2 * 256 * ROPE, OUT_TOTAL = OUT_ST + 32ull * 2 * 2 * D;

constexpr int NWAVES = 8;
constexpr int RING_OFF = 0, RING_BYTES = 131072;
constexpr int LDSCTL_OFF = RING_BYTES, MISC_OFF = LDSCTL_OFF + 320;
constexpr int EDGE_OFF = LDSCTL_OFF + 2048;
constexpr int LDS_BYTES = 147456;
static_assert(MISC_OFF + 128 <= LDS_BYTES && att::ATTN_LDS_BYTES <= RING_BYTES, "LDS map");

struct Args { const float* in[32]; float* out; unsigned char* ws; int ph_lo, ph_hi; };
static_assert(sizeof(Args) == 34 * 8 + 8, "Args has no padding");
struct Frame {
    LAS unsigned char* lds;
    volatile LAS unsigned* MISC;
    int tid, lane, wave;
    int vcu, G;
    float* out;
    unsigned char* ws;
};
__device__ __forceinline__ float shfl_xor_l(float v, int mask, int lane) { return __int_as_float(__builtin_amdgcn_ds_bpermute((lane ^ mask) << 2, __float_as_int(v))); }
__device__ __forceinline__ float wave_sum(float v, int lane) {
#pragma unroll
    for (int o = 1; o < 64; o <<= 1) v += shfl_xor_l(v, o, lane);
    return v;
}
__device__ __forceinline__ int mod_of_row(int m) { return m < MCTX ? 0 : 1 + ((m - MCTX) >> 10); }
__device__ __forceinline__ int kv_row(int m) { return m < MCTX ? m : MCTX + ((m - MCTX) >> 10) * 1280 + 256 + ((m - MCTX) & 1023); }

__device__ __forceinline__ void p0_transpose_item(const float* W, int K, int N, bf16* WT, int row_off, LAS float* scr, int item, int lane, int ldw = 0) {
    if (ldw == 0) ldw = K;
    const int nblk = N / 32; int kb = item / nblk, nb = item % nblk;
#ifndef MK_TRMAP
#define MK_TRMAP 1
#endif
    if (MK_TRMAP == 1 && ((K / 64) & 3) == 0) {
        const int g = item >> 3, w = item & 7, gn = nblk >> 1, kg = g / gn, ng = g - kg * gn; kb = 4 * kg + (w >> 1); nb = 2 * ng + (w & 1); }
    if (MK_TRMAP == 2 && ((K / 64) & 7) == 0) {
        const int g = item >> 3, w = item & 7, kg = g / nblk, ng = g - kg * nblk; kb = 8 * kg + w; nb = ng; }
    const int k0 = 64 * kb, n0 = 32 * nb;
    float wv[32];
#pragma unroll
    for (int i = 0; i < 32; ++i) wv[i] = *(const GAS float*)(W + (size_t)(k0 + 2 * i + (lane >> 5)) * N + n0 + (lane & 31));
#pragma unroll
    for (int i = 0; i < 32; ++i) scr[(2 * i + (lane >> 5)) * 33 + (lane & 31)] = wv[i];
    LDS_WAIT(); asm volatile("" ::: "memory");
    const int c = lane & 7;
#pragma unroll
    for (int j = 0; j < 4; ++j) { const int n = (lane >> 3) + 8 * j; const LAS float* s = scr + (8 * c) * 33 + n;
        v4u o; o.x = pk2(s[0 * 33], s[1 * 33]); o.y = pk2(s[2 * 33], s[3 * 33]); o.z = pk2(s[4 * 33], s[5 * 33]); o.w = pk2(s[6 * 33], s[7 * 33]);
        *(GAS v4u*)(WT + (size_t)(row_off + n0 + n) * ldw + k0 + 8 * c) = o; }
    LDS_WAIT(); asm volatile("" ::: "memory");
}

__device__ __forceinline__ void ada_task(Frame& F, const Args& A, int task) {
    constexpr int CW = 192;
    const int layer = task >> 6, cchunk = task & 63, al = F.lane < 48 ? F.lane : 47;
    LAS float* S = (LAS float*)(F.lds + RING_OFF);
    const float* c_ctx = A.in[6]; const float* cc = A.in[5];
    { f32x4 cv[NMOD];
#pragma unroll
        for (int q = 0; q < NMOD; ++q) cv[q] = *(const GAS f32x4*)((q == 0 ? c_ctx : cc + (q - 1) * D) + 4 * F.tid);
#pragma unroll
        for (int q = 0; q < NMOD; ++q)
#pragma unroll
            for (int i = 0; i < 4; ++i) { const float v = cv[q][i]; S[(4 * F.tid + i) * 12 + q] = v / (1.0f + __expf(-v)); } }
    __syncthreads();
    f32x4 acc[NMOD];
#pragma unroll
    for (int q = 0; q < NMOD; ++q) acc[q] = (f32x4){0.f, 0.f, 0.f, 0.f};
    const int k0 = F.wave * 256;
    const float* wp = A.in[10] + ((size_t)layer * D + k0) * ADA_N + cchunk * CW + al * 4;
    for (int kk = 0; kk < 256; kk += 8) {
        f32x4 w[8];
#pragma unroll
        for (int i = 0; i < 8; ++i) w[i] = *(const GAS f32x4*)(wp + (size_t)(kk + i) * ADA_N);
#pragma unroll
        for (int i = 0; i < 8; ++i) { const LAS f32x4* sp = (const LAS f32x4*)(S + (k0 + kk + i) * 12); const f32x4 s0 = sp[0], s1 = sp[1], s2 = sp[2];
            acc[0] += s0.x * w[i]; acc[1] += s0.y * w[i]; acc[2] += s0.z * w[i]; acc[3] += s0.w * w[i];
            acc[4] += s1.x * w[i]; acc[5] += s1.y * w[i]; acc[6] += s1.z * w[i]; acc[7] += s1.w * w[i]; acc[8] += s2.x * w[i]; }
    }
    __syncthreads();
    LAS float* R = (LAS float*)(F.lds + RING_OFF);
    if (F.lane < 48) {
#pragma unroll
        for (int q = 0; q < NMOD; ++q) *(LAS f32x4*)(R + (F.wave * NMOD + q) * CW + F.lane * 4) = acc[q]; }
    __syncthreads();
    float* mods = (float*)(F.ws + WS_MODS); const float* b_ada = A.in[11];
    for (int idx = F.tid; idx < NMOD * CW; idx += NWAVES * 64) { const int q = idx / CW, cl = idx % CW; float s = b_ada[layer * ADA_N + cchunk * CW + cl];
#pragma unroll
        for (int w = 0; w < NWAVES; ++w) s += R[(w * NMOD + q) * CW + cl];
        mods[(size_t)(layer * NMOD + q) * ADA_N + cchunk * CW + cl] = s; }
    __syncthreads();
}
__device__ __forceinline__ void p0_prologue(Frame& F, const Args& A) {
#ifndef MK_P0A
#define MK_P0A 1
#endif
#ifndef MK_P0T
#define MK_P0T 1
#endif
    for (int ra = 0; ra < MK_P0A; ++ra) if (F.vcu < 256) ada_task(F, A, F.vcu);
    LAS float* scr = (LAS float*)(F.lds + RING_OFF + F.wave * 16384);
    const int gw = F.vcu * NWAVES + F.wave, NGW = F.G * NWAVES;
    bf16* ws16 = (bf16*)F.ws;
    constexpr int I_IN = (D / 64) * (NIN / 32), I_UQ = (QL / 64) * (NQ / 32), I_UK = (KVL / 64) * (D / 32), I_O = (D / 64) * (D / 32), I_RIN = (D / 64) * (2 * D / 32), I_G = 2 * 16 * 8, I_UP = (D / 64) * (NUP / 32), I_DN = (DFF / 64) * (D / 32);
    constexpr int PER_J = I_IN + I_UQ + 2 * I_UK + I_O + I_RIN + I_O + 2 * I_G;
    constexpr int NITEMS = 2 * PER_J + 4 * (I_UP + I_DN);
    for (int rt = 0; rt < MK_P0T; ++rt)
    for (int it = gw; it < NITEMS; it += NGW) {
        int r = it;
        if (r < 2 * PER_J) {
            const int j = r / PER_J; r -= j * PER_J;
            if (r < I_IN) { p0_transpose_item(A.in[12] + (size_t)j * D * NIN, D, NIN, (bf16*)(F.ws + WS_WIN) + (size_t)j * NINP * D, 0, scr, r, F.lane); continue; } r -= I_IN;
            if (r < I_UQ) { p0_transpose_item(A.in[15] + (size_t)j * QL * NQ, QL, NQ, (bf16*)(F.ws + WS_WUQ) + (size_t)j * NQ * QL, 0, scr, r, F.lane); continue; } r -= I_UQ;
            if (r < I_UK) { p0_transpose_item(A.in[16] + (size_t)j * KVL * D, KVL, D, (bf16*)(F.ws + WS_WUKV) + (size_t)j * NKV * KVL, 0, scr, r, F.lane); continue; } r -= I_UK;
            if (r < I_UK) { p0_transpose_item(A.in[17] + (size_t)j * KVL * D, KVL, D, (bf16*)(F.ws + WS_WUKV) + (size_t)j * NKV * KVL, D, scr, r, F.lane); continue; } r -= I_UK;
            if (r < I_O) { p0_transpose_item(A.in[18] + (size_t)j * D * D, D, D, (bf16*)(F.ws + WS_WO) + (size_t)j * D * D, 0, scr, r, F.lane); continue; } r -= I_O;
            if (r < I_RIN) { p0_transpose_item(A.in[19] + (size_t)j * D * 2 * D, D, 2 * D, (bf16*)(F.ws + WS_WRIN) + (size_t)j * 2 * D * D, 0, scr, r, F.lane); continue; } r -= I_RIN;
            if (r < I_O) { p0_transpose_item(A.in[27] + (size_t)j * D * D, D, D, (bf16*)(F.ws + WS_WROUT) + (size_t)j * D * D, 0, scr, r, F.lane); continue; } r -= I_O;
            { const int gate = r / I_G; r -= gate * I_G; const int mat = r >> 3, sub = r & 7, dir = mat >> 4, blk = mat & 15;
              p0_transpose_item(A.in[gate ? 24 : 22] + ((size_t)j * 32 + mat) * 128 * 128, 128, 128, (bf16*)(F.ws + WS_WG) + (size_t)j * 8192 * 128, blk * 512 + dir * 256 + gate * 128, scr, sub, F.lane); continue; }
        }
        r -= 2 * PER_J;
        { const int l = r / (I_UP + I_DN); r -= l * (I_UP + I_DN);
          if (r < I_UP) { p0_transpose_item(A.in[28] + (size_t)l * D * NUP, D, NUP, (bf16*)(F.ws + WS_WUP) + (size_t)l * NUP * D, 0, scr, r, F.lane); continue; } r -= I_UP;
          p0_transpose_item(A.in[31] + (size_t)l * DFF * D, DFF, D, (bf16*)(F.ws + WS_WDN) + (size_t)l * D * ALD, 0, scr, r, F.lane, ALD); }
    }
    (void)ws16;
    const int gt = F.vcu * NWAVES * 64 + F.tid, NGT = F.G * NWAVES * 64;
    for (int i = gt; i < 2 * (NINP - NIN) * D / 8; i += NGT) { const int j = i / ((NINP - NIN) * D / 8), o = i % ((NINP - NIN) * D / 8);
        *(GAS v4u*)((bf16*)(F.ws + WS_WIN) + ((size_t)j * NINP + NIN) * D + (size_t)o * 8) = (v4u){0u, 0u, 0u, 0u}; }
    for (int i = gt; i < 1024 * 32; i += NGT) { const int pos = i >> 5, a = i & 31; const float inv = exp2f(-(float)(2 * (a & 15)) * (13.287712379549449f / 32.0f));
        const float ang = (float)((a < 16) ? (pos >> 6) : (pos & 63)) * inv; float sn, cs; sincosf(ang, &sn, &cs);
        ((float*)(F.ws + WS_COS))[i] = cs; ((float*)(F.ws + WS_SIN))[i] = sn; }
    for (int i = gt; i < 2 * 2 * D; i += NGT) { const float lam = A.in[26][i]; ((float*)(F.ws + WS_SP))[i] = 8.0f * 1.4426950408889634f * log1pf(expf(-lam)); }
}

template <int MODE>
__device__ __forceinline__ void norm_phase(Frame& F, const Args& A, const float* g, const float* modbase  , int shift_idx  ) {
    const int gw = F.vcu * NWAVES + F.wave, NGW = F.G * NWAVES;
    bf16* X = (bf16*)(F.ws + WS_X); bf16* H = (bf16*)(F.ws + WS_H);
    for (int blk = gw; blk < NTOK / 8; blk += NGW) {
        const int m0 = blk * 8;
        f32x4 gs[4][2], sh[4][2];
        if (MODE == 2) {
#pragma unroll
            for (int j = 0; j < 4; ++j)
#pragma unroll
                for (int h = 0; h < 2; ++h) gs[j][h] = *(const GAS f32x4*)(g + 8 * (F.lane + 64 * j) + 4 * h);
        } else { const float* mb = modbase + (size_t)mod_of_row(m0) * ADA_N + (size_t)shift_idx * D;
#pragma unroll
            for (int j = 0; j < 4; ++j)
#pragma unroll
                for (int h = 0; h < 2; ++h) { const int c = 8 * (F.lane + 64 * j) + 4 * h; gs[j][h] = *(const GAS f32x4*)(g + c) * (*(const GAS f32x4*)(mb + D + c) + 1.0f); sh[j][h] = *(const GAS f32x4*)(mb + c); } }
        f32x4 nx[4][2]; v4u nb[4];
#define NORM_LOAD(m) do { if (MODE == 0) { const float* src_ = (m) < MCTX ? A.in[0] + (size_t)(m) * D : A.in[1] + (size_t)((m) - MCTX) * D; \
            _Pragma("unroll") for (int j = 0; j < 4; ++j) { const GAS f32x4* p = (const GAS f32x4*)(src_ + 8 * (F.lane + 64 * j)); nx[j][0] = p[0]; nx[j][1] = p[1]; } } \
        else { _Pragma("unroll") for (int j = 0; j < 4; ++j) nb[j] = *(const GAS v4u*)(X + (size_t)(m) * D + 8 * (F.lane + 64 * j)); } } while (0)
        NORM_LOAD(m0);
#pragma unroll 1
        for (int r = 0; r < 8; ++r) { const int m = m0 + r;
            f32x4 v[4][2];
            if (MODE == 0) {
#pragma unroll
                for (int j = 0; j < 4; ++j) { v[j][0] = nx[j][0]; v[j][1] = nx[j][1]; }
            } else {
#pragma unroll
                for (int j = 0; j < 4; ++j) { const v4u w = nb[j];
                    v[j][0] = (f32x4){pg8::bf_lo(w.x), pg8::bf_hi(w.x), pg8::bf_lo(w.y), pg8::bf_hi(w.y)}; v[j][1] = (f32x4){pg8::bf_lo(w.z), pg8::bf_hi(w.z), pg8::bf_lo(w.w), pg8::bf_hi(w.w)}; } }
            if (r < 7) NORM_LOAD(m + 1);
            if (MODE == 0) {
#pragma unroll
                for (int j = 0; j < 4; ++j) *(GAS v4u*)(X + (size_t)m * D + 8 * (F.lane + 64 * j)) = (v4u){pk2(v[j][0].x, v[j][0].y), pk2(v[j][0].z, v[j][0].w), pk2(v[j][1].x, v[j][1].y), pk2(v[j][1].z, v[j][1].w)}; }
            float s = 0.f;
#pragma unroll
            for (int j = 0; j < 4; ++j)
#pragma unroll
                for (int h = 0; h < 2; ++h) s += (v[j][h].x * v[j][h].x + v[j][h].y * v[j][h].y) + (v[j][h].z * v[j][h].z + v[j][h].w * v[j][h].w);
            const float rstd = 1.0f / sqrtf(wave_sum(s, F.lane) * (1.0f / D) + NORM_EPS);
            if (MODE == 2) { float* yo = F.out + OUT_Y + (size_t)m * D;
#pragma unroll
                for (int j = 0; j < 4; ++j)
#pragma unroll
                    for (int h = 0; h < 2; ++h) *(GAS f32x4*)(yo + 8 * (F.lane + 64 * j) + 4 * h) = v[j][h] * rstd * gs[j][h];
            } else {
#pragma unroll
                for (int j = 0; j < 4; ++j) { const f32x4 h0 = v[j][0] * rstd * gs[j][0] + sh[j][0], h1 = v[j][1] * rstd * gs[j][1] + sh[j][1];
                    *(GAS v4u*)(H + (size_t)m * D + 8 * (F.lane + 64 * j)) = (v4u){pk2(h0.x, h0.y), pk2(h0.z, h0.w), pk2(h1.x, h1.y), pk2(h1.z, h1.w)}; }
            }
        }
#undef NORM_LOAD
    }
}

__device__ __forceinline__ void mla_mid_phase(Frame& F, const Args& A, int j) {
    const int gw = F.vcu * NWAVES + F.wave, NGW = F.G * NWAVES, lane = F.lane;
    const float* PROJ = (const float*)(F.ws + WS_PROJ); bf16* CQ = (bf16*)(F.ws + WS_CQ); bf16* CKV = (bf16*)(F.ws + WS_CKV); bf16* KR = (bf16*)(F.ws + WS_KR);
    const float* gq = A.in[13] + j * QL; const float* gkv = A.in[14] + j * KVL;
    const float* cosT = (const float*)(F.ws + WS_COS); const float* sinT = (const float*)(F.ws + WS_SIN);
    const f32x4 gq0 = *(const GAS f32x4*)(gq + 8 * lane), gq1 = *(const GAS f32x4*)(gq + 8 * lane + 4), gk0 = *(const GAS f32x4*)(gkv + 8 * lane), gk1 = *(const GAS f32x4*)(gkv + 8 * lane + 4);
    for (int m = gw; m < NTOK; m += NGW) {
        const float* pr = PROJ + (size_t)m * NINP;
        const f32x4 q0 = *(const GAS f32x4*)(pr + 8 * lane), q1 = *(const GAS f32x4*)(pr + 8 * lane + 4), k0 = *(const GAS f32x4*)(pr + QL + 8 * lane), k1 = *(const GAS f32x4*)(pr + QL + 8 * lane + 4);
        const float* pk = (const float*)(F.ws + WS_PKR) + (size_t)m * ROPE + lane;
        const float kr = (pk[0] + pk[(size_t)NTOK * ROPE]) + (pk[2ull * NTOK * ROPE] + pk[3ull * NTOK * ROPE]);
        const float sq = wave_sum((q0.x * q0.x + q0.y * q0.y) + (q0.z * q0.z + q0.w * q0.w) + (q1.x * q1.x + q1.y * q1.y) + (q1.z * q1.z + q1.w * q1.w), lane);
        const float sk = wave_sum((k0.x * k0.x + k0.y * k0.y) + (k0.z * k0.z + k0.w * k0.w) + (k1.x * k1.x + k1.y * k1.y) + (k1.z * k1.z + k1.w * k1.w), lane);
        const float rq = 1.0f / sqrtf(sq * (1.0f / QL) + NORM_EPS), rk = 1.0f / sqrtf(sk * (1.0f / KVL) + NORM_EPS);
        const f32x4 a0 = q0 * rq * gq0, a1 = q1 * rq * gq1, c0 = k0 * rk * gk0, c1 = k1 * rk * gk1;
        *(GAS v4u*)(CQ + (size_t)m * QL + 8 * lane) = (v4u){pk2(a0.x, a0.y), pk2(a0.z, a0.w), pk2(a1.x, a1.y), pk2(a1.z, a1.w)};
        const int kvr = kv_row(m);
        *(GAS v4u*)(CKV + (size_t)kvr * KVL + 8 * lane) = (v4u){pk2(c0.x, c0.y), pk2(c0.z, c0.w), pk2(c1.x, c1.y), pk2(c1.z, c1.w)};
        float krv = kr;
        if (m < MCTX) {
            const int b = m >> 8, t = m & 255; float* oc = F.out + OUT_CKV + ((size_t)(b * 2 + j) * 256 + t) * KVL + 8 * lane;
            *(GAS f32x4*)oc = c0; *(GAS f32x4*)(oc + 4) = c1;
            F.out[OUT_KR + ((size_t)(b * 2 + j) * 256 + t) * ROPE + lane] = kr;
        } else {
            const int pos = (m - MCTX) & 1023, ai = (lane & 15) + 16 * (lane >> 5); const float cs = cosT[pos * 32 + ai], sn = sinT[pos * 32 + ai];
            const float other = shfl_xor_l(kr, 16, lane);
            krv = (lane & 16) ? (kr * cs + other * sn) : (kr * cs - other * sn);
        }
        KR[(size_t)kvr * ROPE + lane] = (bf16)f2bf(krv);
    }
    for (int i = gw; i < 8 * 256; i += NGW) { const int b = i >> 8, t = i & 255; const size_t dst = (size_t)MCTX + 1280 * b + t;
        const float* sc = A.in[2] + ((size_t)(b * 2 + j) * 256 + t) * KVL + 8 * lane; const f32x4 c0 = *(const GAS f32x4*)sc, c1 = *(const GAS f32x4*)(sc + 4);
        *(GAS v4u*)(CKV + dst * KVL + 8 * lane) = (v4u){pk2(c0.x, c0.y), pk2(c0.z, c0.w), pk2(c1.x, c1.y), pk2(c1.z, c1.w)};
        KR[dst * ROPE + lane] = (bf16)f2bf(A.in[3][((size_t)(b * 2 + j) * 256 + t) * ROPE + lane]); }
}

__device__ __forceinline__ void attn_phase(Frame& F, char* lds) {
    const att::bf16* Q = (const att::bf16*)(F.ws + WS_Q); const att::bf16* KN = (const att::bf16*)(F.ws + WS_KN); const att::bf16* KR = (const att::bf16*)(F.ws + WS_KR);
    const att::bf16* V = (const att::bf16*)(F.ws + WS_V); att::bf16* O = (att::bf16*)(F.ws + WS_O);
    for (int i = 0; i < 4; ++i) {
        int qrow, krow, h, seq;
        if (i < 2) { const int id = F.vcu * 2 + i, b = id >> 6, rem = id & 63, qb = rem & 3; h = rem >> 2; qrow = MCTX + b * 1024 + qb * 256; krow = MCTX + b * 1280; seq = 1280; }
        else { const int id = F.vcu * 2 + (i - 2), s = id >> 4; h = id & 15; qrow = s * 256; krow = s * 256; seq = 256; }
        __syncthreads();
        att::attn_unit(Q + (size_t)qrow * NQ + h * QKD, KN + (size_t)krow * D + h * NOPE, KR + (size_t)krow * ROPE, V + (size_t)krow * D + h * VD, O + (size_t)qrow * D + h * VD, seq, lds, lds + RING_BYTES + 2048, F.wave);
    }
}

__device__ __forceinline__ void conv4_phase(Frame& F, const Args& A, int j) {
    const int gw = F.vcu * NWAVES + F.wave, NGW = F.G * NWAVES, lane = F.lane;
    const bf16* RIN = (const bf16*)(F.ws + WS_RIN); bf16* XC = (bf16*)(F.ws + WS_XC);
    const float* wc = A.in[20] + (size_t)j * 4 * D; const float* bc = A.in[21] + (size_t)j * D;
    for (int task = gw; task < (NTOK / 32) * 4; task += NGW) {
        const int cg = task & 3, chunk = task >> 2, c0 = cg * 512 + lane * 8;
        float w[4][8], bb[8];
#pragma unroll
        for (int t = 0; t < 4; ++t) { const f32x4 a = *(const GAS f32x4*)(wc + t * D + c0), b = *(const GAS f32x4*)(wc + t * D + c0 + 4); w[t][0] = a.x; w[t][1] = a.y; w[t][2] = a.z; w[t][3] = a.w; w[t][4] = b.x; w[t][5] = b.y; w[t][6] = b.z; w[t][7] = b.w; }
        { const f32x4 a = *(const GAS f32x4*)(bc + c0), b = *(const GAS f32x4*)(bc + c0 + 4); bb[0] = a.x; bb[1] = a.y; bb[2] = a.z; bb[3] = a.w; bb[4] = b.x; bb[5] = b.y; bb[6] = b.z; bb[7] = b.w; }
#pragma unroll 1
        for (int half = 0; half < 2; ++half) {
        const int r0 = chunk * 32 + half * 16;
        const int slen = r0 < MCTX ? 256 : 1024, sbeg = r0 < MCTX ? (r0 & ~255) : MCTX + ((r0 - MCTX) & ~1023), send = sbeg + slen;
        v4u raw[19];
#pragma unroll
        for (int i = 0; i < 19; ++i) { const int r = r0 - 2 + i; raw[i] = (r >= sbeg && r < send) ? *(const GAS v4u*)(RIN + (size_t)r * (2 * D) + D + c0) : (v4u){0u, 0u, 0u, 0u}; }
#pragma unroll
        for (int t = 0; t < 16; ++t) {
            float o[8];
#pragma unroll
            for (int c = 0; c < 8; ++c) o[c] = bb[c];
#pragma unroll
            for (int jj = 0; jj < 4; ++jj) { const v4u x = raw[t + jj];
                o[0] += w[jj][0] * pg8::bf_lo(x.x); o[1] += w[jj][1] * pg8::bf_hi(x.x); o[2] += w[jj][2] * pg8::bf_lo(x.y); o[3] += w[jj][3] * pg8::bf_hi(x.y);
                o[4] += w[jj][4] * pg8::bf_lo(x.z); o[5] += w[jj][5] * pg8::bf_hi(x.z); o[6] += w[jj][6] * pg8::bf_lo(x.w); o[7] += w[jj][7] * pg8::bf_hi(x.w); }
            *(GAS v4u*)(XC + (size_t)(r0 + t) * D + c0) = (v4u){pk2(o[0], o[1]), pk2(o[2], o[3]), pk2(o[4], o[5]), pk2(o[6], o[7])};
        }
        }
    }
}

typedef float sf2 __attribute__((ext_vector_type(2)));
__device__ __forceinline__ sf2 bf2_to_f2(unsigned w) { return (sf2){__uint_as_float(w << 16), __uint_as_float(w & 0xffff0000u)}; }
__device__ __forceinline__ void scan_phase(Frame& F, const Args& A, int j) {
    const int lane = F.lane, wave = F.wave;
    LAS float* aggb = (LAS float*)(F.lds + RING_OFF);
    LAS float* carb = aggb + 2 * 8 * 128 * 2;
    const int nunits = F.vcu < 128 ? 1 : 4; int pass = 0;
    for (int ui = 0; ui < nunits; ++ui) {
        int row0, nsub, cg, bidx; bool ctx;
        if (F.vcu < 128) { const int id = F.vcu; bidx = id >> 4; cg = id & 15; row0 = MCTX + bidx * 1024; nsub = 4; ctx = false; }
        else { const int id = (F.vcu - 128) * 4 + ui; bidx = id >> 4; cg = id & 15; row0 = bidx * 256; nsub = 1; ctx = true; }
        const int ch = cg * 128 + lane * 2;
        const bf16* LAf = (const bf16*)(F.ws + WS_LA) + ch; const bf16* LAb = LAf + (size_t)NTOK * D;
        const bf16* UUf = (const bf16*)(F.ws + WS_UU) + ch; const bf16* UUb = UUf + (size_t)NTOK * D;
        bf16* HB = (bf16*)(F.ws + WS_HB) + ch; const bf16* GY = (const bf16*)(F.ws + WS_RIN) + ch; bf16* MIX = (bf16*)(F.ws + WS_MIX) + ch;
        sf2 hf0 = (sf2){0.f, 0.f}, hb0 = (sf2){0.f, 0.f};
        if (!ctx) { const float* st = A.in[4] + ((size_t)(bidx * 2 + j) * 2) * D + ch; hf0 = *(const GAS sf2*)st; hb0 = *(const GAS sf2*)(st + D); }
        for (int sb = nsub - 1; sb >= 0; --sb, ++pass) {
            const size_t r0 = (size_t)(row0 + sb * 256 + wave * 32);
            unsigned L[32], U[32];
#pragma unroll
            for (int i = 0; i < 32; ++i) { L[i] = *(const GAS unsigned*)(LAb + (r0 + 31 - i) * D); U[i] = *(const GAS unsigned*)(UUb + (r0 + 31 - i) * D); }
            sf2 sl = (sf2){0.f, 0.f}, hl = (sf2){0.f, 0.f};
#pragma unroll
            for (int i = 0; i < 32; ++i) { const sf2 l = bf2_to_f2(L[i]), u = bf2_to_f2(U[i]); sl += l; hl.x = __builtin_amdgcn_exp2f(l.x) * hl.x + u.x; hl.y = __builtin_amdgcn_exp2f(l.y) * hl.y + u.y; }
            LAS float* ag = aggb + (((pass & 1) * 8 + wave) * 128 + lane * 2) * 2;
            *(LAS f32x4*)ag = (f32x4){__builtin_amdgcn_exp2f(sl.x), hl.x, __builtin_amdgcn_exp2f(sl.y), hl.y};
            __syncthreads();
            sf2 h = hb0; if (sb != nsub - 1) h = *(const LAS sf2*)(carb + (pass & 1) * 128 + lane * 2);
            for (int c = 7; c > wave; --c) { const f32x4 q = *(const LAS f32x4*)(aggb + (((pass & 1) * 8 + c) * 128 + lane * 2) * 2); h.x = q.x * h.x + q.y; h.y = q.z * h.y + q.w; }
#pragma unroll
            for (int i = 0; i < 32; ++i) { const sf2 l = bf2_to_f2(L[i]), u = bf2_to_f2(U[i]); h.x = __builtin_amdgcn_exp2f(l.x) * h.x + u.x; h.y = __builtin_amdgcn_exp2f(l.y) * h.y + u.y;
                *(GAS unsigned*)(HB + (r0 + 31 - i) * D) = pk2(h.x, h.y); }
            if (wave == 0) { *(LAS sf2*)(carb + ((pass + 1) & 1) * 128 + lane * 2) = h;
                if (ctx) *(GAS sf2*)(F.out + OUT_ST + ((size_t)(bidx * 2 + j) * 2 + 1) * D + ch) = h; }
        }
        for (int sb = 0; sb < nsub; ++sb, ++pass) {
            const size_t r0 = (size_t)(row0 + sb * 256 + wave * 32);
            unsigned L[32], U[32], G[32], Hh[32];
#pragma unroll
            for (int i = 0; i < 32; ++i) { L[i] = *(const GAS unsigned*)(LAf + (r0 + i) * D); U[i] = *(const GAS unsigned*)(UUf + (r0 + i) * D); }
#pragma unroll
            for (int i = 0; i < 32; ++i) { G[i] = *(const GAS unsigned*)(GY + (r0 + i) * (2 * D)); Hh[i] = *(const GAS unsigned*)(HB + (r0 + i) * D); }
            sf2 sl = (sf2){0.f, 0.f}, hl = (sf2){0.f, 0.f};
#pragma unroll
            for (int i = 0; i < 32; ++i) { const sf2 l = bf2_to_f2(L[i]), u = bf2_to_f2(U[i]); sl += l; hl.x = __builtin_amdgcn_exp2f(l.x) * hl.x + u.x; hl.y = __builtin_amdgcn_exp2f(l.y) * hl.y + u.y; }
            LAS float* ag = aggb + (((pass & 1) * 8 + wave) * 128 + lane * 2) * 2;
            *(LAS f32x4*)ag = (f32x4){__builtin_amdgcn_exp2f(sl.x), hl.x, __builtin_amdgcn_exp2f(sl.y), hl.y};
            __syncthreads();
            sf2 h = hf0; if (sb != 0) h = *(const LAS sf2*)(carb + (pass & 1) * 128 + lane * 2);
            for (int c = 0; c < wave; ++c) { const f32x4 q = *(const LAS f32x4*)(aggb + (((pass & 1) * 8 + c) * 128 + lane * 2) * 2); h.x = q.x * h.x + q.y; h.y = q.z * h.y + q.w; }
#pragma unroll
            for (int i = 0; i < 32; ++i) { const sf2 l = bf2_to_f2(L[i]), u = bf2_to_f2(U[i]), gy = bf2_to_f2(G[i]), hbv = bf2_to_f2(Hh[i]);
                h.x = __builtin_amdgcn_exp2f(l.x) * h.x + u.x; h.y = __builtin_amdgcn_exp2f(l.y) * h.y + u.y;
                *(GAS unsigned*)(MIX + (r0 + i) * D) = pk2((h.x + hbv.x) * gy.x, (h.y + hbv.y) * gy.y); }
            if (wave == 7) { *(LAS sf2*)(carb + ((pass + 1) & 1) * 128 + lane * 2) = h;
                if (ctx) *(GAS sf2*)(F.out + OUT_ST + ((size_t)(bidx * 2 + j) * 2 + 0) * D + ch) = h; }
        }
    }
    __syncthreads();
}


typedef unsigned v2u __attribute__((ext_vector_type(2)));
#define RS_BAR() do { asm volatile("s_waitcnt lgkmcnt(0)" ::: "memory"); __builtin_amdgcn_s_barrier(); asm volatile("" ::: "memory"); } while (0)
__device__ __forceinline__ void rs_phase(Frame& F, const Args& A, int j, int wave0) {
    const int nunits = F.vcu < 128 ? 1 : 4; int pass = 0;
    const pg8::Gemm g = pg8::mk_gemm((const pg8::bf16_t*)(F.ws + WS_XC), (const pg8::bf16_t*)(F.ws + WS_WG) + (size_t)j * 8192 * 128, 128, D);
    const pg8::EpiGatesLds E{(const pg8::bf16_t*)(F.ws + WS_XC), A.in[23] + (size_t)j * 2 * D, A.in[25] + (size_t)j * 2 * D, (const float*)(F.ws + WS_SP) + (size_t)j * 2 * D, (LAS float*)(F.lds + EDGE_OFF)};
    const bool lat = F.vcu < 128; const int nsub = lat ? 4 : 1, npass = 8;
    auto pass_unit = [&](int p, pg8::Unit& u) { const int ui = lat ? 0 : (p >> 1), q = lat ? p : (p & 1), sweep = q / nsub, si = q - sweep * nsub, sb = sweep ? si : nsub - 1 - si;
        const int id = lat ? F.vcu : (F.vcu - 128) * 4 + ui, bidx = id >> 4, cg = id & 15, row0 = lat ? MCTX + bidx * 1024 : bidx * 256;
        u.pm = (row0 >> 8) + sb; u.pn = 2 * cg + (sweep ? 0 : 1); };
    pg8::Unit ucur; pass_unit(0, ucur);
    f32x4 pf; { int tq = wave0 * 64 + lane_now(); asm volatile("" : "+v"(tq)); pf = E.pre(ucur, tq); }
    pg8::gate_stage(F.lds + RING_OFF, g, ucur.pm, ucur.pn, wave0);
    (void)nunits;
#pragma unroll 1
    for (int p = 0; p < npass; ++p, ++pass) {
        const int ui = lat ? 0 : (p >> 1), q = lat ? p : (p & 1), sweep = q / nsub, si = q - sweep * nsub, sb = sweep ? si : nsub - 1 - si;
        const int id = lat ? F.vcu : (F.vcu - 128) * 4 + ui, bidx = id >> 4, cg = id & 15, row0 = lat ? MCTX + bidx * 1024 : bidx * 256; const bool ctx = !lat;
        if (p == 0 || (sweep && si == 0)) asm volatile("s_waitcnt vmcnt(0)" ::: "memory"); else asm volatile("s_waitcnt vmcnt(32)" ::: "memory");
        RS_BAR();
        { int t_ = wave0 * 64 + lane_now(); asm volatile("" : "+v"(t_)); F.tid = t_; F.lane = t_ & 63; F.wave = __builtin_amdgcn_readfirstlane(t_ >> 6); }
        { f32x4 acc[2][2][4][2]; const int wr = F.wave >> 2, wc = F.wave & 3, fr = F.lane & 15, fq = F.lane >> 4;
          pg8::gate_compute(F.lds + RING_OFF, acc, wr, wc, fr, fq);
          RS_BAR();
          E.fused(acc, ucur, wr, wc, fr, fq, F.lds + RING_OFF, pf); }
        RS_BAR();
        const int lane = F.lane, wave = F.wave;
        LAS float* aggb = (LAS float*)(F.lds + EDGE_OFF + 2048);
        LAS float* carb = aggb + 8 * 128 * 2;
        const LAS unsigned char* img = F.lds + RING_OFF;
        const int ch = cg * 128 + lane * 2;
        bf16* HB = (bf16*)(F.ws + WS_HB) + ch; const bf16* GY = (const bf16*)(F.ws + WS_RIN) + ch; bf16* MIX = (bf16*)(F.ws + WS_MIX) + ch;
        const size_t r0 = (size_t)(row0 + sb * 256 + wave * 32);
        unsigned W0[32], W1[32];
#pragma unroll
        for (int i = 0; i < 32; ++i) { const int rl = wave * 32 + (sweep ? i : 31 - i);
            const v2u w = *(const LAS v2u*)(img + rl * 512 + (((lane >> 1) ^ (rl & 31)) << 4) + ((lane & 1) << 3)); W0[i] = w.x; W1[i] = w.y; }
        RS_BAR();
        if (p + 1 < npass) { pass_unit(p + 1, ucur); { int tq = wave0 * 64 + lane_now(); asm volatile("" : "+v"(tq)); pf = E.pre(ucur, tq); }
            pg8::gate_stage(F.lds + RING_OFF, g, ucur.pm, ucur.pn, wave0); }
        unsigned G[32], Hh[32];
#pragma unroll
        for (int i = 0; i < 32; ++i) { G[i] = 0u; Hh[i] = 0u; }
        if (sweep) {
#pragma unroll
            for (int i = 0; i < 32; ++i) { G[i] = *(const GAS unsigned*)(GY + (r0 + i) * (2 * D)); Hh[i] = *(const GAS unsigned*)(HB + (r0 + i) * D); } }
        sf2 sl = (sf2){0.f, 0.f}, hl = (sf2){0.f, 0.f}; float A0[32], A1[32];
#pragma unroll
        for (int i = 0; i < 32; ++i) { const sf2 l = (sf2){pg8::bf_lo(W0[i]), pg8::bf_lo(W1[i])}, u = (sf2){pg8::bf_hi(W0[i]), pg8::bf_hi(W1[i])};
            sl += l; A0[i] = __builtin_amdgcn_exp2f(l.x); A1[i] = __builtin_amdgcn_exp2f(l.y); hl.x = A0[i] * hl.x + u.x; hl.y = A1[i] * hl.y + u.y; }
        LAS float* ag = aggb + (wave * 128 + lane * 2) * 2;
        *(LAS f32x4*)ag = (f32x4){__builtin_amdgcn_exp2f(sl.x), hl.x, __builtin_amdgcn_exp2f(sl.y), hl.y};
        RS_BAR();
        sf2 h;
        if (si == 0) { h = (sf2){0.f, 0.f};
            if (!ctx) { const float* st = A.in[4] + ((size_t)(bidx * 2 + j) * 2) * D + ch; h = *(const GAS sf2*)(st + (sweep ? 0 : D)); } }
        else h = *(const LAS sf2*)(carb + (pass & 1) * 128 + lane * 2);
        if (sweep == 0) {
            for (int c = 7; c > wave; --c) { const f32x4 qv = *(const LAS f32x4*)(aggb + (c * 128 + lane * 2) * 2); h.x = qv.x * h.x + qv.y; h.y = qv.z * h.y + qv.w; }
#pragma unroll
            for (int i = 0; i < 32; ++i) { const sf2 u = (sf2){pg8::bf_hi(W0[i]), pg8::bf_hi(W1[i])};
                h.x = A0[i] * h.x + u.x; h.y = A1[i] * h.y + u.y;
                *(GAS unsigned*)(HB + (r0 + 31 - i) * D) = pk2(h.x, h.y); }
            if (wave == 0) { *(LAS sf2*)(carb + ((pass + 1) & 1) * 128 + lane * 2) = h;
                if (ctx) *(GAS sf2*)(F.out + OUT_ST + ((size_t)(bidx * 2 + j) * 2 + 1) * D + ch) = h; }
        } else {
            for (int c = 0; c < wave; ++c) { const f32x4 qv = *(const LAS f32x4*)(aggb + (c * 128 + lane * 2) * 2); h.x = qv.x * h.x + qv.y; h.y = qv.z * h.y + qv.w; }
#pragma unroll
            for (int i = 0; i < 32; ++i) { const sf2 u = (sf2){pg8::bf_hi(W0[i]), pg8::bf_hi(W1[i])}, gy = bf2_to_f2(G[i]), hbv = bf2_to_f2(Hh[i]);
                h.x = A0[i] * h.x + u.x; h.y = A1[i] * h.y + u.y;
                *(GAS unsigned*)(MIX + (r0 + i) * D) = pk2((h.x + hbv.x) * gy.x, (h.y + hbv.y) * gy.y); }
            if (wave == 7) { *(LAS sf2*)(carb + ((pass + 1) & 1) * 128 + lane * 2) = h;
                if (ctx) *(GAS sf2*)(F.out + OUT_ST + ((size_t)(bidx * 2 + j) * 2 + 0) * D + ch) = h; }
        }
    }
    asm volatile("s_waitcnt vmcnt(0)" ::: "memory"); __syncthreads();
}

__device__ __forceinline__ void ffn_fix_panel(Frame& F, const Args& A, int layer, int pm) {
    if (pm < MCTX / 256) return;
    const float* HALO = (const float*)(F.ws + WS_HALO); bf16* ACT = (bf16*)(F.ws + WS_ACT);
    const float* wc = A.in[29] + (size_t)layer * 3 * NUP; const float* bc = A.in[30] + (size_t)layer * NUP;
    const float* hc = HALO + (size_t)pm * 4 * NUP; const int k = (pm - MCTX / 256) & 3;
    const bool top = k != 0, bot = k != 3;
    for (int c4 = F.tid; c4 < DFF / 4; c4 += NWAVES * 64) { const int c0 = c4 * 4; f32x4 vt[2], vb[2];
#pragma unroll
        for (int bj = 0; bj < 2; ++bj) { const int cc = c0 + bj * DFF;
            const f32x4 b = *(const GAS f32x4*)(bc + cc), w0 = *(const GAS f32x4*)(wc + cc), w1 = *(const GAS f32x4*)(wc + NUP + cc), w2 = *(const GAS f32x4*)(wc + 2 * NUP + cc);
            const f32x4 z = (f32x4){0.f, 0.f, 0.f, 0.f};
            const f32x4 t0 = top ? *(const GAS f32x4*)(hc - NUP + cc) : z, t1 = top ? *(const GAS f32x4*)(hc + cc) : z, t2 = top ? *(const GAS f32x4*)(hc + NUP + cc) : z;
            const f32x4 b0 = bot ? *(const GAS f32x4*)(hc + 2 * NUP + cc) : z, b1 = bot ? *(const GAS f32x4*)(hc + 3 * NUP + cc) : z, b2 = bot ? *(const GAS f32x4*)(hc + 4 * NUP + cc) : z;
            vt[bj] = b + w0 * t0 + w1 * t1 + w2 * t2; vb[bj] = b + w0 * b0 + w1 * b1 + w2 * b2; }
        if (top) { float o[4];
#pragma unroll
            for (int j = 0; j < 4; ++j) o[j] = vt[0][j] * pg8::fast_sigmoid(vt[0][j]) * vt[1][j];
            *(GAS unsigned long long*)(ACT + (size_t)pm * 256 * ALD + c0) = (unsigned long long)pk2(o[0], o[1]) | ((unsigned long long)pk2(o[2], o[3]) << 32); }
        if (bot) { float o[4];
#pragma unroll
            for (int j = 0; j < 4; ++j) o[j] = vb[0][j] * pg8::fast_sigmoid(vb[0][j]) * vb[1][j];
            *(GAS unsigned long long*)(ACT + ((size_t)pm * 256 + 255) * ALD + c0) = (unsigned long long)pk2(o[0], o[1]) | ((unsigned long long)pk2(o[2], o[3]) << 32); } }
}

#ifndef MK_PER_PHASE
#define MK_PER_PHASE 0
#endif
#ifndef MK_MASK
#define MK_MASK 0xffffffffu
#endif
#define ON(i) ((MK_MASK >> (i)) & 1u)
#ifndef MK_REP
#define MK_REP 0u
#endif
#define NREP(i) (((MK_REP >> (i)) & 1u) ? 2 : 1)
#ifndef MK_RS
#define MK_RS 1
#endif
#ifndef MK_ALIGN
#define MK_ALIGN true
#endif
#ifndef MK_ALIGN_S
#define MK_ALIGN_S MK_ALIGN
#endif
#ifndef MK_ALIGN_RES
#define MK_ALIGN_RES MK_ALIGN
#endif
#ifndef MK_ALIGN_G
#define MK_ALIGN_G MK_ALIGN
#endif
#ifndef MK_SP2
#define MK_SP2 true
#endif
#ifndef MK_STOP
#define MK_STOP 1000
#endif
constexpr int NPHASE = 2 + 10 * NLAYER;
#ifndef MK_PROBE
#define MK_PROBE 0
#endif
#ifndef MK_SEL1
#define MK_SEL1 0
#endif
#ifndef MK_SEL2
#define MK_SEL2 1
#endif
#ifndef MK_SCALE2
#define MK_SCALE2 1.0f
#endif
constexpr int STAMP_OFF = LDSCTL_OFF + 1024;

__global__ void __launch_bounds__(NWAVES * 64, 2) mk_fwd(Args args) {
    extern __shared__ __attribute__((aligned(16))) unsigned char lds[];
    Frame F;
    F.lds = (LAS unsigned char*)lds;
    F.MISC = (volatile LAS unsigned*)(F.lds + MISC_OFF);
    F.tid = threadIdx.x; F.lane = F.tid & 63; F.wave = __builtin_amdgcn_readfirstlane(F.tid >> 6);
    const int wave0 = F.wave;
    F.G = gridDim.x; { const int bx = blockIdx.x; F.vcu = (F.G % 8 == 0) ? (bx % 8) * (F.G / 8) + bx / 8 : bx; }
    F.out = args.out; F.ws = args.ws;
    for (int u = F.tid; u < (LDS_BYTES - LDSCTL_OFF) / 4; u += NWAVES * 64) ((LAS unsigned*)(F.lds + LDSCTL_OFF))[u] = 0u;
    __syncthreads();
    const int lo = args.ph_lo, hi = args.ph_hi < MK_STOP ? args.ph_hi : MK_STOP;
    unsigned* barw = (unsigned*)(args.ws + WS_CTL) + CW_BAR;
    XcdBarrier bar; bar.bar = barw; bar.x = 0; bar.st = nullptr;
    if (hi - lo > 1) bar = xcd_barrier_post(barw, F.MISC + 8, F.tid == 0);
#define IN(k) (lo <= (k) && (k) < hi)
#define PHASE_BEGIN() size_t z_ = 0; asm volatile("" : "+s"(z_)); unsigned char* ws = args.ws + z_;     \
    { int t_ = wave0 * 64 + lane_now(); asm volatile("" : "+v"(t_)); F.tid = t_; F.lane = t_ & 63; F.wave = __builtin_amdgcn_readfirstlane(t_ >> 6); F.ws = ws; } \
    const float* mods = (const float*)(ws + WS_MODS); bf16* Hb = (bf16*)(ws + WS_H); bf16* X = (bf16*)(ws + WS_X); (void)mods; (void)Hb; (void)X;
#if MK_PROBE
#define STAMP(i) do { if (blockIdx.x == 0 && threadIdx.x == 0) ((LAS unsigned long long*)(F.lds + STAMP_OFF))[i] = __builtin_amdgcn_s_memrealtime(); } while (0)
#define SEAM2(k, kn) do { if (IN(k) && IN(kn)) xcd_barrier(bar, wave0 * 64 + lane_now() == 0); STAMP((k) + 1); } while (0)
#define SEAM(k) SEAM2(k, (k) + 1)
#else
#define STAMP(i) do { } while (0)
#ifdef MK_BAR2
#define SEAM2(k, kn) do { if (IN(k) && IN(kn)) { xcd_barrier(bar, wave0 * 64 + lane_now() == 0); xcd_barrier(bar, wave0 * 64 + lane_now() == 0); } } while (0)
#define SEAM(k) SEAM2(k, (k) + 1)
#else
#define SEAM2(k, kn) do { if (IN(k) && IN(kn)) xcd_barrier(bar, wave0 * 64 + lane_now() == 0); } while (0)
#define SEAM(k) SEAM2(k, (k) + 1)
#endif
#endif
    const int cid = (int)blockIdx.x;

    STAMP(0);
    if (IN(0) && ON(0)) { PHASE_BEGIN(); for (int rep = 0; rep < NREP(0); ++rep) { if (rep) xcd_barrier(bar, wave0 * 64 + lane_now() == 0); p0_prologue(F, args); } }
    SEAM(0);
    if (IN(1) && ON(1)) { PHASE_BEGIN(); for (int rep = 0; rep < NREP(1); ++rep) { if (rep) xcd_barrier(bar, wave0 * 64 + lane_now() == 0); norm_phase<0>(F, args, args.in[7], mods, 0); } }
    SEAM(1);

#pragma nounroll
    for (int layer = 0; layer < NLAYER; ++layer) {
        const int pb = 2 + 10 * layer, j = layer >> 1;
        if ((layer & 1) == 0) {
            if (IN(pb + 0) && ON(2)) { PHASE_BEGIN(); for (int rep = 0; rep < NREP(2); ++rep) { if (rep) xcd_barrier(bar, wave0 * 64 + lane_now() == 0); const float* lmods = mods + (size_t)layer * NMOD * ADA_N; (void)lmods; pg8::Gemm g = pg8::mk_gemm(Hb, (const bf16*)(ws + WS_WIN) + (size_t)j * NINP * D, D, D); pg8::StaticOrder S; S.init(NTOK, QL + KVL, F.G, cid);
                pg8::EpiF32 E{(float*)(ws + WS_PROJ), NINP};
                pg8::gemm_phase<pg8::EpiF32, pg8::StaticOrder, MK_ALIGN, MK_SP2>(F.lds + RING_OFF, g, S, E, wave0);
                pg8::Gemm g2 = pg8::mk_gemm(Hb, (const bf16*)(ws + WS_WIN) + ((size_t)j * NINP + QL + KVL) * D, D / 4, D); g2.ldb = D; g2.b_hstep = (size_t)pg8::HALF * D * 2; g2.b_tstep = 0;
                pg8::KSplitOrder S2; S2.init(NTOK, D / 4, F.G, cid);
                pg8::EpiKr E2{(float*)(ws + WS_PKR)};
                pg8::gemm_phase<pg8::EpiKr, pg8::KSplitOrder, MK_ALIGN, MK_SP2>(F.lds + RING_OFF, g2, S2, E2, wave0); } }
            SEAM(pb + 0);
            if (IN(pb + 1) && ON(3)) { PHASE_BEGIN(); for (int rep = 0; rep < NREP(3); ++rep) { if (rep) xcd_barrier(bar, wave0 * 64 + lane_now() == 0); const float* lmods = mods + (size_t)layer * NMOD * ADA_N; (void)lmods; mla_mid_phase(F, args, j); } }
            SEAM(pb + 1);
            if (IN(pb + 2) && ON(4)) {
                PHASE_BEGIN(); for (int rep = 0; rep < NREP(4); ++rep) { if (rep) xcd_barrier(bar, wave0 * 64 + lane_now() == 0);
#ifdef MK_SKEW
                if ((cid >> 3) & 1) { for (int i = 0; i < MK_SKEW; ++i) __builtin_amdgcn_s_sleep(127); }
#endif
                { pg8::Gemm g = pg8::mk_gemm((const bf16*)(ws + WS_CQ), (const bf16*)(ws + WS_WUQ) + (size_t)j * NQ * QL, QL, QL); pg8::StaticOrder S; S.init(NTOK, NQ, F.G, cid);
                  pg8::EpiQ E{(bf16*)(ws + WS_Q), (const float*)(ws + WS_COS), (const float*)(ws + WS_SIN)};
                  pg8::gemm_phase<pg8::EpiQ, pg8::StaticOrder, MK_ALIGN, MK_SP2>(F.lds + RING_OFF, g, S, E, wave0); }
                { pg8::Gemm g = pg8::mk_gemm((const bf16*)(ws + WS_CKV), (const bf16*)(ws + WS_WUKV) + (size_t)j * NKV * KVL, KVL, KVL); pg8::StaticOrder S; S.init(MKV, NKV, F.G, cid);
                  pg8::EpiBf16<0> E{(bf16*)(ws + WS_KN), D, D, (size_t)(WS_V - WS_KN) / 2, 0};
                  pg8::gemm_phase<pg8::EpiBf16<0>, pg8::StaticOrder, MK_ALIGN, MK_SP2>(F.lds + RING_OFF, g, S, E, wave0); }
            } }
            SEAM(pb + 2);
            if (IN(pb + 3) && ON(5)) { PHASE_BEGIN(); for (int rep = 0; rep < NREP(5); ++rep) { if (rep) xcd_barrier(bar, wave0 * 64 + lane_now() == 0); const float* lmods = mods + (size_t)layer * NMOD * ADA_N; (void)lmods; attn_phase(F, (char*)lds + RING_OFF); } }
            SEAM(pb + 3);
            if (IN(pb + 4) && ON(6)) { PHASE_BEGIN(); for (int rep = 0; rep < NREP(6); ++rep) { if (rep) xcd_barrier(bar, wave0 * 64 + lane_now() == 0); const float* lmods = mods + (size_t)layer * NMOD * ADA_N; (void)lmods; pg8::Gemm g = pg8::mk_gemm((const bf16*)(ws + WS_O), (const bf16*)(ws + WS_WO) + (size_t)j * D * D, D, D); pg8::StaticOrder S; S.init(NTOK, D, F.G, cid);
                pg8::EpiRes E{(NREP(6) == 2 && rep == 0) ? (bf16*)(ws + WS_PROJ) : X, lmods + 2 * D};
                pg8::gemm_phase<pg8::EpiRes, pg8::StaticOrder, MK_ALIGN_RES, MK_SP2>(F.lds + RING_OFF, g, S, E, wave0); } }
            SEAM(pb + 4);
        } else {
            if (IN(pb + 0) && ON(7)) { PHASE_BEGIN(); for (int rep = 0; rep < NREP(7); ++rep) { if (rep) xcd_barrier(bar, wave0 * 64 + lane_now() == 0); const float* lmods = mods + (size_t)layer * NMOD * ADA_N; (void)lmods; pg8::Gemm g = pg8::mk_gemm(Hb, (const bf16*)(ws + WS_WRIN) + (size_t)j * 2 * D * D, D, D); pg8::StaticOrder S; S.init(NTOK, 2 * D, F.G, cid);
                pg8::EpiBf16<1> E{(bf16*)(ws + WS_RIN), 2 * D, 0, 0, D / 256};
                pg8::gemm_phase<pg8::EpiBf16<1>, pg8::StaticOrder, MK_ALIGN, MK_SP2>(F.lds + RING_OFF, g, S, E, wave0); } }
            SEAM(pb + 0);
            if (IN(pb + 1) && ON(8)) { PHASE_BEGIN(); for (int rep = 0; rep < NREP(8); ++rep) { if (rep) xcd_barrier(bar, wave0 * 64 + lane_now() == 0); const float* lmods = mods + (size_t)layer * NMOD * ADA_N; (void)lmods; conv4_phase(F, args, j); } }
            SEAM(pb + 1);
            if (!MK_RS && IN(pb + 2) && ON(9)) { PHASE_BEGIN(); for (int rep = 0; rep < NREP(9); ++rep) { if (rep) xcd_barrier(bar, wave0 * 64 + lane_now() == 0); const float* lmods = mods + (size_t)layer * NMOD * ADA_N; (void)lmods; pg8::Gemm g = pg8::mk_gemm((const bf16*)(ws + WS_XC), (const bf16*)(ws + WS_WG) + (size_t)j * 8192 * 128, 128, D); pg8::GateOrder S; S.init(NTOK, 8192, F.G, cid);
                pg8::EpiGates E{(bf16*)(ws + WS_LA), (bf16*)(ws + WS_UU), (const bf16*)(ws + WS_XC), args.in[23] + (size_t)j * 2 * D, args.in[25] + (size_t)j * 2 * D, (const float*)(ws + WS_SP) + (size_t)j * 2 * D, (LAS float*)(F.lds + EDGE_OFF)};
                pg8::gemm_phase<pg8::EpiGates, pg8::GateOrder, MK_ALIGN_G, MK_SP2>(F.lds + RING_OFF, g, S, E, wave0); } }
            if (!MK_RS) SEAM(pb + 2);
            if (IN(pb + 3) && ON(10)) { PHASE_BEGIN(); for (int rep = 0; rep < NREP(10); ++rep) { if (rep) xcd_barrier(bar, wave0 * 64 + lane_now() == 0); const float* lmods = mods + (size_t)layer * NMOD * ADA_N; (void)lmods; if (MK_RS) rs_phase(F, args, j, wave0); else scan_phase(F, args, j); } }
            SEAM(pb + 3);
            if (IN(pb + 4) && ON(11)) { PHASE_BEGIN(); for (int rep = 0; rep < NREP(11); ++rep) { if (rep) xcd_barrier(bar, wave0 * 64 + lane_now() == 0); const float* lmods = mods + (size_t)layer * NMOD * ADA_N; (void)lmods; pg8::Gemm g = pg8::mk_gemm((const bf16*)(ws + WS_MIX), (const bf16*)(ws + WS_WROUT) + (size_t)j * D * D, D, D); pg8::StaticOrder S; S.init(NTOK, D, F.G, cid);
                pg8::EpiRes E{(NREP(11) == 2 && rep == 0) ? (bf16*)(ws + WS_RIN) : X, lmods + 2 * D};
                pg8::gemm_phase<pg8::EpiRes, pg8::StaticOrder, MK_ALIGN_RES, MK_SP2>(F.lds + RING_OFF, g, S, E, wave0); } }
            SEAM(pb + 4);
        }
        if (IN(pb + 5) && ON(12)) { PHASE_BEGIN(); for (int rep = 0; rep < NREP(12); ++rep) { if (rep) xcd_barrier(bar, wave0 * 64 + lane_now() == 0); const float* lmods = mods + (size_t)layer * NMOD * ADA_N; (void)lmods; norm_phase<1>(F, args, args.in[8] + (size_t)layer * D, lmods, 3); } }
        SEAM(pb + 5);
        if (IN(pb + 6) && ON(13)) { PHASE_BEGIN(); for (int rep = 0; rep < NREP(13); ++rep) { if (rep) xcd_barrier(bar, wave0 * 64 + lane_now() == 0); const float* lmods = mods + (size_t)layer * NMOD * ADA_N; (void)lmods; pg8::Gemm g = pg8::mk_gemm(Hb, (const bf16*)(ws + WS_WUP) + (size_t)layer * NUP * D, D, D); g.b_hstep = (size_t)DFF * D * 2; g.b_tstep = (size_t)pg8::HALF * D * 2;
            pg8::StaticOrder S; S.init(NTOK, NUP, F.G, cid);
            pg8::EpiFfn E{(bf16*)(ws + WS_ACT), (float*)(ws + WS_HALO), args.in[29] + (size_t)layer * 3 * NUP, args.in[30] + (size_t)layer * NUP, (LAS float*)(F.lds + EDGE_OFF)};
            pg8::gemm_phase<pg8::EpiFfn, pg8::StaticOrder, MK_ALIGN, MK_SP2>(F.lds + RING_OFF, g, S, E, wave0); } }
        SEAM2(pb + 6, pb + 8);
        if (IN(pb + 8) && ON(15)) { PHASE_BEGIN(); for (int rep = 0; rep < NREP(15); ++rep) { if (rep) xcd_barrier(bar, wave0 * 64 + lane_now() == 0); const float* lmods = mods + (size_t)layer * NMOD * ADA_N; (void)lmods; pg8::Gemm g = pg8::mk_gemm((const bf16*)(ws + WS_ACT), (const bf16*)(ws + WS_WDN) + (size_t)layer * D * ALD, DFF, ALD); g.ldb = ALD; g.b_hstep = (size_t)pg8::HALF * ALD * 2; g.b_tstep = (size_t)pg8::BM * ALD * 2; pg8::StaticOrder S; S.init(NTOK, D, F.G, cid);
            { pg8::Unit u0, u1; if (S.next(0, u0)) { ffn_fix_panel(F, args, layer, u0.pm); if (S.next(1, u1) && u1.pm != u0.pm) ffn_fix_panel(F, args, layer, u1.pm); }
              asm volatile("s_waitcnt vmcnt(0)" ::: "memory"); __syncthreads(); }
#ifdef MK_KREP
            typedef pg8::EpiResT<MK_KREP> EpiF3;
#else
            typedef pg8::EpiRes EpiF3;
#endif
            EpiF3 E{(NREP(15) == 2 && rep == 0) ? (bf16*)(ws + WS_U) : X, lmods + 5 * D};
            pg8::gemm_phase<EpiF3, pg8::StaticOrder, MK_ALIGN_RES, MK_SP2>(F.lds + RING_OFF, g, S, E, wave0); } }
        SEAM(pb + 8);
        if (IN(pb + 9) && ON(16)) { PHASE_BEGIN(); for (int rep = 0; rep < NREP(16); ++rep) { if (rep) xcd_barrier(bar, wave0 * 64 + lane_now() == 0); const float* lmods = mods + (size_t)layer * NMOD * ADA_N; (void)lmods; if (layer + 1 < NLAYER) norm_phase<1>(F, args, args.in[7] + (size_t)(layer + 1) * D, lmods + (size_t)NMOD * ADA_N, 0); else norm_phase<2>(F, args, args.in[9], mods, 0); } }
        if (layer + 1 < NLAYER) SEAM(pb + 9);
    }
#if MK_PROBE
    xcd_barrier(bar, wave0 * 64 + lane_now() == 0); STAMP(NPHASE);
    { float* cw = (float*)(args.ws + WS_CTL) + 8192;
      if (blockIdx.x == 0 && threadIdx.x == 0) { float T[17]; for (int i = 0; i < 17; ++i) T[i] = 0.f;
          const LAS unsigned long long* ts = (const LAS unsigned long long*)(F.lds + STAMP_OFF);
          float t1 = 0.f, t2 = 0.f;
          for (int p = 0; p < NPHASE; ++p) { const float dt = (float)(ts[p + 1] - ts[p]) * 0.01f; int kind;
              if (p < 2) kind = p; else { const int k = (p - 2) % 10, ly = (p - 2) / 10; kind = k < 5 ? ((ly & 1) ? 7 + k : 2 + k) : 7 + k; }
              if (kind == MK_SEL1 || MK_SEL1 == 99) t1 += dt; if (kind == MK_SEL2 || MK_SEL2 == 99) t2 += dt; }
          (void)T; cw[0] = sqrtf(t1); cw[1] = t2 * MK_SCALE2; }
      xcd_barrier(bar, wave0 * 64 + lane_now() == 0);
      const float c1 = cw[0], c2 = cw[1];
      for (size_t i = (size_t)blockIdx.x * 512 + threadIdx.x; i < OUT_TOTAL; i += (size_t)gridDim.x * 512)
          args.out[i] = (i >= (size_t)MCTX * D && i < 2ull * MCTX * D) ? c1 : (i == 0 ? c2 : 0.f); }
#endif
#undef IN
#undef SEAM
#undef SEAM2
}

extern "C" void kernel_launch(void* const* d_in, const int* in_sizes, int n_in, void* d_out, int out_size, void* d_ws, size_t ws_size, hipStream_t stream) {
    static int grid = 0;
    if (grid == 0) {
        if (n_in != 32 || in_sizes[0] != MCTX * D || in_sizes[1] != MCTX * D || (size_t)out_size != OUT_TOTAL || ws_size < WS_END) {
            fprintf(stderr, "kernel_launch: shape mismatch (n_in %d, out %d, ws %zu); nothing launched\n", n_in, out_size, ws_size); grid = -1; return; }
        int dev = 0, cus = 0, per_cu = 0;
        if (hipGetDevice(&dev) != hipSuccess || hipDeviceGetAttribute(&cus, hipDeviceAttributeMultiprocessorCount, dev) != hipSuccess) { grid = -1; return; }
        if (hipFuncSetAttribute((const void*)mk_fwd, hipFuncAttributeMaxDynamicSharedMemorySize, LDS_BYTES) != hipSuccess) { fprintf(stderr, "kernel_launch: hipFuncSetAttribute failed\n"); grid = -1; return; }
        if (hipOccupancyMaxActiveBlocksPerMultiprocessor(&per_cu, (const void*)mk_fwd, NWAVES * 64, LDS_BYTES) != hipSuccess || per_cu < 1)
            fprintf(stderr, "kernel_launch: note: occupancy query reports %d workgroups per CU\n", per_cu);
        (void)hipGetLastError();
        grid = cus;
        if (grid != 256) fprintf(stderr, "kernel_launch: note: %d CUs (tuned for 256)\n", grid);
    }
    if (grid < 0) return;
    if (hipMemsetAsync((char*)d_ws + WS_CTL, 0, CTL_ZERO_BYTES, stream) != hipSuccess) { fprintf(stderr, "kernel_launch: memset failed\n"); return; }
    Args a{};
    for (int i = 0; i < 32; ++i) a.in[i] = (const float*)d_in[i];
    a.out = (float*)d_out; a.ws = (unsigned char*)d_ws;
#if MK_PER_PHASE
    for (int p = 0; p < NPHASE && p < MK_STOP; ++p) { a.ph_lo = p; a.ph_hi = p + 1; hipLaunchKernelGGL(mk_fwd, dim3(grid), dim3(NWAVES * 64), LDS_BYTES, stream, a); }
#else
    a.ph_lo = 0; a.ph_hi = NPHASE; hipLaunchKernelGGL(mk_fwd, dim3(grid), dim3(NWAVES * 64), LDS_BYTES, stream, a);
#endif
    const hipError_t le = hipPeekAtLastError();
    if (le != hipSuccess) fprintf(stderr, "kernel_launch: launch failed: %s\n", hipGetErrorName(le));
}
```

```cpp
#define MK_REP 0u
#include <hip/hip_runtime.h>
#include <cstdio>
#include <cstdint>

constexpr int D = 2048, NTOK = 16384, MCTX = 8192, DFF = 5632, NUP = 2 * DFF, NLAYER = 4;
constexpr int QL = 512, KVL = 512, NH = 16, NOPE = 128, ROPE = 64, VD = 128, QKD = NOPE + ROPE;
constexpr int NIN = QL + KVL + ROPE  , NINP = 1280  , NQ = NH * QKD  , NKV = 2 * NH * NOPE  ;
constexpr int MKV = MCTX + 8 * 1280;
constexpr int NMOD = 9, ADA_N = 6 * D;
#ifndef MK_APAD
#define MK_APAD 64
#endif
constexpr int ALD = DFF + MK_APAD;
constexpr float NORM_EPS = 1e-6f;

__device__ __forceinline__ int lane_now() { int z = 0; asm volatile("" : "+v"(z)); return (int)__builtin_amdgcn_mbcnt_hi(~0u, __builtin_amdgcn_mbcnt_lo(~0u, (unsigned)z)); }

namespace pg8 {
#define PG8_LAS __attribute__((address_space(3)))
typedef unsigned short bf16_t;
typedef short bf16x8 __attribute__((ext_vector_type(8)));
typedef float f32x4 __attribute__((ext_vector_type(4)));
typedef float f32x2 __attribute__((ext_vector_type(2)));
typedef unsigned u32x4 __attribute__((ext_vector_type(4)));
typedef unsigned u32x2 __attribute__((ext_vector_type(2)));
constexpr int BM = 256, BK = 64, HALF = 128, HTB = HALF * BK * 2  , STAGE_BYTES = 8 * HTB, NXCD = 8, WGM = 8;

__host__ __device__ __forceinline__ int lds_byte(int r, int c) { const int st = (r >> 4) * 2 + (c >> 5), rr = r & 15, cc = c & 31, ob = rr * 64 + cc * 2; return st * 1024 + (ob ^ (((ob >> 9) & 1) << 5)); }
__host__ __device__ __forceinline__ void stage_rc(int b, int& R, int& C) { const int st = b / 1024, sb = b % 1024, swz = sb ^ (((sb >> 9) & 1) << 5); R = (st >> 1) * 16 + swz / 64; C = (st & 1) * 32 + (swz % 64) / 2; }
__host__ __device__ __forceinline__ int perm32(int rho) { const int n = rho >> 4, i = rho & 15; return 8 * (i >> 2) + 4 * n + (i & 3); }

struct Unit { int pm, pn; };
struct Gemm { const bf16_t* A; const bf16_t* Bt; int K; int lda; int ldb; int pad_; size_t b_hstep, b_tstep; };
__device__ __forceinline__ Gemm mk_gemm(const bf16_t* A, const bf16_t* Bt, int K, int lda) { Gemm g; g.A = A; g.Bt = Bt; g.K = K; g.lda = lda; g.ldb = K; g.pad_ = 0; g.b_hstep = (size_t)HALF * K * 2; g.b_tstep = (size_t)BM * K * 2; return g; }

struct StaticOrder {
    int nM, nN, nwg, G, c;
    __host__ __device__ void init(int M, int N, int G_, int c_) { nM = M / BM; nN = N / BM; nwg = nM * nN; G = G_; c = c_; }
    __host__ __device__ __forceinline__ bool next(int i, Unit& u) const {
        const long L = (long)i * G + c; if (L >= nwg) return false;
        int wgid = (int)L; { const int q = nwg / NXCD, r = nwg % NXCD, xcd = wgid % NXCD, off = wgid / NXCD; wgid = (xcd < r ? xcd * (q + 1) : r * (q + 1) + (xcd - r) * q) + off; }
        const int nig = WGM * nN, gid = wgid / nig, fm = gid * WGM, gsz = (nM - fm) < WGM ? (nM - fm) : WGM;
        u.pm = fm + ((wgid % nig) % gsz); u.pn = (wgid % nig) / gsz; return true;
    }
    __device__ __forceinline__ size_t acol(const Unit&) const { return 0; }
    __device__ __forceinline__ size_t bcol(const Unit&) const { return 0; }
    __device__ __forceinline__ void a_ready(const Unit&) const {}
    __device__ __forceinline__ void done(const Unit&) const {}
};
struct GateOrder : StaticOrder {
    __device__ __forceinline__ size_t acol(const Unit& u) const { return (size_t)(u.pn >> 1) * 256; }
};

struct OneUnit {
    int pm, pn;
    __device__ __forceinline__ bool next(int i, Unit& u) const { if (i) return false; u.pm = pm; u.pn = pn; return true; }
    __device__ __forceinline__ size_t acol(const Unit& u) const { return (size_t)(u.pn >> 1) * 256; }
    __device__ __forceinline__ size_t bcol(const Unit&) const { return 0; }
    __device__ __forceinline__ void a_ready(const Unit&) const {}
    __device__ __forceinline__ void done(const Unit&) const {}
};

struct KSplitOrder {
    int nwg, G, c; unsigned qbytes;
    __device__ void init(int M, int Kq, int G_, int c_) { nwg = (M / BM) * 4; G = G_; c = c_; qbytes = (unsigned)Kq * 2u; }
    __device__ __forceinline__ bool next(int i, Unit& u) const { const long L = (long)i * G + c; if (L >= nwg) return false; u.pm = (int)(L >> 2); u.pn = (int)(L & 3); return true; }
    __device__ __forceinline__ size_t acol(const Unit& u) const { return (size_t)u.pn * qbytes; }
    __device__ __forceinline__ size_t bcol(const Unit& u) const { return (size_t)u.pn * qbytes; }
    __device__ __forceinline__ void a_ready(const Unit&) const {}
    __device__ __forceinline__ void done(const Unit&) const {}
};

__device__ __forceinline__ unsigned cvt_pk_bf16(float lo, float hi) { unsigned r; asm volatile("v_cvt_pk_bf16_f32 %0, %1, %2" : "=v"(r) : "v"(lo), "v"(hi)); return r; }
__device__ __forceinline__ float bf_lo(unsigned w) { return __uint_as_float(w << 16); }
__device__ __forceinline__ float bf_hi(unsigned w) { return __uint_as_float(w & 0xffff0000u); }
__device__ __forceinline__ float fast_sigmoid(float x) { return __builtin_amdgcn_rcpf(1.0f + __builtin_amdgcn_exp2f(-1.4426950408889634f * x)); }
__device__ __forceinline__ float gelu_tanh(float x) { const float z = 0.7978845608028654f * (x + 0.044715f * x * x * x); return x * fast_sigmoid(2.0f * z); }

#ifndef MK_WT
#define MK_WT 0
#endif
template <int TG> __device__ __forceinline__ void gst16(void* p, u32x4 v) {
  if constexpr ((MK_WT >> TG) & 1) {
    asm volatile("global_store_dwordx4 %0, %1, off sc1\n\ts_nop 1" :: "v"(p), "v"(v) : "memory");
  } else {
    *(u32x4*)p = v; }
}
template <int TG> __device__ __forceinline__ void gst16f(void* p, f32x4 v) {
  if constexpr ((MK_WT >> TG) & 1) {
    asm volatile("global_store_dwordx4 %0, %1, off sc1\n\ts_nop 1" :: "v"(p), "v"(v) : "memory");
  } else {
    *(f32x4*)p = v; }
}
template <int TG> __device__ __forceinline__ void gst8(void* p, u32x2 v) {
  if constexpr ((MK_WT >> TG) & 1) {
    asm volatile("global_store_dwordx2 %0, %1, off sc1\n\ts_nop 1" :: "v"(p), "v"(v) : "memory");
  } else {
    *(u32x2*)p = v; }
}
struct EpiF32 {
    static constexpr int TAG = 0;
    static constexpr bool PERM = false, AFTER_DRAIN = false; static constexpr int KREP = 1;
    float* C; int ldc;
    __device__ __forceinline__ void operator()(const f32x4 (&acc)[2][2][4][2], const Unit& u, int wr, int wc, int fr, int fq) const {
        const int row0 = u.pm * BM + wr * 64 + fr, col0 = u.pn * BM + wc * 32 + 4 * fq;
#pragma unroll
        for (int ai = 0; ai < 2; ++ai)
#pragma unroll
            for (int m = 0; m < 4; ++m) { float* rowp = C + (size_t)(row0 + ai * HALF + m * 16) * ldc + col0;
#pragma unroll
                for (int bj = 0; bj < 2; ++bj)
#pragma unroll
                    for (int n = 0; n < 2; ++n) gst16f<TAG>(rowp + bj * HALF + n * 16, acc[ai][bj][m][n]); }
    }
};
struct EpiKr {
    static constexpr int TAG = 1;
    static constexpr bool PERM = false, AFTER_DRAIN = false; static constexpr int KREP = 1;
    float* P;
    __device__ __forceinline__ void operator()(const f32x4 (&acc)[2][2][4][2], const Unit& u, int wr, int wc, int fr, int fq) const {
        if (wc >= 2) return;
        float* base = P + ((size_t)u.pn * NTOK + u.pm * BM + wr * 64 + fr) * ROPE + wc * 32 + 4 * fq;
#pragma unroll
        for (int ai = 0; ai < 2; ++ai)
#pragma unroll
            for (int m = 0; m < 4; ++m)
#pragma unroll
                for (int n = 0; n < 2; ++n) gst16f<TAG>(base + (size_t)(ai * HALF + m * 16) * ROPE + n * 16, acc[ai][0][m][n]);
    }
};
template <int ACT> struct EpiBf16 {
    static constexpr int TAG = 2 + 10 * ACT;
    static constexpr bool PERM = true, AFTER_DRAIN = false; static constexpr int KREP = 1;
    bf16_t* O; int ldc; int split_cols; size_t split_stride; int act_tiles;
    __device__ __forceinline__ void operator()(const f32x4 (&acc)[2][2][4][2], const Unit& u, int wr, int wc, int fr, int fq) const {
        const int row0 = u.pm * BM + wr * 64 + fr; int colt = u.pn * BM; bf16_t* base = O;
        if (split_cols) { const int t = colt / split_cols; base += (size_t)t * split_stride; colt -= t * split_cols; }
        const int col0 = colt + wc * 32 + 8 * fq;
        const bool act = (ACT == 1) && (u.pn < act_tiles);
#pragma unroll
        for (int ai = 0; ai < 2; ++ai)
#pragma unroll
            for (int m = 0; m < 4; ++m) { bf16_t* rowp = base + (size_t)(row0 + ai * HALF + m * 16) * ldc + col0;
#pragma unroll
                for (int bj = 0; bj < 2; ++bj) { f32x4 v0 = acc[ai][bj][m][0], v1 = acc[ai][bj][m][1];
                    if (ACT == 1) { if (act) {
                        f32x4 e0 = v0 * (v0 * v0 * -0.10294324f + -2.3022082f), e1 = v1 * (v1 * v1 * -0.10294324f + -2.3022082f);
#pragma unroll
                        for (int j = 0; j < 4; ++j) { e0[j] = __builtin_amdgcn_exp2f(e0[j]); e1[j] = __builtin_amdgcn_exp2f(e1[j]); }
                        e0 = e0 + 1.0f; e1 = e1 + 1.0f;
#pragma unroll
                        for (int j = 0; j < 4; ++j) { e0[j] = __builtin_amdgcn_rcpf(e0[j]); e1[j] = __builtin_amdgcn_rcpf(e1[j]); }
                        v0 = v0 * e0; v1 = v1 * e1; } }
                    u32x4 w; w.x = cvt_pk_bf16(v0[0], v0[1]); w.y = cvt_pk_bf16(v0[2], v0[3]); w.z = cvt_pk_bf16(v1[0], v1[1]); w.w = cvt_pk_bf16(v1[2], v1[3]);
                    gst16<TAG>(rowp + bj * HALF, w); } }
    }
};
struct EpiQ {
    static constexpr int TAG = 3;
    static constexpr bool PERM = false, AFTER_DRAIN = false; static constexpr int KREP = 1;
    bf16_t* Q; const float* cosT; const float* sinT;
    __device__ __forceinline__ void operator()(const f32x4 (&acc)[2][2][4][2], const Unit& u, int wr, int wc, int fr, int fq) const {
        const int row0 = u.pm * BM + wr * 64 + fr; const bool sample = u.pm >= (MCTX / BM);
#pragma unroll
        for (int bj = 0; bj < 2; ++bj) {
            const int col32 = u.pn * BM + bj * HALF + wc * 32, head = col32 / QKD, d32 = col32 - head * QKD;
            const bool rope = sample && (d32 >= NOPE); const int grp = (d32 - NOPE) >> 5;
#pragma unroll
            for (int ai = 0; ai < 2; ++ai) {
                f32x4 cc[4], ss[4];
                if (rope) {
#pragma unroll
                    for (int m = 0; m < 4; ++m) { const int pos = (row0 + ai * HALF + m * 16 - MCTX) & 1023; cc[m] = *(const f32x4*)(cosT + pos * 32 + grp * 16 + 4 * fq); ss[m] = *(const f32x4*)(sinT + pos * 32 + grp * 16 + 4 * fq); } }
#pragma unroll
                for (int m = 0; m < 4; ++m) { const int row = row0 + ai * HALF + m * 16;
                    f32x4 v0 = acc[ai][bj][m][0], v1 = acc[ai][bj][m][1];
                    if (rope) { const f32x4 y0 = v0 * cc[m] - v1 * ss[m], y1 = v1 * cc[m] + v0 * ss[m]; v0 = y0; v1 = y1; }
                    u32x2 w0, w1; w0.x = cvt_pk_bf16(v0[0], v0[1]); w0.y = cvt_pk_bf16(v0[2], v0[3]); w1.x = cvt_pk_bf16(v1[0], v1[1]); w1.y = cvt_pk_bf16(v1[2], v1[3]);
                    const auto rx = __builtin_amdgcn_permlane16_swap(w0.x, w1.x, false, false), ry = __builtin_amdgcn_permlane16_swap(w0.y, w1.y, false, false);
                    u32x4 w4; w4.x = rx[0]; w4.y = ry[0]; w4.z = rx[1]; w4.w = ry[1];
                    gst16<TAG>(Q + (size_t)row * NQ + col32 + (fq >> 1) * 8 + (fq & 1) * 16, w4); } }
        }
    }
};
template <int KR = 1> struct EpiResT {
    static constexpr int TAG = 4;
    static constexpr bool PERM = true, AFTER_DRAIN = false; static constexpr int KREP = KR;
    bf16_t* X; const float* gate;
    __device__ __forceinline__ void operator()(const f32x4 (&acc)[2][2][4][2], const Unit& u, int wr, int wc, int fr, int fq) const {
        const int row0 = u.pm * BM + wr * 64 + fr, col0 = u.pn * BM + wc * 32 + 8 * fq;
        const int mod = u.pm < (MCTX / BM) ? 0 : 1 + ((u.pm - MCTX / BM) >> 2);
        const float* gp = gate + (size_t)mod * ADA_N + col0;
        f32x4 gv[2][2];
#pragma unroll
        for (int bj = 0; bj < 2; ++bj)
#pragma unroll
            for (int n = 0; n < 2; ++n) gv[bj][n] = *(const f32x4*)(gp + bj * HALF + n * 4);
        u32x4 cur[2], nxt[2];
#pragma unroll
        for (int bj = 0; bj < 2; ++bj) cur[bj] = *(const u32x4*)(X + (size_t)row0 * D + col0 + bj * HALF);
#pragma unroll
        for (int k = 0; k < 8; ++k) { const int ai = k >> 2, m = k & 3; bf16_t* rowp = X + (size_t)(row0 + ai * HALF + m * 16) * D + col0;
            if (k < 7) { const bf16_t* nrow = X + (size_t)(row0 + ((k + 1) >> 2) * HALF + ((k + 1) & 3) * 16) * D + col0;
#pragma unroll
                for (int bj = 0; bj < 2; ++bj) nxt[bj] = *(const u32x4*)(nrow + bj * HALF); }
#pragma unroll
            for (int bj = 0; bj < 2; ++bj) { const u32x4 xw = cur[bj];
                const f32x4 x0 = (f32x4){bf_lo(xw.x), bf_hi(xw.x), bf_lo(xw.y), bf_hi(xw.y)} + gv[bj][0] * acc[ai][bj][m][0];
                const f32x4 x1 = (f32x4){bf_lo(xw.z), bf_hi(xw.z), bf_lo(xw.w), bf_hi(xw.w)} + gv[bj][1] * acc[ai][bj][m][1];
                u32x4 w; w.x = cvt_pk_bf16(x0[0], x0[1]); w.y = cvt_pk_bf16(x0[2], x0[3]); w.z = cvt_pk_bf16(x1[0], x1[1]); w.w = cvt_pk_bf16(x1[2], x1[3]);
                gst16<TAG>(rowp + bj * HALF, w); cur[bj] = nxt[bj]; }
            asm volatile("" ::: "memory"); }
    }
};
typedef EpiResT<1> EpiRes;
#ifndef MK_GOLD
#define MK_GOLD 0
#endif
#if MK_GOLD
#define GSC_B 1.0f
#define GSC_S 1.0f
#else
#define GSC_B 1.4426950408889634f
#define GSC_S -1.0f
#endif
struct EpiGates {
    static constexpr int TAG = 5;
    static constexpr bool PERM = true, AFTER_DRAIN = false; static constexpr int KREP = 1;
    bf16_t* LA; bf16_t* UU; const bf16_t* XC; const float* bgx; const float* bga; const float* sp; PG8_LAS float* prm;
    __device__ __forceinline__ void operator()(const f32x4 (&acc)[2][2][4][2], const Unit& u, int wr, int wc, int fr, int fq) const {
        const int blk = u.pn >> 1, dir = u.pn & 1, row0 = u.pm * BM + wr * 64 + fr, chw = wc * 32 + 8 * fq, ch0 = blk * 128 + chw;
        const char* xcb = (const char*)XC; char* lab = (char*)(LA + (size_t)dir * NTOK * D); char* uub = (char*)(UU + (size_t)dir * NTOK * D);
        { const int t = (wr * 4 + wc) * 64 + fq * 16 + fr;
          const int c4 = (t & 31) * 4, go = dir * D + blk * 128 + c4;
          if (t < 32) *(PG8_LAS f32x4*)(prm + c4) = *(const f32x4*)(bgx + go) * GSC_B;
          else if (t < 64) *(PG8_LAS f32x4*)(prm + 128 + c4) = *(const f32x4*)(bga + go) * GSC_B;
          else if (t < 96) *(PG8_LAS f32x4*)(prm + 256 + c4) = *(const f32x4*)(sp + go) * GSC_S; }
        asm volatile("s_waitcnt vmcnt(0) lgkmcnt(0)" ::: "memory"); __builtin_amdgcn_s_barrier(); asm volatile("" ::: "memory");
#pragma unroll
        for (int aq = 0; aq < 4; ++aq) { const int ai = aq >> 1; u32x4 xw[4];
#pragma unroll
            for (int m = (aq & 1) * 2; m < (aq & 1) * 2 + 2; ++m) xw[m] = *(const u32x4*)(xcb + ((unsigned)(row0 + ai * HALF + m * 16) * D + ch0) * 2u);
#pragma unroll
            for (int m = (aq & 1) * 2; m < (aq & 1) * 2 + 2; ++m) { const unsigned ro = ((unsigned)(row0 + ai * HALF + m * 16) * D + ch0) * 2u; u32x4 wl, wu;
#pragma unroll
                for (int n = 0; n < 2; ++n) { const unsigned x01 = n ? xw[m].z : xw[m].x, x23 = n ? xw[m].w : xw[m].y;
                    const f32x4 bx = *(const PG8_LAS f32x4*)(prm + chw + 4 * n), ba = *(const PG8_LAS f32x4*)(prm + 128 + chw + 4 * n), sv = *(const PG8_LAS f32x4*)(prm + 256 + chw + 4 * n);
#if MK_GOLD
                    const float xv[4] = {bf_lo(x01), bf_hi(x01), bf_lo(x23), bf_hi(x23)}; float l2[4], uv[4];
#pragma unroll
                    for (int j = 0; j < 4; ++j) { const float sx = fast_sigmoid(acc[ai][0][m][n][j] + bx[j]), sa = fast_sigmoid(acc[ai][1][m][n][j] + ba[j]);
                        l2[j] = -sa * sv[j]; const float a2 = __builtin_amdgcn_exp2f(2.0f * l2[j]); uv[j] = __builtin_amdgcn_sqrtf(fmaxf(1.0f - a2, 0.0f)) * sx * xv[j]; }
#else
                    const f32x4 xv = {bf_lo(x01), bf_hi(x01), bf_lo(x23), bf_hi(x23)};
                    f32x4 ex = acc[ai][0][m][n] * 1.4426950408889634f + bx, ea = acc[ai][1][m][n] * 1.4426950408889634f + ba;
#pragma unroll
                    for (int j = 0; j < 4; ++j) { ex[j] = __builtin_amdgcn_exp2f(-ex[j]); ea[j] = __builtin_amdgcn_exp2f(-ea[j]); }
                    ex = ex + 1.0f; ea = ea + 1.0f;
#pragma unroll
                    for (int j = 0; j < 4; ++j) { ex[j] = __builtin_amdgcn_rcpf(ex[j]); ea[j] = __builtin_amdgcn_rcpf(ea[j]); }
                    const f32x4 l2 = ea * sv; f32x4 av;
#pragma unroll
                    for (int j = 0; j < 4; ++j) av[j] = __builtin_amdgcn_exp2f(l2[j]);
                    f32x4 om = av * av - 1.0f;
#pragma unroll
                    for (int j = 0; j < 4; ++j) om[j] = __builtin_amdgcn_sqrtf(__builtin_fabsf(om[j]));
                    const f32x4 uv = om * ex * xv;
#endif
                    if (n == 0) { wl.x = cvt_pk_bf16(l2[0], l2[1]); wl.y = cvt_pk_bf16(l2[2], l2[3]); wu.x = cvt_pk_bf16(uv[0], uv[1]); wu.y = cvt_pk_bf16(uv[2], uv[3]); }
                    else { wl.z = cvt_pk_bf16(l2[0], l2[1]); wl.w = cvt_pk_bf16(l2[2], l2[3]); wu.z = cvt_pk_bf16(uv[0], uv[1]); wu.w = cvt_pk_bf16(uv[2], uv[3]); }
                    __builtin_amdgcn_sched_barrier(0); }
                gst16<TAG>(lab + ro, wl); gst16<TAG>(uub + ro, wu); }
            asm volatile("" ::: "memory"); }
    }
};

struct EpiGatesLds {
    static constexpr int TAG = 7;
    static constexpr bool PERM = true, AFTER_DRAIN = true; static constexpr int KREP = 1;
    const bf16_t* XC; const float* bgx; const float* bga; const float* sp; PG8_LAS float* prm;
    __device__ __forceinline__ void operator()(const f32x4 (&)[2][2][4][2], const Unit&, int, int, int, int) const {}
    __device__ __forceinline__ f32x4 pre(const Unit& u, int t) const { f32x4 r = {0.f, 0.f, 0.f, 0.f};
        const int blk = u.pn >> 1, dir = u.pn & 1, go = dir * D + blk * 128 + (t & 31) * 4;
        if (t < 32) r = *(const f32x4*)(bgx + go); else if (t < 64) r = *(const f32x4*)(bga + go); else if (t < 96) r = *(const f32x4*)(sp + go);
        return r; }
    __device__ __forceinline__ void fused(const f32x4 (&acc)[2][2][4][2], const Unit& u, int wr, int wc, int fr, int fq, PG8_LAS unsigned char* img, const f32x4 pf) const {
        const int blk = u.pn >> 1, dir = u.pn & 1, rl0 = wr * 64 + fr, row0 = u.pm * BM + rl0, chw = wc * 32 + 8 * fq, ch0 = blk * 128 + chw;
        const char* xcb = (const char*)XC;
        u32x4 xa[2][4];
#pragma unroll
        for (int m = 0; m < 4; ++m) xa[0][m] = *(const u32x4*)(xcb + ((unsigned)(row0 + m * 16) * D + ch0) * 2u);
        { const int t = (wr * 4 + wc) * 64 + fq * 16 + fr;
          if (t < 96) *(PG8_LAS f32x4*)(prm + (t >> 5) * 128 + (t & 31) * 4) = pf * (t < 64 ? GSC_B : GSC_S); }
        asm volatile("s_waitcnt lgkmcnt(0)" ::: "memory"); __builtin_amdgcn_s_barrier(); asm volatile("" ::: "memory");
#pragma unroll
        for (int aq = 0; aq < 4; ++aq) { const int ai = aq >> 1;
            if (aq == 0) {
#pragma unroll
                for (int m = 0; m < 4; ++m) xa[1][m] = *(const u32x4*)(xcb + ((unsigned)(row0 + HALF + m * 16) * D + ch0) * 2u); }
#pragma unroll
            for (int m = (aq & 1) * 2; m < (aq & 1) * 2 + 2; ++m) { const int rl = rl0 + ai * HALF + m * 16;
#pragma unroll
                for (int n = 0; n < 2; ++n) { const unsigned x01 = n ? xa[ai][m].z : xa[ai][m].x, x23 = n ? xa[ai][m].w : xa[ai][m].y;
                    const f32x4 bx = *(const PG8_LAS f32x4*)(prm + chw + 4 * n), ba = *(const PG8_LAS f32x4*)(prm + 128 + chw + 4 * n), sv = *(const PG8_LAS f32x4*)(prm + 256 + chw + 4 * n);
                    const f32x4 xv = {bf_lo(x01), bf_hi(x01), bf_lo(x23), bf_hi(x23)};
                    f32x4 ex = acc[ai][0][m][n] * 1.4426950408889634f + bx, ea = acc[ai][1][m][n] * 1.4426950408889634f + ba;
#pragma unroll
                    for (int j = 0; j < 4; ++j) { ex[j] = __builtin_amdgcn_exp2f(-ex[j]); ea[j] = __builtin_amdgcn_exp2f(-ea[j]); }
                    ex = ex + 1.0f; ea = ea + 1.0f;
#pragma unroll
                    for (int j = 0; j < 4; ++j) { ex[j] = __builtin_amdgcn_rcpf(ex[j]); ea[j] = __builtin_amdgcn_rcpf(ea[j]); }
                    const f32x4 l2 = ea * sv; f32x4 av;
#pragma unroll
                    for (int j = 0; j < 4; ++j) av[j] = __builtin_amdgcn_exp2f(l2[j]);
                    f32x4 om = av * av - 1.0f;
#pragma unroll
                    for (int j = 0; j < 4; ++j) om[j] = __builtin_amdgcn_sqrtf(__builtin_fabsf(om[j]));
                    const f32x4 uv = om * ex * xv;
                    u32x4 w; w.x = cvt_pk_bf16(l2[0], uv[0]); w.y = cvt_pk_bf16(l2[1], uv[1]); w.z = cvt_pk_bf16(l2[2], uv[2]); w.w = cvt_pk_bf16(l2[3], uv[3]);
                    const int chunk = (wc * 8 + 2 * fq + n) ^ (rl & 31);
                    *(PG8_LAS u32x4*)(img + rl * 512 + chunk * 16) = w;
                    __builtin_amdgcn_sched_barrier(0); } }
            asm volatile("" ::: "memory"); }
    }
};

__device__ __forceinline__ f32x4 dpp_ror1(f32x4 v) { f32x4 r;
#pragma unroll
    for (int j = 0; j < 4; ++j) r[j] = __int_as_float(__builtin_amdgcn_mov_dpp(__float_as_int(v[j]), 0x121, 0xf, 0xf, false)); return r; }
__device__ __forceinline__ f32x4 dpp_rol1(f32x4 v) { f32x4 r;
#pragma unroll
    for (int j = 0; j < 4; ++j) r[j] = __int_as_float(__builtin_amdgcn_mov_dpp(__float_as_int(v[j]), 0x12f, 0xf, 0xf, false)); return r; }
#ifndef MK_KREP_F1
#define MK_KREP_F1 1
#endif
struct EpiFfn {
    static constexpr int TAG = 6;
    static constexpr bool PERM = true, AFTER_DRAIN = false; static constexpr int KREP = MK_KREP_F1;
    bf16_t* ACT; float* HALO; const float* wcv; const float* bcv; PG8_LAS float* edge;
    __device__ __forceinline__ f32x4 pre(const Unit& u, int t) const { f32x4 r = {0.f, 0.f, 0.f, 0.f};
        if (t < 256) { const int p2 = t >> 5, p = p2 >> 1, bjp = p2 & 1, c4 = (t & 31) * 4; const float* src = (p < 3 ? wcv + (size_t)p * NUP : bcv) + bjp * DFF + u.pn * HALF + c4; asm volatile("global_load_dwordx4 %0, %1, off" : "=&v"(r) : "v"(src) : "memory"); }
        return r; }
    __device__ __forceinline__ void operator()(const f32x4 (&acc)[2][2][4][2], const Unit& u, int wr, int wc, int fr, int fq, const f32x4 pf) const {
        const int chw = wc * 32 + 8 * fq;
#pragma unroll
        for (int ai = 0; ai < 2; ++ai) { const int grp = 2 * ai + wr;
            if (fr == 0) {
#pragma unroll
                for (int bj = 0; bj < 2; ++bj)
#pragma unroll
                    for (int n = 0; n < 2; ++n) *(PG8_LAS f32x4*)(edge + (grp * 2 + 0) * 256 + bj * HALF + chw + 4 * n) = acc[ai][bj][0][n]; }
            if (fr == 15) {
#pragma unroll
                for (int bj = 0; bj < 2; ++bj)
#pragma unroll
                    for (int n = 0; n < 2; ++n) *(PG8_LAS f32x4*)(edge + (grp * 2 + 1) * 256 + bj * HALF + chw + 4 * n) = acc[ai][bj][3][n]; } }
        PG8_LAS float* prm = edge + 4 * 2 * 256;
        { const int t = (wr * 4 + wc) * 64 + fq * 16 + fr;
          asm volatile("s_waitcnt vmcnt(8)" ::: "memory");
          if (t < 256) { const int p2 = t >> 5, bjp = p2 & 1, c4 = (t & 31) * 4;
              *(PG8_LAS f32x4*)(prm + p2 * 128 + c4) = pf * (bjp ? -0.6931471805599453f : -1.4426950408889634f); } }
        asm volatile("s_waitcnt lgkmcnt(0)" ::: "memory"); __builtin_amdgcn_s_barrier(); asm volatile("" ::: "memory");
        if (u.pm >= MCTX / BM) { float* hb = HALO + (size_t)u.pm * 4 * NUP + u.pn * HALF + chw;
            if (wr == 0 && fr == 0) {
#pragma unroll
                for (int m = 0; m < 2; ++m)
#pragma unroll
                    for (int bj = 0; bj < 2; ++bj)
#pragma unroll
                        for (int n = 0; n < 2; ++n) *(f32x4*)(hb + (size_t)m * NUP + bj * DFF + 4 * n) = acc[0][bj][m][n]; }
            if (wr == 1 && fr == 15) {
#pragma unroll
                for (int m = 2; m < 4; ++m)
#pragma unroll
                    for (int bj = 0; bj < 2; ++bj)
#pragma unroll
                        for (int n = 0; n < 2; ++n) *(f32x4*)(hb + (size_t)m * NUP + bj * DFF + 4 * n) = acc[1][bj][m][n]; } }
#pragma unroll
        for (int ai = 0; ai < 2; ++ai) { const int grp = 2 * ai + wr; u32x2 o0[4];
#pragma unroll
            for (int n = 0; n < 2; ++n) { f32x4 gval[4];
#pragma unroll
                for (int bj = 0; bj < 2; ++bj) {
                    const f32x4 w0 = *(const PG8_LAS f32x4*)(prm + (0 + bj) * 128 + chw + 4 * n), w1 = *(const PG8_LAS f32x4*)(prm + (2 + bj) * 128 + chw + 4 * n), w2 = *(const PG8_LAS f32x4*)(prm + (4 + bj) * 128 + chw + 4 * n), bb = *(const PG8_LAS f32x4*)(prm + (6 + bj) * 128 + chw + 4 * n);
                    const f32x4 hp = grp > 0 ? *(const PG8_LAS f32x4*)(edge + ((grp - 1) * 2 + 1) * 256 + bj * HALF + chw + 4 * n) : (f32x4){0.f, 0.f, 0.f, 0.f};
                    const f32x4 hn = grp < 3 ? *(const PG8_LAS f32x4*)(edge + ((grp + 1) * 2 + 0) * 256 + bj * HALF + chw + 4 * n) : (f32x4){0.f, 0.f, 0.f, 0.f};
                    f32x4 pfirst, nlast;
#pragma unroll
                    for (int j = 0; j < 4; ++j) { pfirst[j] = __int_as_float(__builtin_amdgcn_update_dpp(__float_as_int(hp[j]), __float_as_int(acc[ai][bj][3][n][j]), 0x111, 0xf, 0xf, false));
                                                  nlast[j] = __int_as_float(__builtin_amdgcn_update_dpp(__float_as_int(hn[j]), __float_as_int(acc[ai][bj][0][n][j]), 0x101, 0xf, 0xf, false)); }
#pragma unroll
                    for (int m = 0; m < 4; ++m) { const f32x4 pv = m > 0 ? acc[ai][bj][m - 1][n] : pfirst, nx = m < 3 ? acc[ai][bj][m + 1][n] : nlast;
                        const f32x4 val = bb + w0 * pv + w1 * acc[ai][bj][m][n] + w2 * nx;
                        if (bj == 0) gval[m] = val;
                        else { f32x4 e;
#pragma unroll
                            for (int j = 0; j < 4; ++j) e[j] = __builtin_amdgcn_exp2f(gval[m][j]);
                            e = e + 1.0f;
#pragma unroll
                            for (int j = 0; j < 4; ++j) e[j] = __builtin_amdgcn_rcpf(e[j]);
                            const f32x4 o = gval[m] * val * e;
                            u32x2 w; w.x = cvt_pk_bf16(o[0], o[1]); w.y = cvt_pk_bf16(o[2], o[3]);
                            if (n == 0) o0[m] = w;
                            else { u32x4 w4; w4.x = o0[m].x; w4.y = o0[m].y; w4.z = w.x; w4.w = w.y;
                                gst16<TAG>(ACT + (size_t)(u.pm * BM + ai * HALF + wr * 64 + 4 * fr + m) * ALD + u.pn * HALF + chw, w4); } } }
                    __builtin_amdgcn_sched_barrier(0); } } }
    }
};

template <int N> __device__ __forceinline__ void waitv() { asm volatile("s_waitcnt vmcnt(%0)" :: "n"(N) : "memory"); }
template <class Epi, class Sched, bool ALIGN_EPI = false, bool SP2 = false>
__device__ __forceinline__ void gemm_phase(PG8_LAS unsigned char* lds, const Gemm g, const Sched& S, const Epi& E, int wave0  ) {
    int tid_ = wave0 * 64 + lane_now(); asm volatile("" : "+v"(tid_));
    const int tid = tid_, wid = __builtin_amdgcn_readfirstlane(tid >> 6), lane = tid & 63, wr = wid >> 2, wc = wid & 3, fr = lane & 15, fq = lane >> 4;
    const int K = g.K, nt = K / BK;
    constexpr int NST = Epi::TAG == 0 ? 32 : (Epi::TAG == 1 ? 0 : 16);
    unsigned voffA[2], voffB[2];
#pragma unroll
    for (int i = 0; i < 2; ++i) { int R, C; stage_rc(tid * 16 + i * 8192, R, C); const int Rb = Epi::PERM ? ((R & ~31) + perm32(R & 31)) : R;
        const int Ra = (Epi::TAG == 6) ? ((R & ~63) + 4 * (R & 15) + ((R & 63) >> 4)) : R;
        voffA[i] = (unsigned)(Ra * g.lda + C) * 2u; voffB[i] = (unsigned)(Rb * g.ldb + C) * 2u; }
    const size_t kstep = (size_t)(BK * 2);
    const size_t hstepA = (size_t)HALF * g.lda * 2, hstepB = g.b_hstep;
    const size_t tstepA = 2 * hstepA, tstepB = g.b_tstep;
    const unsigned ldsw = (unsigned)wid * 1024u;
    const int aoff = lds_byte(wr * 64 + fr, fq * 8), boff = lds_byte(wc * 32 + fr, fq * 8);
#define PG8_SA(b, h) (((b) * 2 + (h)) * HTB)
#define PG8_SB(b, h) ((4 + (b) * 2 + (h)) * HTB)
#define PG8_STAGE(bufoff, gbase, voff) do { _Pragma("unroll") for (int _i = 0; _i < 2; ++_i) { unsigned vo_ = (voff)[_i]; asm volatile("" : "+v"(vo_));     \
        __builtin_amdgcn_global_load_lds((const unsigned*)((const char*)(gbase) + vo_), (PG8_LAS unsigned*)(lds + (bufoff) + ldsw + _i * 8192), 16, 0, 0); } } while (0)
#define PG8_LDA(dst, b, h) do { _Pragma("unroll") for (int m = 0; m < 4; ++m) _Pragma("unroll") for (int k = 0; k < 2; ++k) dst[m][k] = *(const PG8_LAS bf16x8*)(lds + PG8_SA(b, h) + aoff + m * 2048 + k * 1024); } while (0)
#define PG8_LDB(dst, b, h) do { _Pragma("unroll") for (int n = 0; n < 2; ++n) _Pragma("unroll") for (int k = 0; k < 2; ++k) dst[n][k] = *(const PG8_LAS bf16x8*)(lds + PG8_SB(b, h) + boff + n * 2048 + k * 1024); } while (0)
#define PG8_MMA(ai, bj, At, Bt) do { __builtin_amdgcn_s_setprio(1); _Pragma("unroll") for (int m = 0; m < 4; ++m) _Pragma("unroll") for (int n = 0; n < 2; ++n) _Pragma("unroll") for (int k = 0; k < 2; ++k) \
        acc[ai][bj][m][n] = __builtin_amdgcn_mfma_f32_16x16x32_bf16(Bt[n][k], At[m][k], acc[ai][bj][m][n], 0, 0, 0); __builtin_amdgcn_s_setprio(0); } while (0)
#define PG8_WAIT_V(n) asm volatile("s_waitcnt vmcnt(" #n ")" ::: "memory")
#define PG8_WAIT_L(n) asm volatile("s_waitcnt lgkmcnt(" #n ")" ::: "memory")
#define PG8_BAR __builtin_amdgcn_s_barrier()
#define PG8_SCHED __builtin_amdgcn_sched_barrier(0)
    Unit cur, nxt; int ui = 0;
    if (!S.next(0, cur)) return;
    f32x4 acc[2][2][4][2];
#pragma unroll
    for (int a = 0; a < 2; ++a)
#pragma unroll
        for (int b = 0; b < 2; ++b)
#pragma unroll
            for (int m = 0; m < 4; ++m)
#pragma unroll
                for (int n = 0; n < 2; ++n) acc[a][b][m][n] = (f32x4){0.f, 0.f, 0.f, 0.f};
    bf16x8 At[4][2], B0[2][2], B1[2][2];
    const char* cA = (const char*)g.A + (size_t)cur.pm * tstepA + S.acol(cur); const char* cB = (const char*)g.Bt + (size_t)cur.pn * tstepB + S.bcol(cur);
    S.a_ready(cur);
    if constexpr (SP2) {
        PG8_STAGE(PG8_SB(0, 0), cB, voffB); PG8_STAGE(PG8_SB(0, 1), cB + hstepB, voffB); PG8_STAGE(PG8_SA(0, 0), cA, voffA); PG8_STAGE(PG8_SA(0, 1), cA + hstepA, voffA);
        if (wr == 1) PG8_BAR;
        PG8_WAIT_V(2); PG8_BAR;
        PG8_STAGE(PG8_SB(1, 0), cB + kstep, voffB); PG8_STAGE(PG8_SA(1, 0), cA + kstep, voffA); PG8_STAGE(PG8_SB(1, 1), cB + hstepB + kstep, voffB);
        PG8_WAIT_V(6); PG8_BAR;
    } else {
        PG8_STAGE(PG8_SB(0, 0), cB, voffB); PG8_STAGE(PG8_SA(0, 0), cA, voffA); PG8_STAGE(PG8_SB(0, 1), cB + hstepB, voffB); PG8_STAGE(PG8_SA(0, 1), cA + hstepA, voffA);
        if (wr == 1) PG8_BAR;
        PG8_WAIT_V(4); PG8_BAR;
        PG8_STAGE(PG8_SB(1, 0), cB + kstep, voffB); PG8_STAGE(PG8_SA(1, 0), cA + kstep, voffA); PG8_STAGE(PG8_SB(1, 1), cB + hstepB + kstep, voffB);
        PG8_WAIT_V(6); PG8_BAR;
    }
    f32x4 epre = {0.f, 0.f, 0.f, 0.f};
    if constexpr (Epi::TAG == 7) epre = E.pre(cur, tid);
    for (;;) {
        if constexpr (Epi::TAG == 6) epre = E.pre(cur, tid);
        const bool has_next = S.next(ui + 1, nxt);
        const char* nA = has_next ? (const char*)g.A + (size_t)nxt.pm * tstepA + S.acol(nxt) : cA; const char* nB = has_next ? (const char*)g.Bt + (size_t)nxt.pn * tstepB + S.bcol(nxt) : cB;
#ifdef MK_KREP
        const int ntt = nt * Epi::KREP;
        for (int t0_ = 0; t0_ < ntt; t0_ += 2) {
            const bool last = (t0_ == ntt - 2); const int t = t0_ % nt, tw = (t + 2) % nt;
#else
        for (int t = 0; t < nt; t += 2) {
            const bool last = (t == nt - 2); const int tw = t + 2;
#endif
#if defined(MK_KREP) || defined(MK_NORELAX)
            const bool relax = false;
#else
            const bool relax = (t == 0) && (ui > 0);
#endif
            const char* a1 = cA + (size_t)(t + 1) * kstep;
            const char* a2 = last ? nA : cA + (size_t)tw * kstep; const char* b2 = last ? nB : cB + (size_t)tw * kstep;
            const char* a3 = a2 + kstep; const char* b3 = b2 + kstep;
            if (last && has_next) S.a_ready(nxt);
            if constexpr (SP2) {
            PG8_LDB(B0, 0, 0); PG8_LDB(B1, 0, 1); PG8_SCHED; PG8_LDA(At, 0, 0); PG8_STAGE(PG8_SA(1, 1), a1 + hstepA, voffA);
            if (relax) waitv<8 + NST>(); else PG8_WAIT_V(8);
            PG8_WAIT_L(0); PG8_BAR; PG8_MMA(0, 0, At, B0); PG8_MMA(0, 1, At, B1); PG8_BAR; PG8_SCHED;
            PG8_LDA(At, 0, 1); PG8_STAGE(PG8_SB(0, 0), b2, voffB); PG8_STAGE(PG8_SB(0, 1), b2 + hstepB, voffB); PG8_STAGE(PG8_SA(0, 0), a2, voffA);
            if (relax) waitv<8 + NST>(); else PG8_WAIT_V(8);
            PG8_WAIT_L(0); PG8_BAR; PG8_MMA(1, 0, At, B0); PG8_MMA(1, 1, At, B1); PG8_BAR; PG8_SCHED;
            PG8_LDB(B0, 1, 0); PG8_LDB(B1, 1, 1); PG8_SCHED; PG8_LDA(At, 1, 0); PG8_STAGE(PG8_SA(0, 1), a2 + hstepA, voffA);
            PG8_WAIT_V(8); PG8_WAIT_L(0); PG8_BAR; PG8_MMA(0, 0, At, B0); PG8_MMA(0, 1, At, B1); PG8_BAR; PG8_SCHED;
            PG8_LDA(At, 1, 1); PG8_STAGE(PG8_SB(1, 0), b3, voffB); PG8_STAGE(PG8_SB(1, 1), b3 + hstepB, voffB); PG8_STAGE(PG8_SA(1, 0), a3, voffA);
            PG8_WAIT_V(8); PG8_WAIT_L(0); PG8_BAR; PG8_MMA(1, 0, At, B0); PG8_MMA(1, 1, At, B1); PG8_BAR; PG8_SCHED;
            } else {
            PG8_LDB(B0, 0, 0); PG8_SCHED; PG8_LDA(At, 0, 0); PG8_STAGE(PG8_SA(1, 1), a1 + hstepA, voffA);
            PG8_WAIT_L(8); PG8_BAR; PG8_WAIT_L(0); PG8_MMA(0, 0, At, B0); PG8_BAR; PG8_SCHED;
            PG8_LDB(B1, 0, 1); PG8_STAGE(PG8_SB(0, 0), b2, voffB);
            PG8_BAR; PG8_WAIT_L(0); PG8_MMA(0, 1, At, B1); PG8_BAR;
            PG8_LDA(At, 0, 1); PG8_STAGE(PG8_SA(0, 0), a2, voffA);
            PG8_BAR; PG8_WAIT_L(0); PG8_MMA(1, 0, At, B0); PG8_BAR; PG8_SCHED;
            PG8_STAGE(PG8_SB(0, 1), b2 + hstepB, voffB);
            PG8_WAIT_V(6); PG8_BAR; PG8_MMA(1, 1, At, B1); PG8_BAR;
            PG8_LDB(B0, 1, 0); PG8_SCHED; PG8_LDA(At, 1, 0); PG8_STAGE(PG8_SA(0, 1), a2 + hstepA, voffA);
            PG8_WAIT_L(8); PG8_BAR; PG8_WAIT_L(0); PG8_MMA(0, 0, At, B0); PG8_BAR; PG8_SCHED;
            PG8_LDB(B1, 1, 1); PG8_STAGE(PG8_SB(1, 0), b3, voffB);
            PG8_BAR; PG8_WAIT_L(0); PG8_MMA(0, 1, At, B1); PG8_BAR;
            PG8_LDA(At, 1, 1); PG8_STAGE(PG8_SA(1, 0), a3, voffA);
            PG8_BAR; PG8_WAIT_L(0); PG8_MMA(1, 0, At, B0); PG8_BAR; PG8_SCHED;
            PG8_STAGE(PG8_SB(1, 1), b3 + hstepB, voffB);
            PG8_WAIT_V(6); PG8_BAR; PG8_MMA(1, 1, At, B1); PG8_BAR;
            }
        }
        if constexpr (ALIGN_EPI) { if (wr == 0) PG8_BAR; }
        #ifdef MK_KREP
        if constexpr (Epi::KREP > 1) {
#pragma unroll
            for (int a = 0; a < 2; ++a)
#pragma unroll
                for (int b = 0; b < 2; ++b)
#pragma unroll
                    for (int m = 0; m < 4; ++m)
#pragma unroll
                        for (int n = 0; n < 2; ++n) acc[a][b][m][n] *= (1.0f / Epi::KREP); }
#endif
        if constexpr (!Epi::AFTER_DRAIN) { int t2 = lane_now(); asm volatile("" : "+v"(t2));
            if constexpr (Epi::TAG == 6) E(acc, cur, wr, wc, t2 & 15, (t2 & 63) >> 4, epre); else E(acc, cur, wr, wc, t2 & 15, (t2 & 63) >> 4);
#ifdef MK_EPI2
            if constexpr (Epi::TAG == MK_EPI2 && Epi::TAG != 6) { asm volatile("" ::: "memory"); E(acc, cur, wr, wc, t2 & 15, (t2 & 63) >> 4); }
#endif
            S.done(cur); }
        if (!has_next) break;
#pragma unroll
        for (int a = 0; a < 2; ++a)
#pragma unroll
            for (int b = 0; b < 2; ++b)
#pragma unroll
                for (int m = 0; m < 4; ++m)
#pragma unroll
                    for (int n = 0; n < 2; ++n) acc[a][b][m][n] = (f32x4){0.f, 0.f, 0.f, 0.f};
        cur = nxt; cA = nA; cB = nB; ++ui;
        if constexpr (ALIGN_EPI) { if (wr == 1) PG8_BAR; }
    }
    PG8_WAIT_V(0);
    if constexpr (!ALIGN_EPI) { if (wr == 0) PG8_BAR; }
    PG8_BAR;
    if constexpr (Epi::AFTER_DRAIN) { if constexpr (Epi::TAG == 7) E.fused(acc, cur, wr, wc, fr, fq, lds, epre); else E.fused(acc, cur, wr, wc, fr, fq, lds, wid, lane); S.done(cur); }
#undef PG8_SA
#undef PG8_SB
#undef PG8_STAGE
#undef PG8_LDA
#undef PG8_LDB
#undef PG8_MMA
#undef PG8_WAIT_V
#undef PG8_WAIT_L
#undef PG8_BAR
#undef PG8_SCHED
}

__device__ __forceinline__ void gate_stage(PG8_LAS unsigned char* lds, const Gemm g, int pm, int pn, int wave0) {
    int tid_ = wave0 * 64 + lane_now(); asm volatile("" : "+v"(tid_));
    const int tid = tid_, wid = __builtin_amdgcn_readfirstlane(tid >> 6);
    const unsigned ldsw = (unsigned)wid * 1024u;
    const char* cA = (const char*)g.A + (size_t)pm * (2 * (size_t)HALF * g.lda * 2) + (size_t)(pn >> 1) * 256; const char* cB = (const char*)g.Bt + (size_t)pn * g.b_tstep;
    const size_t hstepA = (size_t)HALF * g.lda * 2, hstepB = g.b_hstep;
#pragma unroll
    for (int i = 0; i < 2; ++i) { int R, C; stage_rc(tid * 16 + i * 8192, R, C); const int Rb = (R & ~31) + perm32(R & 31);
        const unsigned voA = (unsigned)(R * g.lda + C) * 2u, voB = (unsigned)(Rb * g.ldb + C) * 2u;
#pragma unroll
        for (int b = 0; b < 2; ++b)
#pragma unroll
            for (int h = 0; h < 2; ++h) {
                __builtin_amdgcn_global_load_lds((const unsigned*)(cA + h * hstepA + b * (BK * 2) + voA), (PG8_LAS unsigned*)(lds + ((b * 2 + h) * HTB) + ldsw + i * 8192), 16, 0, 0);
                __builtin_amdgcn_global_load_lds((const unsigned*)(cB + h * hstepB + b * (BK * 2) + voB), (PG8_LAS unsigned*)(lds + ((4 + b * 2 + h) * HTB) + ldsw + i * 8192), 16, 0, 0); } }
}
__device__ __forceinline__ void gate_compute(const PG8_LAS unsigned char* lds, f32x4 (&acc)[2][2][4][2], int wr, int wc, int fr, int fq) {
    const int aoff = lds_byte(wr * 64 + fr, fq * 8), boff = lds_byte(wc * 32 + fr, fq * 8);
#pragma unroll
    for (int a = 0; a < 2; ++a)
#pragma unroll
        for (int b = 0; b < 2; ++b)
#pragma unroll
            for (int m = 0; m < 4; ++m)
#pragma unroll
                for (int n = 0; n < 2; ++n) acc[a][b][m][n] = (f32x4){0.f, 0.f, 0.f, 0.f};
#pragma unroll
    for (int kb = 0; kb < 2; ++kb) { bf16x8 B0[2][2], B1[2][2];
#pragma unroll
        for (int n = 0; n < 2; ++n)
#pragma unroll
            for (int k = 0; k < 2; ++k) { B0[n][k] = *(const PG8_LAS bf16x8*)(lds + (4 + kb * 2 + 0) * HTB + boff + n * 2048 + k * 1024); B1[n][k] = *(const PG8_LAS bf16x8*)(lds + (4 + kb * 2 + 1) * HTB + boff + n * 2048 + k * 1024); }
#pragma unroll
        for (int ai = 0; ai < 2; ++ai) { bf16x8 At[4][2];
#pragma unroll
            for (int m = 0; m < 4; ++m)
#pragma unroll
                for (int k = 0; k < 2; ++k) At[m][k] = *(const PG8_LAS bf16x8*)(lds + (kb * 2 + ai) * HTB + aoff + m * 2048 + k * 1024);
#pragma unroll
            for (int m = 0; m < 4; ++m)
#pragma unroll
                for (int n = 0; n < 2; ++n)
#pragma unroll
                    for (int k = 0; k < 2; ++k) { acc[ai][0][m][n] = __builtin_amdgcn_mfma_f32_16x16x32_bf16(B0[n][k], At[m][k], acc[ai][0][m][n], 0, 0, 0);
                                                  acc[ai][1][m][n] = __builtin_amdgcn_mfma_f32_16x16x32_bf16(B1[n][k], At[m][k], acc[ai][1][m][n], 0, 0, 0); } } }
}
}

#define GAS __attribute__((address_space(1)))
#define LAS __attribute__((address_space(3)))
typedef unsigned short bf16;
typedef unsigned v4u __attribute__((ext_vector_type(4)));
typedef float f32x4 __attribute__((ext_vector_type(4)));
typedef short bf16x8 __attribute__((ext_vector_type(8)));
typedef GAS unsigned gu32;
typedef GAS unsigned long long gu64;
#define RLX_AGENT __ATOMIC_RELAXED, __HIP_MEMORY_SCOPE_AGENT
#define LDS_WAIT() asm volatile("s_waitcnt lgkmcnt(0)" ::: "memory")
#define VM_WAIT() asm volatile("s_waitcnt vmcnt(0)" ::: "memory")
__device__ __forceinline__ unsigned long long rt() { return __builtin_amdgcn_s_memrealtime(); }
__device__ __forceinline__ unsigned f2bf(float f) { unsigned u = __builtin_bit_cast(unsigned, f); return (u + 0x7fffu + ((u >> 16) & 1u)) >> 16; }
__device__ __forceinline__ unsigned pk2(float lo, float hi) { unsigned r; asm("v_cvt_pk_bf16_f32 %0, %1, %2" : "=v"(r) : "v"(lo), "v"(hi)); return r; }

#define XB_TMO      128
#define XB_XCNT(j)  (256  + 64 * (j))
#define XB_XSUB(j)  (1280 + 64 * (j))
#define XB_XGEN(j)  (2304 + 64 * (j))
#define XB_TOP      3328
#define XB_TOPGEN   3392
#define XCD_BAR_WORDS 3456
#define XB_SPIN_CAP (1u << 18)

__device__ __forceinline__ unsigned xb_ld(unsigned* p)              { return __hip_atomic_load(p, __ATOMIC_RELAXED, __HIP_MEMORY_SCOPE_AGENT); }
__device__ __forceinline__ unsigned xb_add(unsigned* p, unsigned v) { return __hip_atomic_fetch_add(p, v, __ATOMIC_RELAXED, __HIP_MEMORY_SCOPE_AGENT); }
__device__ __forceinline__ unsigned xb_xcc_id() { return (unsigned)__builtin_amdgcn_s_getreg((3 << 11) | 20) & 0xFu; }
#define XB_SPIN(cond, bar) do { unsigned _sp = 0; while (cond) { __builtin_amdgcn_s_sleep(1); \
    if ((++_sp & 255u) == 0u) { if (xb_ld(&(bar)[XB_TMO])) break; if (_sp > XB_SPIN_CAP) { atomicAdd(&(bar)[XB_TMO], 1u); break; } } } } while (0)

struct XcdBarrier {
    unsigned* bar; unsigned x;
    volatile LAS unsigned* st;
};

__device__ __forceinline__ XcdBarrier xcd_barrier_post(unsigned* bar, volatile LAS unsigned* st, bool t0  ) {
    XcdBarrier b; b.bar = bar; b.x = xb_xcc_id(); b.st = st;
    if (t0) (void)xb_add(&bar[XB_XCNT(b.x)], 1u);
    return b;
}
__device__ __forceinline__ void xcd_barrier_complete(unsigned* bar, unsigned x, unsigned& nloc, unsigned& nx) {
    const unsigned G = gridDim.x * gridDim.y * gridDim.z;
    unsigned sum, cnt, mine, sp = 0u;
    for (;;) {
        sum = 0u; cnt = 0u; mine = 0u;
#pragma unroll
        for (unsigned j = 0; j < 16; ++j) { const unsigned c = xb_ld(&bar[XB_XCNT(j)]); sum += c; cnt += (c > 0u) ? 1u : 0u; mine = (j == x) ? c : mine; }
        if (sum == G) break;
        __builtin_amdgcn_s_sleep(1);
        if ((++sp & 255u) == 0u) { if (xb_ld(&bar[XB_TMO])) break; if (sp > XB_SPIN_CAP) { atomicAdd(&bar[XB_TMO], 1u); break; } }
    }
    nloc = mine > 0u ? mine : 1u; nx = cnt > 0u ? cnt : 1u;
}

__device__ __forceinline__ void xcd_barrier(const XcdBarrier& b, bool t0  ) {
    asm volatile("s_waitcnt vmcnt(0)" ::: "memory");
    __syncthreads();
    if (t0) {
        unsigned* bar = b.bar; asm volatile("" : "+s"(bar));
        __builtin_amdgcn_s_waitcnt(0);
        unsigned nloc = b.st[0], nx = b.st[1];
        if (nloc == 0u) { xcd_barrier_complete(bar, b.x, nloc, nx); b.st[0] = nloc; b.st[1] = nx; }
        const unsigned old = xb_add(&bar[XB_XSUB(b.x)], 1u);
        const unsigned gen = old / nloc;
        if (old + 1u == (gen + 1u) * nloc) {
            __builtin_amdgcn_fence(__ATOMIC_RELEASE, "agent");
            asm volatile("s_waitcnt vmcnt(0)" ::: "memory");
            const unsigned og = xb_add(&bar[XB_TOP], 1u);
            const unsigned tg = og / nx;
            if (og + 1u == (tg + 1u) * nx) xb_add(&bar[XB_TOPGEN], 1u);
            else XB_SPIN(xb_ld(&bar[XB_TOPGEN]) == tg, bar);
            __builtin_amdgcn_fence(__ATOMIC_ACQUIRE, "agent");
            xb_add(&bar[XB_XGEN(b.x)], 1u);
            asm volatile("s_waitcnt vmcnt(0)" ::: "memory");
        } else {
            XB_SPIN(xb_ld(&bar[XB_XGEN(b.x)]) == gen, bar);
            __builtin_amdgcn_fence(__ATOMIC_ACQUIRE, "agent");
            asm volatile("s_waitcnt vmcnt(0)" ::: "memory");
        }
    }
    __syncthreads();
}

namespace att {
using bf16x8 = __attribute__((ext_vector_type(8))) short;
using s16x4  = __attribute__((ext_vector_type(4))) short;
using f32x16 = __attribute__((ext_vector_type(16))) float;
using u32x4  = __attribute__((ext_vector_type(4))) unsigned;
using f32x4  = __attribute__((ext_vector_type(4))) float;
typedef unsigned short bf16;
constexpr int QBLK = 32, KVBLK = 64, NW = 8;
constexpr float SCALE = 0.07216878364870322f;
constexpr float THR = 8.f;
constexpr int LDQ = NQ, LDKN = D, LDKR = ROPE, LDV = D, LDO = D;
constexpr int SHM_V = KVBLK * 128 * 2, SHM_K = KVBLK * 128 * 2, SHM_R = KVBLK * 64 * 2;
constexpr int OFF_V = 0  , OFF_K = 3 * SHM_V  , OFF_R = OFF_K + 2 * SHM_K  , OFF_QR = OFF_R + 2 * SHM_R  , ATTN_LDS_BYTES = OFF_QR + NW * 4096;
#define KSWZ(row, colB) ((row) * 256 + ((colB) ^ (((row) & 7) << 4)))
#define RSWZ(row, colB) ((row) * 128 + ((colB) ^ ((((row) >> 1) & 7) << 4)))
#define SBAR() __builtin_amdgcn_sched_barrier(0)
__device__ __forceinline__ int crow(int r, int hi) { return (r & 3) + 8 * (r >> 2) + 4 * hi; }
__device__ __forceinline__ unsigned cvtpk(float lo, float hi) { unsigned r; asm("v_cvt_pk_bf16_f32 %0, %1, %2" : "=v"(r) : "v"(lo), "v"(hi)); return r; }
#define ATT_INTERLEAVE() do { _Pragma("unroll") for (int i_ = 0; i_ < 12; ++i_) { __builtin_amdgcn_sched_group_barrier(0x100, 3, 0); __builtin_amdgcn_sched_group_barrier(0x008, 2, 0); __builtin_amdgcn_sched_group_barrier(0x002, 12, 0); } } while (0)

__device__ __forceinline__ void partialSM(f32x16& p0, f32x16& p1, float& m_reg, float& mn, float& alpha) {
  constexpr float C = SCALE * 1.4426950408889634f;
  float pmax = p0[0];
#pragma unroll
  for (int r = 1; r < 16; ++r) pmax = fmaxf(pmax, p0[r]);
#pragma unroll
  for (int r = 0; r < 16; ++r) pmax = fmaxf(pmax, p1[r]);
  { auto rr = __builtin_amdgcn_permlane32_swap(__float_as_uint(pmax), __float_as_uint(pmax), false, false);
    pmax = fmaxf(__uint_as_float(rr[0]), __uint_as_float(rr[1])); }
  if (__builtin_expect(__all(pmax - m_reg <= THR / SCALE), 1)) { mn = m_reg; alpha = 1.f; }
  else { mn = fmaxf(m_reg, pmax); alpha = __builtin_amdgcn_exp2f((m_reg - mn) * C); m_reg = mn; }
  float mnC = -mn * C;
#pragma unroll
  for (int r = 0; r < 16; ++r) p0[r] = fmaf(p0[r], C, mnC);
#pragma unroll
  for (int r = 0; r < 16; ++r) p1[r] = fmaf(p1[r], C, mnC);
#pragma unroll
  for (int r = 0; r < 16; ++r) p0[r] = __builtin_amdgcn_exp2f(p0[r]);
}
__device__ __forceinline__ void finishSM(f32x16& p0, f32x16& p1, float alpha, float& l_reg, bf16x8& pa0, bf16x8& pa1, bf16x8& pa2, bf16x8& pa3) {
#pragma unroll
  for (int r = 0; r < 16; ++r) p1[r] = __builtin_amdgcn_exp2f(p1[r]);
  float ps = 0;
#pragma unroll
  for (int r = 0; r < 16; ++r) ps += p0[r];
#pragma unroll
  for (int r = 0; r < 16; ++r) ps += p1[r];
  { auto rr = __builtin_amdgcn_permlane32_swap(__float_as_uint(ps), __float_as_uint(ps), false, false);
    ps = __uint_as_float(rr[0]) + __uint_as_float(rr[1]); }
  l_reg = l_reg * alpha + ps;
#define PK4(P, BASE, OUT) do { unsigned a0 = cvtpk(P[BASE + 0], P[BASE + 1]), a1 = cvtpk(P[BASE + 2], P[BASE + 3]);   \
    unsigned b0 = cvtpk(P[BASE + 4], P[BASE + 5]), b1 = cvtpk(P[BASE + 6], P[BASE + 7]);                              \
    auto r0 = __builtin_amdgcn_permlane32_swap(a0, b0, false, false); auto r1 = __builtin_amdgcn_permlane32_swap(a1, b1, false, false); \
    u32x4 w = {r0[0], r1[0], r0[1], r1[1]}; OUT = *reinterpret_cast<bf16x8*>(&w); } while (0)
  PK4(p0, 0, pa0); PK4(p0, 8, pa1); PK4(p1, 0, pa2); PK4(p1, 8, pa3);
#undef PK4
}
__device__ __forceinline__ void qkt(f32x16& p0, f32x16& p1, const char* Ks, const char* Rs, const char* Qs, const char* Q7s  , const bf16x8* qr, int r32, int hi) {
  p0 = f32x16{}; p1 = f32x16{};
  bf16x8 b0 = *reinterpret_cast<const bf16x8*>(Ks + KSWZ(r32, (hi * 8) * 2)), b1 = *reinterpret_cast<const bf16x8*>(Ks + KSWZ(32 + r32, (hi * 8) * 2)), qf = qr[0];
#pragma unroll
  for (int d0 = 0; d0 < 12; ++d0) {
    bf16x8 n0 = b0, n1 = b1, nq = qf;
    if (d0 + 1 < 8) { const int cb = ((d0 + 1) * 16 + hi * 8) * 2; n0 = *reinterpret_cast<const bf16x8*>(Ks + KSWZ(r32, cb)); n1 = *reinterpret_cast<const bf16x8*>(Ks + KSWZ(32 + r32, cb)); if (d0 + 1 < 7) nq = qr[d0 + 1]; else nq = *reinterpret_cast<const bf16x8*>(Q7s); }
    else if (d0 + 1 < 12) { const int cb = ((d0 + 1 - 8) * 16 + hi * 8) * 2; n0 = *reinterpret_cast<const bf16x8*>(Rs + RSWZ(r32, cb)); n1 = *reinterpret_cast<const bf16x8*>(Rs + RSWZ(32 + r32, cb)); nq = *reinterpret_cast<const bf16x8*>(Qs + RSWZ(r32, cb)); }
    p0 = __builtin_amdgcn_mfma_f32_32x32x16_bf16(b0, qf, p0, 0, 0, 0);
    p1 = __builtin_amdgcn_mfma_f32_32x32x16_bf16(b1, qf, p1, 0, 0, 0);
    b0 = n0; b1 = n1; qf = nq; }
}
__device__ __forceinline__ int v_st(int k, int c) { const int kk = (k & ~0xC) | ((k & 4) << 1) | ((k & 8) >> 1); return ((kk >> 3) * 4 + (c >> 5)) * 512 + ((kk & 7) * 32 + (c & 31)) * 2; }
__device__ __forceinline__ int v_rd_base(int lane) { return ((lane & 3) << 3) | (((lane >> 2) & 3) << 6) | (((lane >> 4) & 1) << 5) | (((lane >> 5) & 1) << 8); }
constexpr int v_rd_off(int d0, int ks, int half) { return d0 * 512 + ks * 4096 + half * 2048; }
template <int OFF> __device__ __forceinline__ s16x4 tr_read(int vb) {
  s16x4 r; asm volatile("ds_read_b64_tr_b16 %0, %1 offset:%2" : "=&v"(r) : "v"(vb), "i"(OFF) : "memory"); return r;
}
template <int D0> __device__ __forceinline__ void pv_one(f32x16& od, int vb, bf16x8 pa0, bf16x8 pa1, bf16x8 pa2, bf16x8 pa3) {
  const s16x4 l0 = tr_read<v_rd_off(D0, 0, 0)>(vb), h0 = tr_read<v_rd_off(D0, 0, 1)>(vb), l1 = tr_read<v_rd_off(D0, 1, 0)>(vb), h1 = tr_read<v_rd_off(D0, 1, 1)>(vb);
  const s16x4 l2 = tr_read<v_rd_off(D0, 2, 0)>(vb), h2 = tr_read<v_rd_off(D0, 2, 1)>(vb), l3 = tr_read<v_rd_off(D0, 3, 0)>(vb), h3 = tr_read<v_rd_off(D0, 3, 1)>(vb);
  asm volatile("s_waitcnt lgkmcnt(0)" ::: "memory"); SBAR();
#define PK(L, H) (bf16x8){L[0], L[1], L[2], L[3], H[0], H[1], H[2], H[3]}
  od = __builtin_amdgcn_mfma_f32_32x32x16_bf16(pa0, PK(l0, h0), od, 0, 0, 0);
  od = __builtin_amdgcn_mfma_f32_32x32x16_bf16(pa1, PK(l1, h1), od, 0, 0, 0);
  od = __builtin_amdgcn_mfma_f32_32x32x16_bf16(pa2, PK(l2, h2), od, 0, 0, 0);
  od = __builtin_amdgcn_mfma_f32_32x32x16_bf16(pa3, PK(l3, h3), od, 0, 0, 0);
#undef PK
}
__device__ __forceinline__ void pv_d0(f32x16* o, int vb, bf16x8 pa0, bf16x8 pa1, bf16x8 pa2, bf16x8 pa3) {
  pv_one<0>(o[0], vb, pa0, pa1, pa2, pa3); pv_one<1>(o[1], vb, pa0, pa1, pa2, pa3); pv_one<2>(o[2], vb, pa0, pa1, pa2, pa3); pv_one<3>(o[3], vb, pa0, pa1, pa2, pa3);
}

__device__ __forceinline__ void attn_unit(const bf16* __restrict__ Qb, const bf16* __restrict__ Kn, const bf16* __restrict__ Kr, const bf16* __restrict__ Vh,
                                          bf16* __restrict__ Ob, int seq, char* lds, char* wsl, int wave0) {
  int tid_ = wave0 * 64 + lane_now(); asm volatile("" : "+v"(tid_));
  const int tid = tid_, wid = __builtin_amdgcn_readfirstlane(tid >> 6), lane = tid & 63, r32 = lane & 31, hi = lane >> 5;
  float* ws = (float*)wsl + wid * 64; float* li_l = ws; float* al_l = ws + 32;
  float m_reg = -1e30f, l_reg = 0; f32x16 o[4] = {}; bf16x8 qr[7];
  typedef __attribute__((address_space(3))) unsigned lds_u32;
#define DMA_TILE(t, vs, ks) do { const bf16* gk_ = Kn + (size_t)(t) * KVBLK * LDKN; const bf16* gv_ = Vh + (size_t)(t) * KVBLK * LDV; const bf16* gr_ = Kr + (size_t)(t) * KVBLK * LDKR; \
    int ln_ = lane; asm volatile("" : "+v"(ln_)); \
    _Pragma("unroll") for (int i_ = 0; i_ < 2; ++i_) { const int L16 = wid * 128 + i_ * 64 + ln_; \
      const int rowk_ = L16 >> 4, ck_ = (L16 & 15) ^ (rowk_ & 7); \
      const int sub_ = L16 >> 5, wi_ = L16 & 31, kk_ = ((sub_ >> 2) << 3) | (wi_ >> 2), cv_ = ((sub_ & 3) << 5) + ((wi_ & 3) << 3), kv_ = (kk_ & ~0xC) | ((kk_ & 4) << 1) | ((kk_ & 8) >> 1); \
      __builtin_amdgcn_global_load_lds((const unsigned*)(gv_ + (unsigned)(kv_ * LDV + cv_)), (lds_u32*)(lds + OFF_V + (vs) + (wid * 128 + i_ * 64) * 16), 16, 0, 0); \
      __builtin_amdgcn_global_load_lds((const unsigned*)(gk_ + (unsigned)(rowk_ * LDKN + ck_ * 8)), (lds_u32*)(lds + OFF_K + (ks) * SHM_K + (wid * 128 + i_ * 64) * 16), 16, 0, 0); } \
    { const int L16 = wid * 64 + ln_, rowr_ = L16 >> 3, cr_ = (L16 & 7) ^ ((rowr_ >> 1) & 7); \
      __builtin_amdgcn_global_load_lds((const unsigned*)(gr_ + (unsigned)(rowr_ * LDKR + cr_ * 8)), (lds_u32*)(lds + OFF_R + (ks) * SHM_R + (wid * 64) * 16), 16, 0, 0); } } while (0)
#define TILE_SYNC() do { asm volatile("s_waitcnt vmcnt(0)" ::: "memory"); __syncthreads(); } while (0)
#define RESC(a) do { if (__any((a) < 1.f)) { if (hi == 0) al_l[r32] = (a); asm volatile("s_waitcnt lgkmcnt(0)" ::: "memory"); \
    _Pragma("unroll") for (int d = 0; d < 4; ++d) _Pragma("unroll") for (int r = 0; r < 16; ++r) o[d][r] *= al_l[crow(r, hi)]; } } while (0)
  const int NT = seq / KVBLK;
  int s0 = 0, s1 = SHM_V, s2 = 2 * SHM_V;
  DMA_TILE(0, s0, 0); DMA_TILE(1, s1, 1);
  const bf16* Qw = Qb + (long)(wid * QBLK + r32) * LDQ + hi * 8;
#pragma unroll
  for (int d0 = 0; d0 < 7; ++d0) qr[d0] = *reinterpret_cast<const bf16x8*>(Qw + d0 * 16);
  char* Q7s = wsl + 2048 + wid * 1024 + r32 * 32 + hi * 16;
  *reinterpret_cast<bf16x8*>(Q7s) = *reinterpret_cast<const bf16x8*>(Qw + 7 * 16);
  char* Qs = lds + OFF_QR + wid * 4096;
  { bf16x8 qx[4];
#pragma unroll
    for (int d0 = 0; d0 < 4; ++d0) qx[d0] = *reinterpret_cast<const bf16x8*>(Qw + (8 + d0) * 16);
#pragma unroll
    for (int d0 = 0; d0 < 4; ++d0) *reinterpret_cast<bf16x8*>(Qs + RSWZ(r32, (d0 * 16 + hi * 8) * 2)) = qx[d0]; }
  const int vb0 = (int)(uintptr_t)lds + OFF_V + v_rd_base(lane);
  TILE_SYNC();
  f32x16 pA0, pA1, pB0, pB1; float mnA, mnB, alA, alB; bf16x8 pa0, pa1, pa2, pa3;
  qkt(pA0, pA1, lds + OFF_K, lds + OFF_R, Qs, Q7s, qr, r32, hi); partialSM(pA0, pA1, m_reg, mnA, alA);
  for (int j = 0; j < NT; j += 2) {
    if (j + 2 < NT) DMA_TILE(j + 2, s2, 0);
    SBAR(); qkt(pB0, pB1, lds + OFF_K + SHM_K, lds + OFF_R + SHM_R, Qs, Q7s, qr, r32, hi);
#ifdef MK_AQ2
    asm volatile("" : "+v"(pB0), "+v"(pB1)); qkt(pB0, pB1, lds + OFF_K + SHM_K, lds + OFF_R + SHM_R, Qs, Q7s, qr, r32, hi);
#endif
    finishSM(pA0, pA1, alA, l_reg, pa0, pa1, pa2, pa3); SBAR();
    pv_d0(o, vb0 + s0, pa0, pa1, pa2, pa3);
#ifdef MK_APV2
    { bf16x8 z_ = {0, 0, 0, 0, 0, 0, 0, 0}; asm volatile("" : "+v"(z_)); pv_d0(o, vb0 + s0, z_, z_, z_, z_); }
#endif
    partialSM(pB0, pB1, m_reg, mnB, alB);
    TILE_SYNC(); RESC(alB);
    const bool more = j + 2 < NT;
    if (j + 3 < NT) DMA_TILE(j + 3, s0, 1);
    SBAR(); if (more) qkt(pA0, pA1, lds + OFF_K, lds + OFF_R, Qs, Q7s, qr, r32, hi);
#ifdef MK_AQ2
    asm volatile("" : "+v"(pA0), "+v"(pA1)); if (more) qkt(pA0, pA1, lds + OFF_K, lds + OFF_R, Qs, Q7s, qr, r32, hi);
#endif
    finishSM(pB0, pB1, alB, l_reg, pa0, pa1, pa2, pa3); SBAR();
    pv_d0(o, vb0 + s1, pa0, pa1, pa2, pa3);
#ifdef MK_APV2
    { bf16x8 z_ = {0, 0, 0, 0, 0, 0, 0, 0}; asm volatile("" : "+v"(z_)); pv_d0(o, vb0 + s1, z_, z_, z_, z_); }
#endif
    if (more) partialSM(pA0, pA1, m_reg, mnA, alA);
    TILE_SYNC(); if (more) RESC(alA);
    const int t_ = s0; s0 = s2; s2 = s1; s1 = t_;
  }
  { const int le = lane_now(), r32e = le & 31, hie = le >> 5; float* li_e = (float*)wsl + wid * 64;
    if (hie == 0) li_e[r32e] = l_reg; asm volatile("s_waitcnt lgkmcnt(0)" ::: "memory");
    float rli[16];
#pragma unroll
    for (int r = 0; r < 16; ++r) rli[r] = __builtin_amdgcn_rcpf(li_e[crow(r, hie)]);
    float* os = (float*)(lds + wid * 16384);
#pragma unroll
    for (int r = 0; r < 16; ++r) { const int orow = crow(r, hie);
#pragma unroll
      for (int d0 = 0; d0 < 4; ++d0) os[orow * 128 + d0 * 32 + r32e] = o[d0][r] * rli[r]; }
    asm volatile("s_waitcnt lgkmcnt(0)" ::: "memory");
    bf16* Ow = Ob + (long)(wid * QBLK) * LDO;
#pragma unroll
    for (int i = 0; i < 8; ++i) { const int ch = i * 64 + le, row = ch >> 4, c8 = (ch & 15) * 8;
      const f32x4* sp = (const f32x4*)(os + row * 128 + c8); const f32x4 a = sp[0], b = sp[1];
      u32x4 w = {cvtpk(a[0], a[1]), cvtpk(a[2], a[3]), cvtpk(b[0], b[1]), cvtpk(b[2], b[3])};
      *reinterpret_cast<u32x4*>(Ow + (long)row * LDO + c8) = w; } }
#undef DMA_TILE
#undef TILE_SYNC
#undef RESC
}
}

constexpr size_t MiB = 1u << 20;
constexpr size_t WS_CTL = 0, CTL_ZERO_BYTES = 64 * 1024;
constexpr size_t WS_MODS = 1 * MiB;
constexpr size_t WS_COS = 3 * MiB, WS_SIN = WS_COS + 128 * 1024, WS_SP = WS_SIN + 128 * 1024;
constexpr size_t WS_WIN = 4 * MiB, WS_WUQ = 14 * MiB, WS_WUKV = 20 * MiB, WS_WO = 28 * MiB, WS_WRIN = 44 * MiB, WS_WG = 76 * MiB, WS_WROUT = 80 * MiB, WS_WUP = 96 * MiB, WS_WDN = 272 * MiB;
constexpr size_t WS_X = 362 * MiB, WS_H = 490 * MiB, WS_S = 554 * MiB, WS_END = 1194 * MiB;
constexpr size_t WS_U = WS_S, WS_HALO = WS_S, WS_ACT = WS_S + 352 * MiB;
constexpr size_t WS_PROJ = WS_S, WS_CQ = WS_S + 80 * MiB, WS_CKV = WS_S + 96 * MiB, WS_KR = WS_S + 114 * MiB, WS_Q = WS_S + 117 * MiB, WS_KN = WS_S + 213 * MiB, WS_V = WS_S + 285 * MiB, WS_O = WS_S + 357 * MiB, WS_PKR = WS_S + 421 * MiB;
constexpr size_t WS_RIN = WS_S, WS_XC = WS_S + 128 * MiB, WS_LA = WS_S + 192 * MiB, WS_UU = WS_S + 320 * MiB, WS_HB = WS_S + 448 * MiB, WS_MIX = WS_S + 576 * MiB;
static_assert(WS_WIN + 2ull * NINP * D * 2 <= WS_WUQ && WS_WUQ + 2ull * NQ * QL * 2 <= WS_WUKV && WS_WUKV + 2ull * NKV * KVL * 2 <= WS_WO && WS_WO + 2ull * D * D * 2 <= WS_WRIN, "ws map 1");
static_assert(WS_WRIN + 2ull * 2 * D * D * 2 <= WS_WG && WS_WG + 2ull * 8192 * 128 * 2 <= WS_WROUT && WS_WROUT + 2ull * D * D * 2 <= WS_WUP && WS_WUP + 4ull * NUP * D * 2 <= WS_WDN && WS_WDN + 4ull * D * ALD * 2 <= WS_X, "ws map 2");
static_assert(WS_X + (size_t)NTOK * D * 2 <= WS_H && WS_H + (size_t)NTOK * D * 2 <= WS_S, "ws map 3");
static_assert(WS_U + (size_t)NTOK * NUP * 2 <= WS_ACT && WS_ACT + (size_t)NTOK * ALD * 2 <= WS_END, "ws map ffn");
static_assert(WS_PROJ + (size_t)NTOK * NINP * 4 <= WS_CQ && WS_CQ + (size_t)NTOK * QL * 2 <= WS_CKV && WS_CKV + (size_t)MKV * KVL * 2 <= WS_KR && WS_KR + (size_t)MKV * ROPE * 2 <= WS_Q && WS_Q + (size_t)NTOK * NQ * 2 <= WS_KN
              && WS_KN + (size_t)MKV * D * 2 <= WS_V && WS_V + (size_t)MKV * D * 2 <= WS_O && WS_O + (size_t)NTOK * D * 2 <= WS_END, "ws map attn");
static_assert(WS_RIN + (size_t)NTOK * 2 * D * 2 <= WS_XC && WS_XC + (size_t)NTOK * D * 2 <= WS_LA && WS_LA + 2ull * NTOK * D * 2 <= WS_UU && WS_UU + 2ull * NTOK * D * 2 <= WS_HB && WS_HB + (size_t)NTOK * D * 4 <= WS_MIX && WS_MIX + (size_t)NTOK * D * 2 <= WS_END, "ws map rec");
constexpr int CW_BAR = 1024;
constexpr size_t OUT_Y = 0, OUT_CKV = 2ull * MCTX * D, OUT_KR = OUT_CKV + 32ull * 2 * 256 * KVL, OUT_ST = OUT_KR + 32ull * 2 * 256 * ROPE, OUT_TOTAL = OUT_ST + 32ull * 2 * 2 * D;

constexpr int NWAVES = 8;
constexpr int RING_OFF = 0, RING_BYTES = 131072;
constexpr int LDSCTL_OFF = RING_BYTES, MISC_OFF = LDSCTL_OFF + 320;
constexpr int EDGE_OFF = LDSCTL_OFF + 2048;
constexpr int LDS_BYTES = 147456;
static_assert(MISC_OFF + 128 <= LDS_BYTES && att::ATTN_LDS_BYTES <= RING_BYTES, "LDS map");

struct Args { const float* in[32]; float* out; unsigned char* ws; int ph_lo, ph_hi; };
static_assert(sizeof(Args) == 34 * 8 + 8, "Args has no padding");
struct Frame {
    LAS unsigned char* lds;
    volatile LAS unsigned* MISC;
    int tid, lane, wave;
    int vcu, G;
    float* out;
    unsigned char* ws;
};
__device__ __forceinline__ float shfl_xor_l(float v, int mask, int lane) { return __int_as_float(__builtin_amdgcn_ds_bpermute((lane ^ mask) << 2, __float_as_int(v))); }
__device__ __forceinline__ float wave_sum(float v, int lane) {
#pragma unroll
    for (int o = 1; o < 64; o <<= 1) v += shfl_xor_l(v, o, lane);
    return v;
}
__device__ __forceinline__ int mod_of_row(int m) { return m < MCTX ? 0 : 1 + ((m - MCTX) >> 10); }
__device__ __forceinline__ int kv_row(int m) { return m < MCTX ? m : MCTX + ((m - MCTX) >> 10) * 1280 + 256 + ((m - MCTX) & 1023); }

__device__ __forceinline__ void p0_transpose_item(const float* W, int K, int N, bf16* WT, int row_off, LAS float* scr, int item, int lane, int ldw = 0) {
    if (ldw == 0) ldw = K;
    const int nblk = N / 32; int kb = item / nblk, nb = item % nblk;
#ifndef MK_TRMAP
#define MK_TRMAP 1
#endif
    if (MK_TRMAP == 1 && ((K / 64) & 3) == 0) {
        const int g = item >> 3, w = item & 7, gn = nblk >> 1, kg = g / gn, ng = g - kg * gn; kb = 4 * kg + (w >> 1); nb = 2 * ng + (w & 1); }
    if (MK_TRMAP == 2 && ((K / 64) & 7) == 0) {
        const int g = item >> 3, w = item & 7, kg = g / nblk, ng = g - kg * nblk; kb = 8 * kg + w; nb = ng; }
    const int k0 = 64 * kb, n0 = 32 * nb;
    float wv[32];
#pragma unroll
    for (int i = 0; i < 32; ++i) wv[i] = *(const GAS float*)(W + (size_t)(k0 + 2 * i + (lane >> 5)) * N + n0 + (lane & 31));
#pragma unroll
    for (int i = 0; i < 32; ++i) scr[(2 * i + (lane >> 5)) * 33 + (lane & 31)] = wv[i];
    LDS_WAIT(); asm volatile("" ::: "memory");
    const int c = lane & 7;
#pragma unroll
    for (int j = 0; j < 4; ++j) { const int n = (lane >> 3) + 8 * j; const LAS float* s = scr + (8 * c) * 33 + n;
        v4u o; o.x = pk2(s[0 * 33], s[1 * 33]); o.y = pk2(s[2 * 33], s[3 * 33]); o.z = pk2(s[4 * 33], s[5 * 33]); o.w = pk2(s[6 * 33], s[7 * 33]);
        *(GAS v4u*)(WT + (size_t)(row_off + n0 + n) * ldw + k0 + 8 * c) = o; }
    LDS_WAIT(); asm volatile("" ::: "memory");
}

__device__ __forceinline__ void ada_task(Frame& F, const Args& A, int task) {
    constexpr int CW = 192;
    const int layer = task >> 6, cchunk = task & 63, al = F.lane < 48 ? F.lane : 47;
    LAS float* S = (LAS float*)(F.lds + RING_OFF);
    const float* c_ctx = A.in[6]; const float* cc = A.in[5];
    { f32x4 cv[NMOD];
#pragma unroll
        for (int q = 0; q < NMOD; ++q) cv[q] = *(const GAS f32x4*)((q == 0 ? c_ctx : cc + (q - 1) * D) + 4 * F.tid);
#pragma unroll
        for (int q = 0; q < NMOD; ++q)
#pragma unroll
            for (int i = 0; i < 4; ++i) { const float v = cv[q][i]; S[(4 * F.tid + i) * 12 + q] = v / (1.0f + __expf(-v)); } }
    __syncthreads();
    f32x4 acc[NMOD];
#pragma unroll
    for (int q = 0; q < NMOD; ++q) acc[q] = (f32x4){0.f, 0.f, 0.f, 0.f};
    const int k0 = F.wave * 256;
    const float* wp = A.in[10] + ((size_t)layer * D + k0) * ADA_N + cchunk * CW + al * 4;
    for (int kk = 0; kk < 256; kk += 8) {
        f32x4 w[8];
#pragma unroll
        for (int i = 0; i < 8; ++i) w[i] = *(const GAS f32x4*)(wp + (size_t)(kk + i) * ADA_N);
#pragma unroll
        for (int i = 0; i < 8; ++i) { const LAS f32x4* sp = (const LAS f32x4*)(S + (k0 + kk + i) * 12); const f32x4 s0 = sp[0], s1 = sp[1], s2 = sp[2];
            acc[0] += s0.x * w[i]; acc[1] += s0.y * w[i]; acc[2] += s0.z * w[i]; acc[3] += s0.w * w[i];
            acc[4] += s1.x * w[i]; acc[5] += s1.y * w[i]; acc[6] += s1.z * w[i]; acc[7] += s1.w * w[i]; acc[8] += s2.x * w[i]; }
    }
    __syncthreads();
    LAS float* R = (LAS float*)(F.lds + RING_OFF);
    if (F.lane < 48) {
#pragma unroll
        for (int q = 0; q < NMOD; ++q) *(LAS f32x4*)(R + (F.wave * NMOD + q) * CW + F.lane * 4) = acc[q]; }
    __syncthreads();
    float* mods = (float*)(F.ws + WS_MODS); const float* b_ada = A.in[11];
    for (int idx = F.tid; idx < NMOD * CW; idx += NWAVES * 64) { const int q = idx / CW, cl = idx % CW; float s = b_ada[layer * ADA_N + cchunk * CW + cl];
#pragma unroll
        for (int w = 0; w < NWAVES; ++w) s += R[(w * NMOD + q) * CW + cl];
        mods[(size_t)(layer * NMOD + q) * ADA_N + cchunk * CW + cl] = s; }
    __syncthreads();
}
__device__ __forceinline__ void p0_prologue(Frame& F, const Args& A) {
#ifndef MK_P0A
#define MK_P0A 1
#endif
#ifndef MK_P0T
#define MK_P0T 1
#endif
    for (int ra = 0; ra < MK_P0A; ++ra) if (F.vcu < 256) ada_task(F, A, F.vcu);
    LAS float* scr = (LAS float*)(F.lds + RING_OFF + F.wave * 16384);
    const int gw = F.vcu * NWAVES + F.wave, NGW = F.G * NWAVES;
    bf16* ws16 = (bf16*)F.ws;
    constexpr int I_IN = (D / 64) * (NIN / 32), I_UQ = (QL / 64) * (NQ / 32), I_UK = (KVL / 64) * (D / 32), I_O = (D / 64) * (D / 32), I_RIN = (D / 64) * (2 * D / 32), I_G = 2 * 16 * 8, I_UP = (D / 64) * (NUP / 32), I_DN = (DFF / 64) * (D / 32);
    constexpr int PER_J = I_IN + I_UQ + 2 * I_UK + I_O + I_RIN + I_O + 2 * I_G;
    constexpr int NITEMS = 2 * PER_J + 4 * (I_UP + I_DN);
    for (int rt = 0; rt < MK_P0T; ++rt)
    for (int it = gw; it < NITEMS; it += NGW) {
        int r = it;
        if (r < 2 * PER_J) {
            const int j = r / PER_J; r -= j * PER_J;
            if (r < I_IN) { p0_transpose_item(A.in[12] + (size_t)j * D * NIN, D, NIN, (bf16*)(F.ws + WS_WIN) + (size_t)j * NINP * D, 0, scr, r, F.lane); continue; } r -= I_IN;
            if (r < I_UQ) { p0_transpose_item(A.in[15] + (size_t)j * QL * NQ, QL, NQ, (bf16*)(F.ws + WS_WUQ) + (size_t)j * NQ * QL, 0, scr, r, F.lane); continue; } r -= I_UQ;
            if (r < I_UK) { p0_transpose_item(A.in[16] + (size_t)j * KVL * D, KVL, D, (bf16*)(F.ws + WS_WUKV) + (size_t)j * NKV * KVL, 0, scr, r, F.lane); continue; } r -= I_UK;
            if (r < I_UK) { p0_transpose_item(A.in[17] + (size_t)j * KVL * D, KVL, D, (bf16*)(F.ws + WS_WUKV) + (size_t)j * NKV * KVL, D, scr, r, F.lane); continue; } r -= I_UK;
            if (r < I_O) { p0_transpose_item(A.in[18] + (size_t)j * D * D, D, D, (bf16*)(F.ws + WS_WO) + (size_t)j * D * D, 0, scr, r, F.lane); continue; } r -= I_O;
            if (r < I_RIN) { p0_transpose_item(A.in[19] + (size_t)j * D * 2 * D, D, 2 * D, (bf16*)(F.ws + WS_WRIN) + (size_t)j * 2 * D * D, 0, scr, r, F.lane); continue; } r -= I_RIN;
            if (r < I_O) { p0_transpose_item(A.in[27] + (size_t)j * D * D, D, D, (bf16*)(F.ws + WS_WROUT) + (size_t)j * D * D, 0, scr, r, F.lane); continue; } r -= I_O;
            { const int gate = r / I_G; r -= gate * I_G; const int mat = r >> 3, sub = r & 7, dir = mat >> 4, blk = mat & 15;
              p0_transpose_item(A.in[gate ? 24 : 22] + ((size_t)j * 32 + mat) * 128 * 128, 128, 128, (bf16*)(F.ws + WS_WG) + (size_t)j * 8192 * 128, blk * 512 + dir * 256 + gate * 128, scr, sub, F.lane); continue; }
        }
        r -= 2 * PER_J;
        { const int l = r / (I_UP + I_DN); r -= l * (I_UP + I_DN);
          if (r < I_UP) { p0_transpose_item(A.in[28] + (size_t)l * D * NUP, D, NUP, (bf16*)(F.ws + WS_WUP) + (size_t)l * NUP * D, 0, scr, r, F.lane); continue; } r -= I_UP;
          p0_transpose_item(A.in[31] + (size_t)l * DFF * D, DFF, D, (bf16*)(F.ws + WS_WDN) + (size_t)l * D * ALD, 0, scr, r, F.lane, ALD); }
    }
    (void)ws16;
    const int gt = F.vcu * NWAVES * 64 + F.tid, NGT = F.G * NWAVES * 64;
    for (int i = gt; i < 2 * (NINP - NIN) * D / 8; i += NGT) { const int j = i / ((NINP - NIN) * D / 8), o = i % ((NINP - NIN) * D / 8);
        *(GAS v4u*)((bf16*)(F.ws + WS_WIN) + ((size_t)j * NINP + NIN) * D + (size_t)o * 8) = (v4u){0u, 0u, 0u, 0u}; }
    for (int i = gt; i < 1024 * 32; i += NGT) { const int pos = i >> 5, a = i & 31; const float inv = exp2f(-(float)(2 * (a & 15)) * (13.287712379549449f / 32.0f));
        const float ang = (float)((a < 16) ? (pos >> 6) : (pos & 63)) * inv; float sn, cs; sincosf(ang, &sn, &cs);
        ((float*)(F.ws + WS_COS))[i] = cs; ((float*)(F.ws + WS_SIN))[i] = sn; }
    for (int i = gt; i < 2 * 2 * D; i += NGT) { const float lam = A.in[26][i]; ((float*)(F.ws + WS_SP))[i] = 8.0f * 1.4426950408889634f * log1pf(expf(-lam)); }
}

template <int MODE>
__device__ __forceinline__ void norm_phase(Frame& F, const Args& A, const float* g, const float* modbase  , int shift_idx  ) {
    const int gw = F.vcu * NWAVES + F.wave, NGW = F.G * NWAVES;
    bf16* X = (bf16*)(F.ws + WS_X); bf16* H = (bf16*)(F.ws + WS_H);
    for (int blk = gw; blk < NTOK / 8; blk += NGW) {
        const int m0 = blk * 8;
        f32x4 gs[4][2], sh[4][2];
        if (MODE == 2) {
#pragma unroll
            for (int j = 0; j < 4; ++j)
#pragma unroll
                for (int h = 0; h < 2; ++h) gs[j][h] = *(const GAS f32x4*)(g + 8 * (F.lane + 64 * j) + 4 * h);
        } else { const float* mb = modbase + (size_t)mod_of_row(m0) * ADA_N + (size_t)shift_idx * D;
#pragma unroll
            for (int j = 0; j < 4; ++j)
#pragma unroll
                for (int h = 0; h < 2; ++h) { const int c = 8 * (F.lane + 64 * j) + 4 * h; gs[j][h] = *(const GAS f32x4*)(g + c) * (*(const GAS f32x4*)(mb + D + c) + 1.0f); sh[j][h] = *(const GAS f32x4*)(mb + c); } }
        f32x4 nx[4][2]; v4u nb[4];
#define NORM_LOAD(m) do { if (MODE == 0) { const float* src_ = (m) < MCTX ? A.in[0] + (size_t)(m) * D : A.in[1] + (size_t)((m) - MCTX) * D; \
            _Pragma("unroll") for (int j = 0; j < 4; ++j) { const GAS f32x4* p = (const GAS f32x4*)(src_ + 8 * (F.lane + 64 * j)); nx[j][0] = p[0]; nx[j][1] = p[1]; } } \
        else { _Pragma("unroll") for (int j = 0; j < 4; ++j) nb[j] = *(const GAS v4u*)(X + (size_t)(m) * D + 8 * (F.lane + 64 * j)); } } while (0)
        NORM_LOAD(m0);
#pragma unroll 1
        for (int r = 0; r < 8; ++r) { const int m = m0 + r;
            f32x4 v[4][2];
            if (MODE == 0) {
#pragma unroll
                for (int j = 0; j < 4; ++j) { v[j][0] = nx[j][0]; v[j][1] = nx[j][1]; }
            } else {
#pragma unroll
                for (int j = 0; j < 4; ++j) { const v4u w = nb[j];
                    v[j][0] = (f32x4){pg8::bf_lo(w.x), pg8::bf_hi(w.x), pg8::bf_lo(w.y), pg8::bf_hi(w.y)}; v[j][1] = (f32x4){pg8::bf_lo(w.z), pg8::bf_hi(w.z), pg8::bf_lo(w.w), pg8::bf_hi(w.w)}; } }
            if (r < 7) NORM_LOAD(m + 1);
            if (MODE == 0) {
#pragma unroll
                for (int j = 0; j < 4; ++j) *(GAS v4u*)(X + (size_t)m * D + 8 * (F.lane + 64 * j)) = (v4u){pk2(v[j][0].x, v[j][0].y), pk2(v[j][0].z, v[j][0].w), pk2(v[j][1].x, v[j][1].y), pk2(v[j][1].z, v[j][1].w)}; }
            float s = 0.f;
#pragma unroll
            for (int j = 0; j < 4; ++j)
#pragma unroll
                for (int h = 0; h < 2; ++h) s += (v[j][h].x * v[j][h].x + v[j][h].y * v[j][h].y) + (v[j][h].z * v[j][h].z + v[j][h].w * v[j][h].w);
            const float rstd = 1.0f / sqrtf(wave_sum(s, F.lane) * (1.0f / D) + NORM_EPS);
            if (MODE == 2) { float* yo = F.out + OUT_Y + (size_t)m * D;
#pragma unroll
                for (int j = 0; j < 4; ++j)
#pragma unroll
                    for (int h = 0; h < 2; ++h) *(GAS f32x4*)(yo + 8 * (F.lane + 64 * j) + 4 * h) = v[j][h] * rstd * gs[j][h];
            } else {
#pragma unroll
                for (int j = 0; j < 4; ++j) { const f32x4 h0 = v[j][0] * rstd * gs[j][0] + sh[j][0], h1 = v[j][1] * rstd * gs[j][1] + sh[j][1];
                    *(GAS v4u*)(H + (size_t)m * D + 8 * (F.lane + 64 * j)) = (v4u){pk2(h0.x, h0.y), pk2(h0.z, h0.w), pk2(h1.x, h1.y), pk2(h1.z, h1.w)}; }
            }
        }
#undef NORM_LOAD
    }
}

__device__ __forceinline__ void mla_mid_phase(Frame& F, const Args& A, int j) {
    const int gw = F.vcu * NWAVES + F.wave, NGW = F.G * NWAVES, lane = F.lane;
    const float* PROJ = (const float*)(F.ws + WS_PROJ); bf16* CQ = (bf16*)(F.ws + WS_CQ); bf16* CKV = (bf16*)(F.ws + WS_CKV); bf16* KR = (bf16*)(F.ws + WS_KR);
    const float* gq = A.in[13] + j * QL; const float* gkv = A.in[14] + j * KVL;
    const float* cosT = (const float*)(F.ws + WS_COS); const float* sinT = (const float*)(F.ws + WS_SIN);
    const f32x4 gq0 = *(const GAS f32x4*)(gq + 8 * lane), gq1 = *(const GAS f32x4*)(gq + 8 * lane + 4), gk0 = *(const GAS f32x4*)(gkv + 8 * lane), gk1 = *(const GAS f32x4*)(gkv + 8 * lane + 4);
    for (int m = gw; m < NTOK; m += NGW) {
        const float* pr = PROJ + (size_t)m * NINP;
        const f32x4 q0 = *(const GAS f32x4*)(pr + 8 * lane), q1 = *(const GAS f32x4*)(pr + 8 * lane + 4), k0 = *(const GAS f32x4*)(pr + QL + 8 * lane), k1 = *(const GAS f32x4*)(pr + QL + 8 * lane + 4);
        const float* pk = (const float*)(F.ws + WS_PKR) + (size_t)m * ROPE + lane;
        const float kr = (pk[0] + pk[(size_t)NTOK * ROPE]) + (pk[2ull * NTOK * ROPE] + pk[3ull * NTOK * ROPE]);
        const float sq = wave_sum((q0.x * q0.x + q0.y * q0.y) + (q0.z * q0.z + q0.w * q0.w) + (q1.x * q1.x + q1.y * q1.y) + (q1.z * q1.z + q1.w * q1.w), lane);
        const float sk = wave_sum((k0.x * k0.x + k0.y * k0.y) + (k0.z * k0.z + k0.w * k0.w) + (k1.x * k1.x + k1.y * k1.y) + (k1.z * k1.z + k1.w * k1.w), lane);
        const float rq = 1.0f / sqrtf(sq * (1.0f / QL) + NORM_EPS), rk = 1.0f / sqrtf(sk * (1.0f / KVL) + NORM_EPS);
        const f32x4 a0 = q0 * rq * gq0, a1 = q1 * rq * gq1, c0 = k0 * rk * gk0, c1 = k1 * rk * gk1;
        *(GAS v4u*)(CQ + (size_t)m * QL + 8 * lane) = (v4u){pk2(a0.x, a0.y), pk2(a0.z, a0.w), pk2(a1.x, a1.y), pk2(a1.z, a1.w)};
        const int kvr = kv_row(m);
        *(GAS v4u*)(CKV + (size_t)kvr * KVL + 8 * lane) = (v4u){pk2(c0.x, c0.y), pk2(c0.z, c0.w), pk2(c1.x, c1.y), pk2(c1.z, c1.w)};
        float krv = kr;
        if (m < MCTX) {
            const int b = m >> 8, t = m & 255; float* oc = F.out + OUT_CKV + ((size_t)(b * 2 + j) * 256 + t) * KVL + 8 * lane;
            *(GAS f32x4*)oc = c0; *(GAS f32x4*)(oc + 4) = c1;
            F.out[OUT_KR + ((size_t)(b * 2 + j) * 256 + t) * ROPE + lane] = kr;
        } else {
            const int pos = (m - MCTX) & 1023, ai = (lane & 15) + 16 * (lane >> 5); const float cs = cosT[pos * 32 + ai], sn = sinT[pos * 32 + ai];
            const float other = shfl_xor_l(kr, 16, lane);
            krv = (lane & 16) ? (kr * cs + other * sn) : (kr * cs - other * sn);
        }
        KR[(size_t)kvr * ROPE + lane] = (bf16)f2bf(krv);
    }
    for (int i = gw; i < 8 * 256; i += NGW) { const int b = i >> 8, t = i & 255; const size_t dst = (size_t)MCTX + 1280 * b + t;
        const float* sc = A.in[2] + ((size_t)(b * 2 + j) * 256 + t) * KVL + 8 * lane; const f32x4 c0 = *(const GAS f32x4*)sc, c1 = *(const GAS f32x4*)(sc + 4);
        *(GAS v4u*)(CKV + dst * KVL + 8 * lane) = (v4u){pk2(c0.x, c0.y), pk2(c0.z, c0.w), pk2(c1.x, c1.y), pk2(c1.z, c1.w)};
        KR[dst * ROPE + lane] = (bf16)f2bf(A.in[3][((size_t)(b * 2 + j) * 256 + t) * ROPE + lane]); }
}

__device__ __forceinline__ void attn_phase(Frame& F, char* lds) {
    const att::bf16* Q = (const att::bf16*)(F.ws + WS_Q); const att::bf16* KN = (const att::bf16*)(F.ws + WS_KN); const att::bf16* KR = (const att::bf16*)(F.ws + WS_KR);
    const att::bf16* V = (const att::bf16*)(F.ws + WS_V); att::bf16* O = (att::bf16*)(F.ws + WS_O);
    for (int i = 0; i < 4; ++i) {
        int qrow, krow, h, seq;
        if (i < 2) { const int id = F.vcu * 2 + i, b = id >> 6, rem = id & 63, qb = rem & 3; h = rem >> 2; qrow = MCTX + b * 1024 + qb * 256; krow = MCTX + b * 1280; seq = 1280; }
        else { const int id = F.vcu * 2 + (i - 2), s = id >> 4; h = id & 15; qrow = s * 256; krow = s * 256; seq = 256; }
        __syncthreads();
        att::attn_unit(Q + (size_t)qrow * NQ + h * QKD, KN + (size_t)krow * D + h * NOPE, KR + (size_t)krow * ROPE, V + (size_t)krow * D + h * VD, O + (size_t)qrow * D + h * VD, seq, lds, lds + RING_BYTES + 2048, F.wave);
    }
}

__device__ __forceinline__ void conv4_phase(Frame& F, const Args& A, int j) {
    const int gw = F.vcu * NWAVES + F.wave, NGW = F.G * NWAVES, lane = F.lane;
    const bf16* RIN = (const bf16*)(F.ws + WS_RIN); bf16* XC = (bf16*)(F.ws + WS_XC);
    const float* wc = A.in[20] + (size_t)j * 4 * D; const float* bc = A.in[21] + (size_t)j * D;
    for (int task = gw; task < (NTOK / 32) * 4; task += NGW) {
        const int cg = task & 3, chunk = task >> 2, c0 = cg * 512 + lane * 8;
        float w[4][8], bb[8];
#pragma unroll
        for (int t = 0; t < 4; ++t) { const f32x4 a = *(const GAS f32x4*)(wc + t * D + c0), b = *(const GAS f32x4*)(wc + t * D + c0 + 4); w[t][0] = a.x; w[t][1] = a.y; w[t][2] = a.z; w[t][3] = a.w; w[t][4] = b.x; w[t][5] = b.y; w[t][6] = b.z; w[t][7] = b.w; }
        { const f32x4 a = *(const GAS f32x4*)(bc + c0), b = *(const GAS f32x4*)(bc + c0 + 4); bb[0] = a.x; bb[1] = a.y; bb[2] = a.z; bb[3] = a.w; bb[4] = b.x; bb[5] = b.y; bb[6] = b.z; bb[7] = b.w; }
#pragma unroll 1
        for (int half = 0; half < 2; ++half) {
        const int r0 = chunk * 32 + half * 16;
        const int slen = r0 < MCTX ? 256 : 1024, sbeg = r0 < MCTX ? (r0 & ~255) : MCTX + ((r0 - MCTX) & ~1023), send = sbeg + slen;
        v4u raw[19];
#pragma unroll
        for (int i = 0; i < 19; ++i) { const int r = r0 - 2 + i; raw[i] = (r >= sbeg && r < send) ? *(const GAS v4u*)(RIN + (size_t)r * (2 * D) + D + c0) : (v4u){0u, 0u, 0u, 0u}; }
#pragma unroll
        for (int t = 0; t < 16; ++t) {
            float o[8];
#pragma unroll
            for (int c = 0; c < 8; ++c) o[c] = bb[c];
#pragma unroll
            for (int jj = 0; jj < 4; ++jj) { const v4u x = raw[t + jj];
                o[0] += w[jj][0] * pg8::bf_lo(x.x); o[1] += w[jj][1] * pg8::bf_hi(x.x); o[2] += w[jj][2] * pg8::bf_lo(x.y); o[3] += w[jj][3] * pg8::bf_hi(x.y);
                o[4] += w[jj][4] * pg8::bf_lo(x.z); o[5] += w[jj][5] * pg8::bf_hi(x.z); o[6] += w[jj][6] * pg8::bf_lo(x.w); o[7] += w[jj][7] * pg8::bf_hi(x.w); }
            *(GAS v4u*)(XC + (size_t)(r0 + t) * D + c0) = (v4u){pk2(o[0], o[1]), pk2(o[2], o[3]), pk2(o[4], o[5]), pk2(o[6], o[7])};
        }
        }
    }
}

typedef float sf2 __attribute__((ext_vector_type(2)));
__device__ __forceinline__ sf2 bf2_to_f2(unsigned w) { return (sf2){__uint_as_float(w << 16), __uint_as_float(w & 0xffff0000u)}; }
__device__ __forceinline__ void scan_phase(Frame& F, const Args& A, int j) {
    const int lane = F.lane, wave = F.wave;
    LAS float* aggb = (LAS float*)(F.lds + RING_OFF);
    LAS float* carb = aggb + 2 * 8 * 128 * 2;
    const int nunits = F.vcu < 128 ? 1 : 4; int pass = 0;
    for (int ui = 0; ui < nunits; ++ui) {
        int row0, nsub, cg, bidx; bool ctx;
        if (F.vcu < 128) { const int id = F.vcu; bidx = id >> 4; cg = id & 15; row0 = MCTX + bidx * 1024; nsub = 4; ctx = false; }
        else { const int id = (F.vcu - 128) * 4 + ui; bidx = id >> 4; cg = id & 15; row0 = bidx * 256; nsub = 1; ctx = true; }
        const int ch = cg * 128 + lane * 2;
        const bf16* LAf = (const bf16*)(F.ws + WS_LA) + ch; const bf16* LAb = LAf + (size_t)NTOK * D;
        const bf16* UUf = (const bf16*)(F.ws + WS_UU) + ch; const bf16* UUb = UUf + (size_t)NTOK * D;
        bf16* HB = (bf16*)(F.ws + WS_HB) + ch; const bf16* GY = (const bf16*)(F.ws + WS_RIN) + ch; bf16* MIX = (bf16*)(F.ws + WS_MIX) + ch;
        sf2 hf0 = (sf2){0.f, 0.f}, hb0 = (sf2){0.f, 0.f};
        if (!ctx) { const float* st = A.in[4] + ((size_t)(bidx * 2 + j) * 2) * D + ch; hf0 = *(const GAS sf2*)st; hb0 = *(const GAS sf2*)(st + D); }
        for (int sb = nsub - 1; sb >= 0; --sb, ++pass) {
            const size_t r0 = (size_t)(row0 + sb * 256 + wave * 32);
            unsigned L[32], U[32];
#pragma unroll
            for (int i = 0; i < 32; ++i) { L[i] = *(const GAS unsigned*)(LAb + (r0 + 31 - i) * D); U[i] = *(const GAS unsigned*)(UUb + (r0 + 31 - i) * D); }
            sf2 sl = (sf2){0.f, 0.f}, hl = (sf2){0.f, 0.f};
#pragma unroll
            for (int i = 0; i < 32; ++i) { const sf2 l = bf2_to_f2(L[i]), u = bf2_to_f2(U[i]); sl += l; hl.x = __builtin_amdgcn_exp2f(l.x) * hl.x + u.x; hl.y = __builtin_amdgcn_exp2f(l.y) * hl.y + u.y; }
            LAS float* ag = aggb + (((pass & 1) * 8 + wave) * 128 + lane * 2) * 2;
            *(LAS f32x4*)ag = (f32x4){__builtin_amdgcn_exp2f(sl.x), hl.x, __builtin_amdgcn_exp2f(sl.y), hl.y};
            __syncthreads();
            sf2 h = hb0; if (sb != nsub - 1) h = *(const LAS sf2*)(carb + (pass & 1) * 128 + lane * 2);
            for (int c = 7; c > wave; --c) { const f32x4 q = *(const LAS f32x4*)(aggb + (((pass & 1) * 8 + c) * 128 + lane * 2) * 2); h.x = q.x * h.x + q.y; h.y = q.z * h.y + q.w; }
#pragma unroll
            for (int i = 0; i < 32; ++i) { const sf2 l = bf2_to_f2(L[i]), u = bf2_to_f2(U[i]); h.x = __builtin_amdgcn_exp2f(l.x) * h.x + u.x; h.y = __builtin_amdgcn_exp2f(l.y) * h.y + u.y;
                *(GAS unsigned*)(HB + (r0 + 31 - i) * D) = pk2(h.x, h.y); }
            if (wave == 0) { *(LAS sf2*)(carb + ((pass + 1) & 1) * 128 + lane * 2) = h;
                if (ctx) *(GAS sf2*)(F.out + OUT_ST + ((size_t)(bidx * 2 + j) * 2 + 1) * D + ch) = h; }
        }
        for (int sb = 0; sb < nsub; ++sb, ++pass) {
            const size_t r0 = (size_t)(row0 + sb * 256 + wave * 32);
            unsigned L[32], U[32], G[32], Hh[32];
#pragma unroll
            for (int i = 0; i < 32; ++i) { L[i] = *(const GAS unsigned*)(LAf + (r0 + i) * D); U[i] = *(const GAS unsigned*)(UUf + (r0 + i) * D); }
#pragma unroll
            for (int i = 0; i < 32; ++i) { G[i] = *(const GAS unsigned*)(GY + (r0 + i) * (2 * D)); Hh[i] = *(const GAS unsigned*)(HB + (r0 + i) * D); }
            sf2 sl = (sf2){0.f, 0.f}, hl = (sf2){0.f, 0.f};
#pragma unroll
            for (int i = 0; i < 32; ++i) { const sf2 l = bf2_to_f2(L[i]), u = bf2_to_f2(U[i]); sl += l; hl.x = __builtin_amdgcn_exp2f(l.x) * hl.x + u.x; hl.y = __builtin_amdgcn_exp2f(l.y) * hl.y + u.y; }
            LAS float* ag = aggb + (((pass & 1) * 8 + wave) * 128 + lane * 2) * 2;
            *(LAS f32x4*)ag = (f32x4){__builtin_amdgcn_exp2f(sl.x), hl.x, __builtin_amdgcn_exp2f(sl.y), hl.y};
            __syncthreads();
            sf2 h = hf0; if (sb != 0) h = *(const LAS sf2*)(carb + (pass & 1) * 128 + lane * 2);
            for (int c = 0; c < wave; ++c) { const f32x4 q = *(const LAS f32x4*)(aggb + (((pass & 1) * 8 + c) * 128 + lane * 2) * 2); h.x = q.x * h.x + q.y; h.y = q.z * h.y + q.w; }
#pragma unroll
            for (int i = 0; i < 32; ++i) { const sf2 l = bf2_to_f2(L[i]), u = bf2_to_f2(U[i]), gy = bf2_to_f2(G[i]), hbv = bf2_to_f2(Hh[i]);
                h.x = __builtin_amdgcn_exp2f(l.x) * h.x + u.x; h.y = __builtin_amdgcn_exp2f(l.y) * h.y + u.y;
                *(GAS unsigned*)(MIX + (r0 + i) * D) = pk2((h.x + hbv.x) * gy.x, (h.y + hbv.y) * gy.y); }
            if (wave == 7) { *(LAS sf2*)(carb + ((pass + 1) & 1) * 128 + lane * 2) = h;
                if (ctx) *(GAS sf2*)(F.out + OUT_ST + ((size_t)(bidx * 2 + j) * 2 + 0) * D + ch) = h; }
        }
    }
    __syncthreads();
}


typedef unsigned v2u __attribute__((ext_vector_type(2)));
#define RS_BAR() do { asm volatile("s_waitcnt lgkmcnt(0)" ::: "memory"); __builtin_amdgcn_s_barrier(); asm volatile("" ::: "memory"); } while (0)
__device__ __forceinline__ void rs_phase(Frame& F, const Args& A, int j, int wave0) {
    const int nunits = F.vcu < 128 ? 1 : 4; int pass = 0;
    const pg8::Gemm g = pg8::mk_gemm((const pg8::bf16_t*)(F.ws + WS_XC), (const pg8::bf16_t*)(F.ws + WS_WG) + (size_t)j * 8192 * 128, 128, D);
    const pg8::EpiGatesLds E{(const pg8::bf16_t*)(F.ws + WS_XC), A.in[23] + (size_t)j * 2 * D, A.in[25] + (size_t)j * 2 * D, (const float*)(F.ws + WS_SP) + (size_t)j * 2 * D, (LAS float*)(F.lds + EDGE_OFF)};
    const bool lat = F.vcu < 128; const int nsub = lat ? 4 : 1, npass = 8;
    auto pass_unit = [&](int p, pg8::Unit& u) { const int ui = lat ? 0 : (p >> 1), q = lat ? p : (p & 1), sweep = q / nsub, si = q - sweep * nsub, sb = sweep ? si : nsub - 1 - si;
        const int id = lat ? F.vcu : (F.vcu - 128) * 4 + ui, bidx = id >> 4, cg = id & 15, row0 = lat ? MCTX + bidx * 1024 : bidx * 256;
        u.pm = (row0 >> 8) + sb; u.pn = 2 * cg + (sweep ? 0 : 1); };
    pg8::Unit ucur; pass_unit(0, ucur);
    f32x4 pf; { int tq = wave0 * 64 + lane_now(); asm volatile("" : "+v"(tq)); pf = E.pre(ucur, tq); }
    pg8::gate_stage(F.lds + RING_OFF, g, ucur.pm, ucur.pn, wave0);
    (void)nunits;
#pragma unroll 1
    for (int p = 0; p < npass; ++p, ++pass) {
        const int ui = lat ? 0 : (p >> 1), q = lat ? p : (p & 1), sweep = q / nsub, si = q - sweep * nsub, sb = sweep ? si : nsub - 1 - si;
        const int id = lat ? F.vcu : (F.vcu - 128) * 4 + ui, bidx = id >> 4, cg = id & 15, row0 = lat ? MCTX + bidx * 1024 : bidx * 256; const bool ctx = !lat;
        if (p == 0 || (sweep && si == 0)) asm volatile("s_waitcnt vmcnt(0)" ::: "memory"); else asm volatile("s_waitcnt vmcnt(32)" ::: "memory");
        RS_BAR();
        { int t_ = wave0 * 64 + lane_now(); asm volatile("" : "+v"(t_)); F.tid = t_; F.lane = t_ & 63; F.wave = __builtin_amdgcn_readfirstlane(t_ >> 6); }
        { f32x4 acc[2][2][4][2]; const int wr = F.wave >> 2, wc = F.wave & 3, fr = F.lane & 15, fq = F.lane >> 4;
          pg8::gate_compute(F.lds + RING_OFF, acc, wr, wc, fr, fq);
          RS_BAR();
          E.fused(acc, ucur, wr, wc, fr, fq, F.lds + RING_OFF, pf); }
        RS_BAR();
        const int lane = F.lane, wave = F.wave;
        LAS float* aggb = (LAS float*)(F.lds + EDGE_OFF + 2048);
        LAS float* carb = aggb + 8 * 128 * 2;
        const LAS unsigned char* img = F.lds + RING_OFF;
        const int ch = cg * 128 + lane * 2;
        bf16* HB = (bf16*)(F.ws + WS_HB) + ch; const bf16* GY = (const bf16*)(F.ws + WS_RIN) + ch; bf16* MIX = (bf16*)(F.ws + WS_MIX) + ch;
        const size_t r0 = (size_t)(row0 + sb * 256 + wave * 32);
        unsigned W0[32], W1[32];
#pragma unroll
        for (int i = 0; i < 32; ++i) { const int rl = wave * 32 + (sweep ? i : 31 - i);
            const v2u w = *(const LAS v2u*)(img + rl * 512 + (((lane >> 1) ^ (rl & 31)) << 4) + ((lane & 1) << 3)); W0[i] = w.x; W1[i] = w.y; }
        RS_BAR();
        if (p + 1 < npass) { pass_unit(p + 1, ucur); { int tq = wave0 * 64 + lane_now(); asm volatile("" : "+v"(tq)); pf = E.pre(ucur, tq); }
            pg8::gate_stage(F.lds + RING_OFF, g, ucur.pm, ucur.pn, wave0); }
        unsigned G[32], Hh[32];
#pragma unroll
        for (int i = 0; i < 32; ++i) { G[i] = 0u; Hh[i] = 0u; }
        if (sweep) {
#pragma unroll
            for (int i = 0; i < 32; ++i) { G[i] = *(const GAS unsigned*)(GY + (r0 + i) * (2 * D)); Hh[i] = *(const GAS unsigned*)(HB + (r0 + i) * D); } }
        sf2 sl = (sf2){0.f, 0.f}, hl = (sf2){0.f, 0.f}; float A0[32], A1[32];
#pragma unroll
        for (int i = 0; i < 32; ++i) { const sf2 l = (sf2){pg8::bf_lo(W0[i]), pg8::bf_lo(W1[i])}, u = (sf2){pg8::bf_hi(W0[i]), pg8::bf_hi(W1[i])};
            sl += l; A0[i] = __builtin_amdgcn_exp2f(l.x); A1[i] = __builtin_amdgcn_exp2f(l.y); hl.x = A0[i] * hl.x + u.x; hl.y = A1[i] * hl.y + u.y; }
        LAS float* ag = aggb + (wave * 128 + lane * 2) * 2;
        *(LAS f32x4*)ag = (f32x4){__builtin_amdgcn_exp2f(sl.x), hl.x, __builtin_amdgcn_exp2f(sl.y), hl.y};
        RS_BAR();
        sf2 h;
        if (si == 0) { h = (sf2){0.f, 0.f};
            if (!ctx) { const float* st = A.in[4] + ((size_t)(bidx * 2 + j) * 2) * D + ch; h = *(const GAS sf2*)(st + (sweep ? 0 : D)); } }
        else h = *(const LAS sf2*)(carb + (pass & 1) * 128 + lane * 2);
        if (sweep == 0) {
            for (int c = 7; c > wave; --c) { const f32x4 qv = *(const LAS f32x4*)(aggb + (c * 128 + lane * 2) * 2); h.x = qv.x * h.x + qv.y; h.y = qv.z * h.y + qv.w; }
#pragma unroll
            for (int i = 0; i < 32; ++i) { const sf2 u = (sf2){pg8::bf_hi(W0[i]), pg8::bf_hi(W1[i])};
                h.x = A0[i] * h.x + u.x; h.y = A1[i] * h.y + u.y;
                *(GAS unsigned*)(HB + (r0 + 31 - i) * D) = pk2(h.x, h.y); }
            if (wave == 0) { *(LAS sf2*)(carb + ((pass + 1) & 1) * 128 + lane * 2) = h;
                if (ctx) *(GAS sf2*)(F.out + OUT_ST + ((size_t)(bidx * 2 + j) * 2 + 1) * D + ch) = h; }
        } else {
            for (int c = 0; c < wave; ++c) { const f32x4 qv = *(const LAS f32x4*)(aggb + (c * 128 + lane * 2) * 2); h.x = qv.x * h.x + qv.y; h.y = qv.z * h.y + qv.w; }
#pragma unroll
            for (int i = 0; i < 32; ++i) { const sf2 u = (sf2){pg8::bf_hi(W0[i]), pg8::bf_hi(W1[i])}, gy = bf2_to_f2(G[i]), hbv = bf2_to_f2(Hh[i]);
                h.x = A0[i] * h.x + u.x; h.y = A1[i] * h.y + u.y;
                *(GAS unsigned*)(MIX + (r0 + i) * D) = pk2((h.x + hbv.x) * gy.x, (h.y + hbv.y) * gy.y); }
            if (wave == 7) { *(LAS sf2*)(carb + ((pass + 1) & 1) * 128 + lane * 2) = h;
                if (ctx) *(GAS sf2*)(F.out + OUT_ST + ((size_t)(bidx * 2 + j) * 2 + 0) * D + ch) = h; }
        }
    }
    asm volatile("s_waitcnt vmcnt(0)" ::: "memory"); __syncthreads();
}

__device__ __forceinline__ void ffn_fix_panel(Frame& F, const Args& A, int layer, int pm) {
    if (pm < MCTX / 256) return;
    const float* HALO = (const float*)(F.ws + WS_HALO); bf16* ACT = (bf16*)(F.ws + WS_ACT);
    const float* wc = A.in[29] + (size_t)layer * 3 * NUP; const float* bc = A.in[30] + (size_t)layer * NUP;
    const float* hc = HALO + (size_t)pm * 4 * NUP; const int k = (pm - MCTX / 256) & 3;
    const bool top = k != 0, bot = k != 3;
    for (int c4 = F.tid; c4 < DFF / 4; c4 += NWAVES * 64) { const int c0 = c4 * 4; f32x4 vt[2], vb[2];
#pragma unroll
        for (int bj = 0; bj < 2; ++bj) { const int cc = c0 + bj * DFF;
            const f32x4 b = *(const GAS f32x4*)(bc + cc), w0 = *(const GAS f32x4*)(wc + cc), w1 = *(const GAS f32x4*)(wc + NUP + cc), w2 = *(const GAS f32x4*)(wc + 2 * NUP + cc);
            const f32x4 z = (f32x4){0.f, 0.f, 0.f, 0.f};
            const f32x4 t0 = top ? *(const GAS f32x4*)(hc - NUP + cc) : z, t1 = top ? *(const GAS f32x4*)(hc + cc) : z, t2 = top ? *(const GAS f32x4*)(hc + NUP + cc) : z;
            const f32x4 b0 = bot ? *(const GAS f32x4*)(hc + 2 * NUP + cc) : z, b1 = bot ? *(const GAS f32x4*)(hc + 3 * NUP + cc) : z, b2 = bot ? *(const GAS f32x4*)(hc + 4 * NUP + cc) : z;
            vt[bj] = b + w0 * t0 + w1 * t1 + w2 * t2; vb[bj] = b + w0 * b0 + w1 * b1 + w2 * b2; }
        if (top) { float o[4];
#pragma unroll
            for (int j = 0; j < 4; ++j) o[j] = vt[0][j] * pg8::fast_sigmoid(vt[0][j]) * vt[1][j];
            *(GAS unsigned long long*)(ACT + (size_t)pm * 256 * ALD + c0) = (unsigned long long)pk2(o[0], o[1]) | ((unsigned long long)pk2(o[2], o[3]) << 32); }
        if (bot) { float o[4];
#pragma unroll
            for (int j = 0; j < 4; ++j) o[j] = vb[0][j] * pg8::fast_sigmoid(vb[0][j]) * vb[1][j];
            *(GAS unsigned long long*)(ACT + ((size_t)pm * 256 + 255) * ALD + c0) = (unsigned long long)pk2(o[0], o[1]) | ((unsigned long long)pk2(o[2], o[3]) << 32); } }
}

#ifndef MK_PER_PHASE
#define MK_PER_PHASE 0
#endif
#ifndef MK_MASK
#define MK_MASK 0xffffffffu
#endif
#define ON(i) ((MK_MASK >> (i)) & 1u)
#ifndef MK_REP
#define MK_REP 0u
#endif
#define NREP(i) (((MK_REP >> (i)) & 1u) ? 2 : 1)
#ifndef MK_RS
#define MK_RS 1
#endif
#ifndef MK_ALIGN
#define MK_ALIGN true
#endif
#ifndef MK_ALIGN_S
#define MK_ALIGN_S MK_ALIGN
#endif
#ifndef MK_ALIGN_RES
#define MK_ALIGN_RES MK_ALIGN
#endif
#ifndef MK_ALIGN_G
#define MK_ALIGN_G MK_ALIGN
#endif
#ifndef MK_SP2
#define MK_SP2 true
#endif
#ifndef MK_STOP
#define MK_STOP 1000
#endif
constexpr int NPHASE = 2 + 10 * NLAYER;
#ifndef MK_PROBE
#define MK_PROBE 0
#endif
#ifndef MK_SEL1
#define MK_SEL1 0
#endif
#ifndef MK_SEL2
#define MK_SEL2 1
#endif
#ifndef MK_SCALE2
#define MK_SCALE2 1.0f
#endif
constexpr int STAMP_OFF = LDSCTL_OFF + 1024;

__global__ void __launch_bounds__(NWAVES * 64, 2) mk_fwd(Args args) {
    extern __shared__ __attribute__((aligned(16))) unsigned char lds[];
    Frame F;
    F.lds = (LAS unsigned char*)lds;
    F.MISC = (volatile LAS unsigned*)(F.lds + MISC_OFF);
    F.tid = threadIdx.x; F.lane = F.tid & 63; F.wave = __builtin_amdgcn_readfirstlane(F.tid >> 6);
    const int wave0 = F.wave;
    F.G = gridDim.x; { const int bx = blockIdx.x; F.vcu = (F.G % 8 == 0) ? (bx % 8) * (F.G / 8) + bx / 8 : bx; }
    F.out = args.out; F.ws = args.ws;
    for (int u = F.tid; u < (LDS_BYTES - LDSCTL_OFF) / 4; u += NWAVES * 64) ((LAS unsigned*)(F.lds + LDSCTL_OFF))[u] = 0u;
    __syncthreads();
    const int lo = args.ph_lo, hi = args.ph_hi < MK_STOP ? args.ph_hi : MK_STOP;
    unsigned* barw = (unsigned*)(args.ws + WS_CTL) + CW_BAR;
    XcdBarrier bar; bar.bar = barw; bar.x = 0; bar.st = nullptr;
    if (hi - lo > 1) bar = xcd_barrier_post(barw, F.MISC + 8, F.tid == 0);
#define IN(k) (lo <= (k) && (k) < hi)
#define PHASE_BEGIN() size_t z_ = 0; asm volatile("" : "+s"(z_)); unsigned char* ws = args.ws + z_;     \
    { int t_ = wave0 * 64 + lane_now(); asm volatile("" : "+v"(t_)); F.tid = t_; F.lane = t_ & 63; F.wave = __builtin_amdgcn_readfirstlane(t_ >> 6); F.ws = ws; } \
    const float* mods = (const float*)(ws + WS_MODS); bf16* Hb = (bf16*)(ws + WS_H); bf16* X = (bf16*)(ws + WS_X); (void)mods; (void)Hb; (void)X;
#if MK_PROBE
#define STAMP(i) do { if (blockIdx.x == 0 && threadIdx.x == 0) ((LAS unsigned long long*)(F.lds + STAMP_OFF))[i] = __builtin_amdgcn_s_memrealtime(); } while (0)
#define SEAM2(k, kn) do { if (IN(k) && IN(kn)) xcd_barrier(bar, wave0 * 64 + lane_now() == 0); STAMP((k) + 1); } while (0)
#define SEAM(k) SEAM2(k, (k) + 1)
#else
#define STAMP(i) do { } while (0)
#ifdef MK_BAR2
#define SEAM2(k, kn) do { if (IN(k) && IN(kn)) { xcd_barrier(bar, wave0 * 64 + lane_now() == 0); xcd_barrier(bar, wave0 * 64 + lane_now() == 0); } } while (0)
#define SEAM(k) SEAM2(k, (k) + 1)
#else
#define SEAM2(k, kn) do { if (IN(k) && IN(kn)) xcd_barrier(bar, wave0 * 64 + lane_now() == 0); } while (0)
#define SEAM(k) SEAM2(k, (k) + 1)
#endif
#endif
    const int cid = (int)blockIdx.x;

    STAMP(0);
    if (IN(0) && ON(0)) { PHASE_BEGIN(); for (int rep = 0; rep < NREP(0); ++rep) { if (rep) xcd_barrier(bar, wave0 * 64 + lane_now() == 0); p0_prologue(F, args); } }
    SEAM(0);
    if (IN(1) && ON(1)) { PHASE_BEGIN(); for (int rep = 0; rep < NREP(1); ++rep) { if (rep) xcd_barrier(bar, wave0 * 64 + lane_now() == 0); norm_phase<0>(F, args, args.in[7], mods, 0); } }
    SEAM(1);

#pragma nounroll
    for (int layer = 0; layer < NLAYER; ++layer) {
        const int pb = 2 + 10 * layer, j = layer >> 1;
        if ((layer & 1) == 0) {
            if (IN(pb + 0) && ON(2)) { PHASE_BEGIN(); for (int rep = 0; rep < NREP(2); ++rep) { if (rep) xcd_barrier(bar, wave0 * 64 + lane_now() == 0); const float* lmods = mods + (size_t)layer * NMOD * ADA_N; (void)lmods; pg8::Gemm g = pg8::mk_gemm(Hb, (const bf16*)(ws + WS_WIN) + (size_t)j * NINP * D, D, D); pg8::StaticOrder S; S.init(NTOK, QL + KVL, F.G, cid);
                pg8::EpiF32 E{(float*)(ws + WS_PROJ), NINP};
                pg8::gemm_phase<pg8::EpiF32, pg8::StaticOrder, MK_ALIGN, MK_SP2>(F.lds + RING_OFF, g, S, E, wave0);
                pg8::Gemm g2 = pg8::mk_gemm(Hb, (const bf16*)(ws + WS_WIN) + ((size_t)j * NINP + QL + KVL) * D, D / 4, D); g2.ldb = D; g2.b_hstep = (size_t)pg8::HALF * D * 2; g2.b_tstep = 0;
                pg8::KSplitOrder S2; S2.init(NTOK, D / 4, F.G, cid);
                pg8::EpiKr E2{(float*)(ws + WS_PKR)};
                pg8::gemm_phase<pg8::EpiKr, pg8::KSplitOrder, MK_ALIGN, MK_SP2>(F.lds + RING_OFF, g2, S2, E2, wave0); } }
            SEAM(pb + 0);
            if (IN(pb + 1) && ON(3)) { PHASE_BEGIN(); for (int rep = 0; rep < NREP(3); ++rep) { if (rep) xcd_barrier(bar, wave0 * 64 + lane_now() == 0); const float* lmods = mods + (size_t)layer * NMOD * ADA_N; (void)lmods; mla_mid_phase(F, args, j); } }
            SEAM(pb + 1);
            if (IN(pb + 2) && ON(4)) {
                PHASE_BEGIN(); for (int rep = 0; rep < NREP(4); ++rep) { if (rep) xcd_barrier(bar, wave0 * 64 + lane_now() == 0);
#ifdef MK_SKEW
                if ((cid >> 3) & 1) { for (int i = 0; i < MK_SKEW; ++i) __builtin_amdgcn_s_sleep(127); }
#endif
                { pg8::Gemm g = pg8::mk_gemm((const bf16*)(ws + WS_CQ), (const bf16*)(ws + WS_WUQ) + (size_t)j * NQ * QL, QL, QL); pg8::StaticOrder S; S.init(NTOK, NQ, F.G, cid);
                  pg8::EpiQ E{(bf16*)(ws + WS_Q), (const float*)(ws + WS_COS), (const float*)(ws + WS_SIN)};
                  pg8::gemm_phase<pg8::EpiQ, pg8::StaticOrder, MK_ALIGN, MK_SP2>(F.lds + RING_OFF, g, S, E, wave0); }
                { pg8::Gemm g = pg8::mk_gemm((const bf16*)(ws + WS_CKV), (const bf16*)(ws + WS_WUKV) + (size_t)j * NKV * KVL, KVL, KVL); pg8::StaticOrder S; S.init(MKV, NKV, F.G, cid);
                  pg8::EpiBf16<0> E{(bf16*)(ws + WS_KN), D, D, (size_t)(WS_V - WS_KN) / 2, 0};
                  pg8::gemm_phase<pg8::EpiBf16<0>, pg8::StaticOrder, MK_ALIGN, MK_SP2>(F.lds + RING_OFF, g, S, E, wave0); }
            } }
            SEAM(pb + 2);
            if (IN(pb + 3) && ON(5)) { PHASE_BEGIN(); for (int rep = 0; rep < NREP(5); ++rep) { if (rep) xcd_barrier(bar, wave0 * 64 + lane_now() == 0); const float* lmods = mods + (size_t)layer * NMOD * ADA_N; (void)lmods; attn_phase(F, (char*)lds + RING_OFF); } }
            SEAM(pb + 3);
            if (IN(pb + 4) && ON(6)) { PHASE_BEGIN(); for (int rep = 0; rep < NREP(6); ++rep) { if (rep) xcd_barrier(bar, wave0 * 64 + lane_now() == 0); const float* lmods = mods + (size_t)layer * NMOD * ADA_N; (void)lmods; pg8::Gemm g = pg8::mk_gemm((const bf16*)(ws + WS_O), (const bf16*)(ws + WS_WO) + (size_t)j * D * D, D, D); pg8::StaticOrder S; S.init(NTOK, D, F.G, cid);
                pg8::EpiRes E{(NREP(6) == 2 && rep == 0) ? (bf16*)(ws + WS_PROJ) : X, lmods + 2 * D};
                pg8::gemm_phase<pg8::EpiRes, pg8::StaticOrder, MK_ALIGN_RES, MK_SP2>(F.lds + RING_OFF, g, S, E, wave0); } }
            SEAM(pb + 4);
        } else {
            if (IN(pb + 0) && ON(7)) { PHASE_BEGIN(); for (int rep = 0; rep < NREP(7); ++rep) { if (rep) xcd_barrier(bar, wave0 * 64 + lane_now() == 0); const float* lmods = mods + (size_t)layer * NMOD * ADA_N; (void)lmods; pg8::Gemm g = pg8::mk_gemm(Hb, (const bf16*)(ws + WS_WRIN) + (size_t)j * 2 * D * D, D, D); pg8::StaticOrder S; S.init(NTOK, 2 * D, F.G, cid);
                pg8::EpiBf16<1> E{(bf16*)(ws + WS_RIN), 2 * D, 0, 0, D / 256};
                pg8::gemm_phase<pg8::EpiBf16<1>, pg8::StaticOrder, MK_ALIGN, MK_SP2>(F.lds + RING_OFF, g, S, E, wave0); } }
            SEAM(pb + 0);
            if (IN(pb + 1) && ON(8)) { PHASE_BEGIN(); for (int rep = 0; rep < NREP(8); ++rep) { if (rep) xcd_barrier(bar, wave0 * 64 + lane_now() == 0); const float* lmods = mods + (size_t)layer * NMOD * ADA_N; (void)lmods; conv4_phase(F, args, j); } }
            SEAM(pb + 1);
            if (!MK_RS && IN(pb + 2) && ON(9)) { PHASE_BEGIN(); for (int rep = 0; rep < NREP(9); ++rep) { if (rep) xcd_barrier(bar, wave0 * 64 + lane_now() == 0); const float* lmods = mods + (size_t)layer * NMOD * ADA_N; (void)lmods; pg8::Gemm g = pg8::mk_gemm((const bf16*)(ws + WS_XC), (const bf16*)(ws + WS_WG) + (size_t)j * 8192 * 128, 128, D); pg8::GateOrder S; S.init(NTOK, 8192, F.G, cid);
                pg8::EpiGates E{(bf16*)(ws + WS_LA), (bf16*)(ws + WS_UU), (const bf16*)(ws + WS_XC), args.in[23] + (size_t)j * 2 * D, args.in[25] + (size_t)j * 2 * D, (const float*)(ws + WS_SP) + (size_t)j * 2 * D, (LAS float*)(F.lds + EDGE_OFF)};
                pg8::gemm_phase<pg8::EpiGates, pg8::GateOrder, MK_ALIGN_G, MK_SP2>(F.lds + RING_OFF, g, S, E, wave0); } }
            if (!MK_RS) SEAM(pb + 2);
            if (IN(pb + 3) && ON(10)) { PHASE_BEGIN(); for (int rep = 0; rep < NREP(10); ++rep) { if (rep) xcd_barrier(bar, wave0 * 64 + lane_now() == 0); const float* lmods = mods + (size_t)layer * NMOD * ADA_N; (void)lmods; if (MK_RS) rs_phase(F, args, j, wave0); else scan_phase(F, args, j); } }
            SEAM(pb + 3);
            if (IN(pb + 4) && ON(11)) { PHASE_BEGIN(); for (int rep = 0; rep < NREP(11); ++rep) { if (rep) xcd_barrier(bar, wave0 * 64 + lane_now() == 0); const float* lmods = mods + (size_t)layer * NMOD * ADA_N; (void)lmods; pg8::Gemm g = pg8::mk_gemm((const bf16*)(ws + WS_MIX), (const bf16*)(ws + WS_WROUT) + (size_t)j * D * D, D, D); pg8::StaticOrder S; S.init(NTOK, D, F.G, cid);
                pg8::EpiRes E{(NREP(11) == 2 && rep == 0) ? (bf16*)(ws + WS_RIN) : X, lmods + 2 * D};
                pg8::gemm_phase<pg8::EpiRes, pg8::StaticOrder, MK_ALIGN_RES, MK_SP2>(F.lds + RING_OFF, g, S, E, wave0); } }
            SEAM(pb + 4);
        }
        if (IN(pb + 5) && ON(12)) { PHASE_BEGIN(); for (int rep = 0; rep < NREP(12); ++rep) { if (rep) xcd_barrier(bar, wave0 * 64 + lane_now() == 0); const float* lmods = mods + (size_t)layer * NMOD * ADA_N; (void)lmods; norm_phase<1>(F, args, args.in[8] + (size_t)layer * D, lmods, 3); } }
        SEAM(pb + 5);
        if (IN(pb + 6) && ON(13)) { PHASE_BEGIN(); for (int rep = 0; rep < NREP(13); ++rep) { if (rep) xcd_barrier(bar, wave0 * 64 + lane_now() == 0); const float* lmods = mods + (size_t)layer * NMOD * ADA_N; (void)lmods; pg8::Gemm g = pg8::mk_gemm(Hb, (const bf16*)(ws + WS_WUP) + (size_t)layer * NUP * D, D, D); g.b_hstep = (size_t)DFF * D * 2; g.b_tstep = (size_t)pg8::HALF * D * 2;
            pg8::StaticOrder S; S.init(NTOK, NUP, F.G, cid);
            pg8::EpiFfn E{(bf16*)(ws + WS_ACT), (float*)(ws + WS_HALO), args.in[29] + (size_t)layer * 3 * NUP, args.in[30] + (size_t)layer * NUP, (LAS float*)(F.lds + EDGE_OFF)};
            pg8::gemm_phase<pg8::EpiFfn, pg8::StaticOrder, MK_ALIGN, MK_SP2>(F.lds + RING_OFF, g, S, E, wave0); } }
        SEAM2(pb + 6, pb + 8);
        if (IN(pb + 8) && ON(15)) { PHASE_BEGIN(); for (int rep = 0; rep < NREP(15); ++rep) { if (rep) xcd_barrier(bar, wave0 * 64 + lane_now() == 0); const float* lmods = mods + (size_t)layer * NMOD * ADA_N; (void)lmods; pg8::Gemm g = pg8::mk_gemm((const bf16*)(ws + WS_ACT), (const bf16*)(ws + WS_WDN) + (size_t)layer * D * ALD, DFF, ALD); g.ldb = ALD; g.b_hstep = (size_t)pg8::HALF * ALD * 2; g.b_tstep = (size_t)pg8::BM * ALD * 2; pg8::StaticOrder S; S.init(NTOK, D, F.G, cid);
            { pg8::Unit u0, u1; if (S.next(0, u0)) { ffn_fix_panel(F, args, layer, u0.pm); if (S.next(1, u1) && u1.pm != u0.pm) ffn_fix_panel(F, args, layer, u1.pm); }
              asm volatile("s_waitcnt vmcnt(0)" ::: "memory"); __syncthreads(); }
#ifdef MK_KREP
            typedef pg8::EpiResT<MK_KREP> EpiF3;
#else
            typedef pg8::EpiRes EpiF3;
#endif
            EpiF3 E{(NREP(15) == 2 && rep == 0) ? (bf16*)(ws + WS_U) : X, lmods + 5 * D};
            pg8::gemm_phase<EpiF3, pg8::StaticOrder, MK_ALIGN_RES, MK_SP2>(F.lds + RING_OFF, g, S, E, wave0); } }
        SEAM(pb + 8);
        if (IN(pb + 9) && ON(16)) { PHASE_BEGIN(); for (int rep = 0; rep < NREP(16); ++rep) { if (rep) xcd_barrier(bar, wave0 * 64 + lane_now() == 0); const float* lmods = mods + (size_t)layer * NMOD * ADA_N; (void)lmods; if (layer + 1 < NLAYER) norm_phase<1>(F, args, args.in[7] + (size_t)(layer + 1) * D, lmods + (size_t)NMOD * ADA_N, 0); else norm_phase<2>(F, args, args.in[9], mods, 0); } }
        if (layer + 1 < NLAYER) SEAM(pb + 9);
    }
#if MK_PROBE
    xcd_barrier(bar, wave0 * 64 + lane_now() == 0); STAMP(NPHASE);
    { float* cw = (float*)(args.ws + WS_CTL) + 8192;
      if (blockIdx.x == 0 && threadIdx.x == 0) { float T[17]; for (int i = 0; i < 17; ++i) T[i] = 0.f;
          const LAS unsigned long long* ts = (const LAS unsigned long long*)(F.lds + STAMP_OFF);
          float t1 = 0.f, t2 = 0.f;
          for (int p = 0; p < NPHASE; ++p) { const float dt = (float)(ts[p + 1] - ts[p]) * 0.01f; int kind;
              if (p < 2) kind = p; else { const int k = (p - 2) % 10, ly = (p - 2) / 10; kind = k < 5 ? ((ly & 1) ? 7 + k : 2 + k) : 7 + k; }
              if (kind == MK_SEL1 || MK_SEL1 == 99) t1 += dt; if (kind == MK_SEL2 || MK_SEL2 == 99) t2 += dt; }
          (void)T; cw[0] = sqrtf(t1); cw[1] = t2 * MK_SCALE2; }
      xcd_barrier(bar, wave0 * 64 + lane_now() == 0);
      const float c1 = cw[0], c2 = cw[1];
      for (size_t i = (size_t)blockIdx.x * 512 + threadIdx.x; i < OUT_TOTAL; i += (size_t)gridDim.x * 512)
          args.out[i] = (i >= (size_t)MCTX * D && i < 2ull * MCTX * D) ? c1 : (i == 0 ? c2 : 0.f); }
#endif
#undef IN
#undef SEAM
#undef SEAM2
}

extern "C" void kernel_launch(void* const* d_in, const int* in_sizes, int n_in, void* d_out, int out_size, void* d_ws, size_t ws_size, hipStream_t stream) {
    static int grid = 0;
    if (grid == 0) {
        if (n_in != 32 || in_sizes[0] != MCTX * D || in_sizes[1] != MCTX * D || (size_t)out_size != OUT_TOTAL || ws_size < WS_END) {
            fprintf(stderr, "kernel_launch: shape mismatch (n_in %d, out %d, ws %zu); nothing launched\n", n_in, out_size, ws_size); grid = -1; return; }
        int dev = 0, cus = 0, per_cu = 0;
        if (hipGetDevice(&dev) != hipSuccess || hipDeviceGetAttribute(&cus, hipDeviceAttributeMultiprocessorCount, dev) != hipSuccess) { grid = -1; return; }
        if (hipFuncSetAttribute((const void*)mk_fwd, hipFuncAttributeMaxDynamicSharedMemorySize, LDS_BYTES) != hipSuccess) { fprintf(stderr, "kernel_launch: hipFuncSetAttribute failed\n"); grid = -1; return; }
        if (hipOccupancyMaxActiveBlocksPerMultiprocessor(&per_cu, (const void*)mk_fwd, NWAVES * 64, LDS_BYTES) != hipSuccess || per_cu < 1)
            fprintf(stderr, "kernel_launch: note: occupancy query reports %d workgroups per CU\n", per_cu);
        (void)hipGetLastError();
        grid = cus;
        if (grid != 256) fprintf(stderr, "kernel_launch: note: %d CUs (tuned for 256)\n", grid);
    }
    if (grid < 0) return;
    if (hipMemsetAsync((char*)d_ws + WS_CTL, 0, CTL_ZERO_BYTES, stream) != hipSuccess) { fprintf(stderr, "kernel_launch: memset failed\n"); return; }
    Args a{};
    for (int i = 0; i < 32; ++i) a.in[i] = (const float*)d_in[i];
    a.out = (float*)d_out; a.ws = (unsigned char*)d_ws;
#if MK_PER_PHASE
    for (int p = 0; p < NPHASE && p < MK_STOP; ++p) { a.ph_lo = p; a.ph_hi = p + 1; hipLaunchKernelGGL(mk_fwd, dim3(grid), dim3(NWAVES * 64), LDS_BYTES, stream, a); }
#else
    a.ph_lo = 0; a.ph_hi = NPHASE; hipLaunchKernelGGL(mk_fwd, dim3(grid), dim3(NWAVES * 64), LDS_BYTES, stream, a);
#endif
    const hipError_t le = hipPeekAtLastError();
    if (le != hipSuccess) fprintf(stderr, "kernel_launch: launch failed: %s\n", hipGetErrorName(le));
}
```
